# Optimizing an MI355X kernel written in HIP

```python
import math
import jax, jax.numpy as jnp
from jax import lax
import numpy as np

D_MODEL = 2048
BATCH = 2
SEQ = 4096
DEPTH = 1

HEAD_DIM = 64
ATTN_WIDTH = D_MODEL // 2
N_Q_HEADS = ATTN_WIDTH // HEAD_DIM
N_KV_HEADS = N_Q_HEADS // 4
KV_WIDTH = N_KV_HEADS * HEAD_DIM
CONV_WIDTH = D_MODEL - ATTN_WIDTH
CONV_K = 3
WINDOW = 128
Q_BLOCK = 128
IN_WIDTH = ATTN_WIDTH + 2 * KV_WIDTH + 3 * CONV_WIDTH
N_EXPERTS = 64
TOP_K = 8
N_GROUPS = 8
TOPK_GROUPS = 4
D_EXPERT = 512
ROUTED_SCALE = 2.5
EXPERT_BLOCK = 128
ALPHA = (2.0 * DEPTH) ** 0.25
BETA = (8.0 * DEPTH) ** -0.25
LN_EPS = 1e-5

kernel_name = "hymba_conv_swa_moe_deepnorm_adaln"


def layer_norm(x, g, b):
    xf = x.astype(jnp.float32)
    mu = jnp.mean(xf, axis=-1, keepdims=True)
    var = jnp.mean(jnp.square(xf - mu), axis=-1, keepdims=True)
    y = (xf - mu) * lax.rsqrt(var + LN_EPS) * g.astype(jnp.float32) + b.astype(jnp.float32)
    return y.astype(x.dtype)


def alibi_slopes(n_heads):
    return 2.0 ** (-8.0 * jnp.arange(1, n_heads + 1, dtype=jnp.float32) / n_heads)


def swa_sink_attention(q, k, v, sinks):
    b, s = q.shape[0], q.shape[1]
    nb = s // Q_BLOCK
    g = N_Q_HEADS // N_KV_HEADS
    qb = q.reshape(b, nb, Q_BLOCK, N_KV_HEADS, g, HEAD_DIM)

    def band(t):
        tb = t.reshape(b, nb, Q_BLOCK, N_KV_HEADS, HEAD_DIM)
        prev = jnp.pad(tb, ((0, 0), (1, 0), (0, 0), (0, 0), (0, 0)))[:, :-1]
        return jnp.concatenate([prev, tb], axis=2)

    kk, vv = band(k), band(v)
    scores = jnp.einsum('bnqhgd,bnkhd->bnhgqk', qb, kk,
                        preferred_element_type=jnp.float32) * (HEAD_DIM ** -0.5)
    qi = jnp.arange(Q_BLOCK)[:, None]
    kj = jnp.arange(2 * Q_BLOCK)[None, :]
    dist = qi + Q_BLOCK - kj
    valid = (dist >= 0) & (dist < WINDOW)
    valid = valid[None] & ((jnp.arange(nb)[:, None, None] > 0) | (kj[None] >= Q_BLOCK))
    slopes = alibi_slopes(N_Q_HEADS).reshape(N_KV_HEADS, g)
    scores = scores - slopes[:, :, None, None] * dist.astype(jnp.float32)
    scores = jnp.where(valid[None, :, None, None], scores, -jnp.inf)
    sink = sinks.astype(jnp.float32).reshape(N_KV_HEADS, g)[None, None, :, :, None, None]
    m = jnp.maximum(jnp.max(scores, axis=-1, keepdims=True), sink)
    p = jnp.exp(scores - m)
    denom = jnp.sum(p, axis=-1, keepdims=True) + jnp.exp(sink - m)
    p = (p / denom).astype(v.dtype)
    out = jnp.einsum('bnhgqk,bnkhd->bnqhgd', p, vv)
    return out.reshape(b, s, ATTN_WIDTH)


def short_gated_conv(gate_b, gate_c, hc, conv_w):
    u = gate_c * hc
    up = jnp.pad(u, ((0, 0), (CONV_K - 1, 0), (0, 0)))
    s = u.shape[1]
    y = sum(conv_w[j] * up[:, j:j + s] for j in range(CONV_K))
    return gate_b * y


def swiglu(h, wg, wu, wd):
    return (jax.nn.silu(h @ wg) * (h @ wu)) @ wd


def routed_moe(h, w_router, router_bias, w_gate, w_up, w_down):
    n, d = h.shape
    scores = jax.nn.sigmoid((h @ w_router).astype(jnp.float32))
    sel = scores + router_bias.astype(jnp.float32)
    grp = sel.reshape(n, N_GROUPS, N_EXPERTS // N_GROUPS)
    gscore = jnp.sum(lax.top_k(grp, 2)[0], axis=-1)
    _, gidx = lax.top_k(gscore, TOPK_GROUPS)
    gmask = jnp.sum(jax.nn.one_hot(gidx, N_GROUPS, dtype=jnp.int32), axis=1) > 0
    emask = jnp.repeat(gmask, N_EXPERTS // N_GROUPS, axis=1)
    _, eidx = lax.top_k(jnp.where(emask, sel, -jnp.inf), TOP_K)
    w = jnp.take_along_axis(scores, eidx, axis=1)
    w = (w / jnp.sum(w, axis=-1, keepdims=True) * ROUTED_SCALE).astype(h.dtype)

    a = n * TOP_K
    flat_e = eidx.reshape(-1).astype(jnp.int32)
    flat_w = w.reshape(-1)
    order = jnp.argsort(flat_e)
    sorted_e = flat_e[order]
    counts = jnp.bincount(flat_e, length=N_EXPERTS)
    offsets = jnp.cumsum(counts) - counts
    rank = jnp.arange(a, dtype=jnp.int32) - offsets[sorted_e]
    padded = (counts + EXPERT_BLOCK - 1) // EXPERT_BLOCK * EXPERT_BLOCK
    pad_end = jnp.cumsum(padded)
    dest = (pad_end - padded)[sorted_e] + rank
    n_rows = (a + EXPERT_BLOCK - 1) // EXPERT_BLOCK * EXPERT_BLOCK + N_EXPERTS * EXPERT_BLOCK
    n_blk = n_rows // EXPERT_BLOCK
    row_tok = jnp.zeros((n_rows,), jnp.int32).at[dest].set((order // TOP_K).astype(jnp.int32))
    row_w = jnp.zeros((n_rows,), h.dtype).at[dest].set(flat_w[order])
    block_e = jnp.minimum(jnp.searchsorted(pad_end, jnp.arange(n_blk) * EXPERT_BLOCK, side='right'),
                          N_EXPERTS - 1).astype(jnp.int32)

    def expert_block(args):
        tok, wr, e = args
        xb = h[tok]
        return swiglu(xb, w_gate[e], w_up[e], w_down[e]) * wr[:, None]

    ys = lax.map(expert_block, (row_tok.reshape(n_blk, EXPERT_BLOCK),
                                row_w.reshape(n_blk, EXPERT_BLOCK), block_e))
    return jnp.zeros_like(h).at[row_tok].add(ys.reshape(n_rows, d))


def setup_inputs(seed: int = 0) -> dict:
    key = jax.random.key(seed)
    ks = jax.random.split(key, 20)
    f32 = jnp.float32
    D, L = D_MODEL, DEPTH
    nrm = lambda k, shp, s: jax.random.normal(k, shp, f32) * s
    col_scale = jnp.concatenate([
        jnp.ones((ATTN_WIDTH + KV_WIDTH,), f32), jnp.full((KV_WIDTH,), BETA, f32),
        jnp.ones((2 * CONV_WIDTH,), f32), jnp.full((CONV_WIDTH,), BETA, f32)])
    return {
        "x": jax.random.normal(ks[0], (BATCH, SEQ, D), f32),
        "c": jax.random.normal(ks[1], (BATCH, D), f32),
        "w_mod": nrm(ks[2], (L, D, 6 * D), 0.5 * D ** -0.5),
        "b_mod": nrm(ks[3], (L, 6 * D), 0.02),
        "w_in": nrm(ks[4], (L, D, IN_WIDTH), D ** -0.5) * col_scale,
        "conv_w": nrm(ks[5], (L, CONV_K, CONV_WIDTH), CONV_K ** -0.5),
        "attn_sinks": nrm(ks[6], (L, N_Q_HEADS), 0.5),
        "w_out": nrm(ks[7], (L, D, D), BETA * D ** -0.5),
        "ln1_g": 1.0 + nrm(ks[8], (L, D), 0.02),
        "ln1_b": nrm(ks[9], (L, D), 0.02),
        "w_router": nrm(ks[10], (L, D, N_EXPERTS), D ** -0.5),
        "router_bias": nrm(ks[11], (L, N_EXPERTS), 0.01),
        "w_gate": nrm(ks[12], (L, N_EXPERTS, D, D_EXPERT), BETA * D ** -0.5),
        "w_up": nrm(ks[13], (L, N_EXPERTS, D, D_EXPERT), BETA * D ** -0.5),
        "w_down": nrm(ks[14], (L, N_EXPERTS, D_EXPERT, D), BETA * D_EXPERT ** -0.5),
        "ws_gate": nrm(ks[15], (L, D, D_EXPERT), BETA * D ** -0.5),
        "ws_up": nrm(ks[16], (L, D, D_EXPERT), BETA * D ** -0.5),
        "ws_down": nrm(ks[17], (L, D_EXPERT, D), BETA * D_EXPERT ** -0.5),
        "ln2_g": 1.0 + nrm(ks[18], (L, D), 0.02),
        "ln2_b": nrm(ks[19], (L, D), 0.02),
    }


def reference(x, c, w_mod, b_mod, w_in, conv_w, attn_sinks, w_out, ln1_g, ln1_b,
              w_router, router_bias, w_gate, w_up, w_down, ws_gate, ws_up, ws_down,
              ln2_g, ln2_b):
    b, s, d = x.shape
    cs = jax.nn.silu(c)
    splits = [ATTN_WIDTH, ATTN_WIDTH + KV_WIDTH, ATTN_WIDTH + 2 * KV_WIDTH,
              ATTN_WIDTH + 2 * KV_WIDTH + CONV_WIDTH, ATTN_WIDTH + 2 * KV_WIDTH + 2 * CONV_WIDTH]
    for l in range(DEPTH):
        mod = (cs @ w_mod[l] + b_mod[l])[:, None, :]
        sh1, sc1, g1, sh2, sc2, g2 = jnp.split(mod, 6, axis=-1)
        h = x * (1.0 + sc1) + sh1
        proj = h @ w_in[l]
        q, k, v, cb, cc, ch = jnp.split(proj, splits, axis=-1)
        attn = swa_sink_attention(q.reshape(b, s, N_Q_HEADS, HEAD_DIM),
                                  k.reshape(b, s, N_KV_HEADS, HEAD_DIM),
                                  v.reshape(b, s, N_KV_HEADS, HEAD_DIM), attn_sinks[l])
        conv = short_gated_conv(cb, cc, ch, conv_w[l])
        mix = jnp.concatenate([attn, conv], axis=-1) @ w_out[l]
        x = layer_norm(ALPHA * x + (1.0 + g1) * mix, ln1_g[l], ln1_b[l])
        h = (x * (1.0 + sc2) + sh2).reshape(b * s, d)
        ffn = routed_moe(h, w_router[l], router_bias[l], w_gate[l], w_up[l], w_down[l]) \
            + swiglu(h, ws_gate[l], ws_up[l], ws_down[l])
        x = layer_norm(ALPHA * x + (1.0 + g2) * ffn.reshape(b, s, d), ln2_g[l], ln2_b[l])
    return x
```

```cpp
#include <hip/hip_runtime.h>
#include <cstdio>
#include <cstdint>
#include <cmath>
namespace pg8 {
#define PG8_LAS __attribute__((address_space(3)))
typedef unsigned short bf16_t;
typedef short bf16x8 __attribute__((ext_vector_type(8)));
typedef float f32x4 __attribute__((ext_vector_type(4)));
typedef unsigned u32x4 __attribute__((ext_vector_type(4)));
constexpr int BM = 256, BK = 64, HALF = 128, HTB = HALF * BK * 2  , STAGE_BYTES = 8 * HTB, NXCD = 8, WGM = 8;

__host__ __device__ __forceinline__ int lds_byte(int r, int c) { const int st = (r >> 4) * 2 + (c >> 5), rr = r & 15, cc = c & 31, ob = rr * 64 + cc * 2; return st * 1024 + (ob ^ (((ob >> 9) & 1) << 5)); }
__host__ __device__ __forceinline__ void stage_rc(int b, int& R, int& C) { const int st = b / 1024, sb = b % 1024, swz = sb ^ (((sb >> 9) & 1) << 5); R = (st >> 1) * 16 + swz / 64; C = (st & 1) * 32 + (swz % 64) / 2; }
__host__ __device__ __forceinline__ int perm32(int rho) { const int n = rho >> 4, i = rho & 15; return 8 * (i >> 2) + 4 * n + (i & 3); }

struct Unit { int pm, pn; };
struct Gemm { const bf16_t* A; const bf16_t* Bt; int M, N, K; };

struct StaticOrder {
    int nM, nN, nwg, G, c;
    __host__ __device__ void init(int M, int N, int G_, int c_) { nM = M / BM; nN = N / BM; nwg = nM * nN; G = G_; c = c_; }
    __host__ __device__ bool next(int i, Unit& u) const {
        const long L = (long)i * G + c; if (L >= nwg) return false;
        int wgid = (int)L; { const int q = nwg / NXCD, r = nwg % NXCD, xcd = wgid % NXCD, off = wgid / NXCD; wgid = (xcd < r ? xcd * (q + 1) : r * (q + 1) + (xcd - r) * q) + off; }
        const int nig = WGM * nN, gid = wgid / nig, fm = gid * WGM, gsz = (nM - fm) < WGM ? (nM - fm) : WGM;
        u.pm = fm + ((wgid % nig) % gsz); u.pn = (wgid % nig) / gsz; return true;
    }
    __device__ __forceinline__ void a_ready(const Unit&) const {}
    __device__ __forceinline__ void done(const Unit&) const {}
};

__device__ __forceinline__ unsigned cvt_pk_bf16(float lo, float hi) { unsigned r; asm volatile("v_cvt_pk_bf16_f32 %0, %1, %2" : "=v"(r) : "v"(lo), "v"(hi)); return r; }
typedef float f32x2 __attribute__((ext_vector_type(2)));
__device__ __forceinline__ f32x2 gelu_pk(f32x2 v) {
    const f32x2 av = __builtin_elementwise_abs(v), d = av * 0.2316418882f + 1.0f;
    f32x2 t; t.x = __builtin_amdgcn_rcpf(d.x); t.y = __builtin_amdgcn_rcpf(d.y);
    f32x2 q = t * 0.5307027145f + (-0.7265760135f); q = q * t + 0.7107068705f; q = q * t + (-0.142248368f); q = q * t + 0.127414796f; q = q * t;
    const f32x2 s = (v * v) * (-0.72134752044f);
    f32x2 e; e.x = __builtin_amdgcn_exp2f(s.x); e.y = __builtin_amdgcn_exp2f(s.y);
    const f32x2 m = v * (q * e), r = v - m;
    f32x2 o; o.x = v.x < 0.f ? m.x : r.x; o.y = v.y < 0.f ? m.y : r.y; return o;
}

template <int ACT  > struct EpiBf16 {
    static constexpr bool PERM = true, AFTER_DRAIN = false; static_assert(ACT == 0 || ACT == 1, "EpiBf16: ACT is 0 (none) or 1 (gelu_pk)");
    bf16_t* O; int ldc; const float* bias; int split_cols; size_t split_stride; float scale0;
    __device__ __forceinline__ void operator()(const f32x4 (&acc)[2][2][4][2], const Unit& u, int wr, int wc, int fr, int fq) const {
        const int row0 = u.pm * BM + wr * 64 + fr; int colt = u.pn * BM; bf16_t* base = O;
        float sc = 1.f; if (split_cols) { const int t = colt / split_cols; base += (size_t)t * split_stride; colt -= t * split_cols; if (t == 0) sc = scale0; }
        const int col0 = colt + wc * 32 + 8 * fq, bcol0 = u.pn * BM + wc * 32 + 8 * fq;
        f32x4 bv[2][2];
#pragma unroll
        for (int bj = 0; bj < 2; ++bj)
#pragma unroll
            for (int n = 0; n < 2; ++n) bv[bj][n] = bias ? *(const f32x4*)(bias + bcol0 + bj * HALF + 4 * n) : (f32x4){0.f, 0.f, 0.f, 0.f};
#pragma unroll
        for (int ai = 0; ai < 2; ++ai)
#pragma unroll
            for (int m = 0; m < 4; ++m) { bf16_t* rowp = base + (size_t)(row0 + ai * HALF + m * 16) * ldc + col0;
#pragma unroll
                for (int bj = 0; bj < 2; ++bj) { f32x4 v0 = acc[ai][bj][m][0] + bv[bj][0], v1 = acc[ai][bj][m][1] + bv[bj][1];
                    if (ACT == 1) { f32x2 a = gelu_pk((f32x2){v0[0], v0[1]}), b = gelu_pk((f32x2){v0[2], v0[3]}), c = gelu_pk((f32x2){v1[0], v1[1]}), d = gelu_pk((f32x2){v1[2], v1[3]});
                        v0 = (f32x4){a.x, a.y, b.x, b.y}; v1 = (f32x4){c.x, c.y, d.x, d.y}; }
                    v0 = v0 * sc; v1 = v1 * sc; u32x4 w; w.x = cvt_pk_bf16(v0[0], v0[1]); w.y = cvt_pk_bf16(v0[2], v0[3]); w.z = cvt_pk_bf16(v1[0], v1[1]); w.w = cvt_pk_bf16(v1[2], v1[3]);
                    *(u32x4*)(rowp + bj * HALF) = w; } }
    }
};

__device__ __forceinline__ float silu_f(float g) { return g * __builtin_amdgcn_rcpf(1.0f + __builtin_amdgcn_exp2f(-1.4426950408889634f * g)); }
struct EpiResF32 {
    static constexpr bool PERM = false, AFTER_DRAIN = false;
    const float* x; float* y; const float* gate; int ldc; int rows_per_batch; int gate_stride; float alpha;
    __device__ __forceinline__ void operator()(const f32x4 (&acc)[2][2][4][2], const Unit& u, int wr, int wc, int fr, int fq) const {
        const int row0 = u.pm * BM + wr * 64 + fr, col0 = u.pn * BM + wc * 32 + 4 * fq;
        const float* gp = gate + (size_t)((u.pm * BM) / rows_per_batch) * gate_stride + col0;
        f32x4 gv[2][2];
#pragma unroll
        for (int bj = 0; bj < 2; ++bj)
#pragma unroll
            for (int n = 0; n < 2; ++n) gv[bj][n] = *(const f32x4*)(gp + bj * HALF + n * 16) + 1.0f;
#pragma unroll
        for (int ai = 0; ai < 2; ++ai)
#pragma unroll
            for (int m = 0; m < 4; ++m) { const size_t off = (size_t)(row0 + ai * HALF + m * 16) * ldc + col0;
#pragma unroll
                for (int bj = 0; bj < 2; ++bj)
#pragma unroll
                    for (int n = 0; n < 2; ++n) { const f32x4 xv = *(const f32x4*)(x + off + bj * HALF + n * 16);
                        *(f32x4*)(y + off + bj * HALF + n * 16) = xv * alpha + gv[bj][n] * acc[ai][bj][m][n]; } }
    }
};
struct EpiSwiGLU {
    static constexpr bool PERM = true, AFTER_DRAIN = false;
    bf16_t* H; int ldh; int npn;
    __device__ __forceinline__ void operator()(const f32x4 (&acc)[2][2][4][2], const Unit& u, int wr, int wc, int fr, int fq) const {
        const int row0 = u.pm * BM + wr * 64 + fr, col0 = (u.pn % npn) * HALF + wc * 32 + 8 * fq;
#pragma unroll
        for (int ai = 0; ai < 2; ++ai)
#pragma unroll
            for (int m = 0; m < 4; ++m) { bf16_t* rowp = H + (size_t)(row0 + ai * HALF + m * 16) * ldh + col0;
                const f32x4 g0 = acc[ai][0][m][0], g1 = acc[ai][0][m][1], u0 = acc[ai][1][m][0], u1 = acc[ai][1][m][1];
                u32x4 w; w.x = cvt_pk_bf16(silu_f(g0[0]) * u0[0], silu_f(g0[1]) * u0[1]); w.y = cvt_pk_bf16(silu_f(g0[2]) * u0[2], silu_f(g0[3]) * u0[3]);
                w.z = cvt_pk_bf16(silu_f(g1[0]) * u1[0], silu_f(g1[1]) * u1[1]); w.w = cvt_pk_bf16(silu_f(g1[2]) * u1[2], silu_f(g1[3]) * u1[3]);
                *(u32x4*)rowp = w; }
    }
};
struct EpiDown {
    static constexpr bool PERM = true, AFTER_DRAIN = false;
    bf16_t* Y; const float* wrow; int ldc; int npn;
    __device__ __forceinline__ void operator()(const f32x4 (&acc)[2][2][4][2], const Unit& u, int wr, int wc, int fr, int fq) const {
        const int row0 = u.pm * BM + wr * 64 + fr, col0 = (u.pn % npn) * BM + wc * 32 + 8 * fq;
#pragma unroll
        for (int ai = 0; ai < 2; ++ai)
#pragma unroll
            for (int m = 0; m < 4; ++m) { const int r = row0 + ai * HALF + m * 16; const float w8 = wrow[r]; bf16_t* rowp = Y + (size_t)r * ldc + col0;
#pragma unroll
                for (int bj = 0; bj < 2; ++bj) { const f32x4 v0 = acc[ai][bj][m][0] * w8, v1 = acc[ai][bj][m][1] * w8;
                    u32x4 w; w.x = cvt_pk_bf16(v0[0], v0[1]); w.y = cvt_pk_bf16(v0[2], v0[3]); w.z = cvt_pk_bf16(v1[0], v1[1]); w.w = cvt_pk_bf16(v1[2], v1[3]);
                    *(u32x4*)(rowp + bj * HALF) = w; } }
    }
};
struct GroupedOrder {
    const PG8_LAS unsigned short* tslot; int ntiles, npn, G, c;
    __device__ __forceinline__ bool next(int i, Unit& u) const {
        const int L = i * G + c; if (L >= ntiles * npn) return false;
        const int t = L / npn, p = L - t * npn; u.pm = t; u.pn = (int)tslot[t] * npn + p; return true;
    }
    __device__ __forceinline__ void a_ready(const Unit&) const {}
    __device__ __forceinline__ void done(const Unit&) const {}
};


template <class Epi, class Sched, bool ALIGN_EPI = false, bool SP2 = false>
__device__ __forceinline__ void gemm_phase(PG8_LAS unsigned char* lds, const Gemm g, const Sched& S, const Epi& E) {
    const int tid = threadIdx.x, wid = __builtin_amdgcn_readfirstlane(tid >> 6), lane = tid & 63, wr = wid >> 2, wc = wid & 3, fr = lane & 15, fq = lane >> 4;
    const int K = g.K, nt = K / BK;
    unsigned voffA[2], voffB[2];
#pragma unroll
    for (int i = 0; i < 2; ++i) { int R, C; stage_rc(tid * 16 + i * 8192, R, C); const int Rb = Epi::PERM ? ((R & ~31) + perm32(R & 31)) : R;
        voffA[i] = (unsigned)(R * K + C) * 2u; voffB[i] = (unsigned)(Rb * K + C) * 2u; }
    const size_t kstep = (size_t)(BK * 2);
    const size_t hstep = (size_t)HALF * K * 2;
    const size_t tstep = 2 * hstep;
    const unsigned ldsw = (unsigned)wid * 1024u;
    const int aoff = lds_byte(wr * 64 + fr, fq * 8), boff = lds_byte(wc * 32 + fr, fq * 8);
#define PG8_SA(b, h) (((b) * 2 + (h)) * HTB)
#define PG8_SB(b, h) ((4 + (b) * 2 + (h)) * HTB)
#define PG8_STAGE(bufoff, gbase, voff) do { _Pragma("unroll") for (int _i = 0; _i < 2; ++_i) \
        __builtin_amdgcn_global_load_lds((const unsigned*)((const char*)(gbase) + (voff)[_i]), (PG8_LAS unsigned*)(lds + (bufoff) + ldsw + _i * 8192), 16, 0, 0); } while (0)
#define PG8_LDA(dst, b, h) do { _Pragma("unroll") for (int m = 0; m < 4; ++m) _Pragma("unroll") for (int k = 0; k < 2; ++k) dst[m][k] = *(const PG8_LAS bf16x8*)(lds + PG8_SA(b, h) + aoff + m * 2048 + k * 1024); } while (0)
#define PG8_LDB(dst, b, h) do { _Pragma("unroll") for (int n = 0; n < 2; ++n) _Pragma("unroll") for (int k = 0; k < 2; ++k) dst[n][k] = *(const PG8_LAS bf16x8*)(lds + PG8_SB(b, h) + boff + n * 2048 + k * 1024); } while (0)
#define PG8_MMA(ai, bj, At, Bt) do { __builtin_amdgcn_s_setprio(1); _Pragma("unroll") for (int m = 0; m < 4; ++m) _Pragma("unroll") for (int n = 0; n < 2; ++n) _Pragma("unroll") for (int k = 0; k < 2; ++k) \
        acc[ai][bj][m][n] = __builtin_amdgcn_mfma_f32_16x16x32_bf16(Bt[n][k], At[m][k], acc[ai][bj][m][n], 0, 0, 0); __builtin_amdgcn_s_setprio(0); } while (0)
#define PG8_WAIT_V(n) asm volatile("s_waitcnt vmcnt(" #n ")" ::: "memory")
#define PG8_WAIT_L(n) asm volatile("s_waitcnt lgkmcnt(" #n ")" ::: "memory")
#define PG8_BAR __builtin_amdgcn_s_barrier()
#define PG8_SCHED __builtin_amdgcn_sched_barrier(0)
    Unit cur, nxt; int ui = 0;
    if (!S.next(0, cur)) return;
    f32x4 acc[2][2][4][2];
#pragma unroll
    for (int a = 0; a < 2; ++a)
#pragma unroll
        for (int b = 0; b < 2; ++b)
#pragma unroll
            for (int m = 0; m < 4; ++m)
#pragma unroll
                for (int n = 0; n < 2; ++n) acc[a][b][m][n] = (f32x4){0.f, 0.f, 0.f, 0.f};
    bf16x8 At[4][2], B0[2][2], B1[2][2];
    const char* cA = (const char*)g.A + (size_t)cur.pm * tstep; const char* cB = (const char*)g.Bt + (size_t)cur.pn * tstep;
    S.a_ready(cur);
    if constexpr (SP2) {
        PG8_STAGE(PG8_SB(0, 0), cB, voffB); PG8_STAGE(PG8_SB(0, 1), cB + hstep, voffB); PG8_STAGE(PG8_SA(0, 0), cA, voffA); PG8_STAGE(PG8_SA(0, 1), cA + hstep, voffA);
        if (wr == 1) PG8_BAR;
        PG8_WAIT_V(2); PG8_BAR;
        PG8_STAGE(PG8_SB(1, 0), cB + kstep, voffB); PG8_STAGE(PG8_SA(1, 0), cA + kstep, voffA); PG8_STAGE(PG8_SB(1, 1), cB + hstep + kstep, voffB);
        PG8_WAIT_V(6); PG8_BAR;
    } else {
        PG8_STAGE(PG8_SB(0, 0), cB, voffB); PG8_STAGE(PG8_SA(0, 0), cA, voffA); PG8_STAGE(PG8_SB(0, 1), cB + hstep, voffB); PG8_STAGE(PG8_SA(0, 1), cA + hstep, voffA);
        if (wr == 1) PG8_BAR;
        PG8_WAIT_V(4); PG8_BAR;
        PG8_STAGE(PG8_SB(1, 0), cB + kstep, voffB); PG8_STAGE(PG8_SA(1, 0), cA + kstep, voffA); PG8_STAGE(PG8_SB(1, 1), cB + hstep + kstep, voffB);
        PG8_WAIT_V(6); PG8_BAR;
    }
    for (;;) {
        const bool has_next = S.next(ui + 1, nxt);
        const char* nA = has_next ? (const char*)g.A + (size_t)nxt.pm * tstep : cA; const char* nB = has_next ? (const char*)g.Bt + (size_t)nxt.pn * tstep : cB;
        for (int t = 0; t < nt; t += 2) {
            const bool last = (t == nt - 2);
            const char* a1 = cA + (size_t)(t + 1) * kstep;
            const char* a2 = last ? nA : cA + (size_t)(t + 2) * kstep; const char* b2 = last ? nB : cB + (size_t)(t + 2) * kstep;
            const char* a3 = a2 + kstep; const char* b3 = b2 + kstep;
            if (last && has_next) S.a_ready(nxt);
            if constexpr (SP2) {
            PG8_LDB(B0, 0, 0); PG8_LDB(B1, 0, 1); PG8_SCHED; PG8_LDA(At, 0, 0); PG8_STAGE(PG8_SA(1, 1), a1 + hstep, voffA);
            PG8_WAIT_V(8); PG8_WAIT_L(0); PG8_BAR; PG8_MMA(0, 0, At, B0); PG8_MMA(0, 1, At, B1); PG8_BAR; PG8_SCHED;
            PG8_LDA(At, 0, 1); PG8_STAGE(PG8_SB(0, 0), b2, voffB); PG8_STAGE(PG8_SB(0, 1), b2 + hstep, voffB); PG8_STAGE(PG8_SA(0, 0), a2, voffA);
            PG8_WAIT_V(8); PG8_WAIT_L(0); PG8_BAR; PG8_MMA(1, 0, At, B0); PG8_MMA(1, 1, At, B1); PG8_BAR; PG8_SCHED;
            PG8_LDB(B0, 1, 0); PG8_LDB(B1, 1, 1); PG8_SCHED; PG8_LDA(At, 1, 0); PG8_STAGE(PG8_SA(0, 1), a2 + hstep, voffA);
            PG8_WAIT_V(8); PG8_WAIT_L(0); PG8_BAR; PG8_MMA(0, 0, At, B0); PG8_MMA(0, 1, At, B1); PG8_BAR; PG8_SCHED;
            PG8_LDA(At, 1, 1); PG8_STAGE(PG8_SB(1, 0), b3, voffB); PG8_STAGE(PG8_SB(1, 1), b3 + hstep, voffB); PG8_STAGE(PG8_SA(1, 0), a3, voffA);
            PG8_WAIT_V(8); PG8_WAIT_L(0); PG8_BAR; PG8_MMA(1, 0, At, B0); PG8_MMA(1, 1, At, B1); PG8_BAR; PG8_SCHED;
            } else {
            PG8_LDB(B0, 0, 0); PG8_SCHED; PG8_LDA(At, 0, 0); PG8_STAGE(PG8_SA(1, 1), a1 + hstep, voffA);
            PG8_WAIT_L(8); PG8_BAR; PG8_WAIT_L(0); PG8_MMA(0, 0, At, B0); PG8_BAR; PG8_SCHED;
            PG8_LDB(B1, 0, 1); PG8_STAGE(PG8_SB(0, 0), b2, voffB);
            PG8_BAR; PG8_WAIT_L(0); PG8_MMA(0, 1, At, B1); PG8_BAR;
            PG8_LDA(At, 0, 1); PG8_STAGE(PG8_SA(0, 0), a2, voffA);
            PG8_BAR; PG8_WAIT_L(0); PG8_MMA(1, 0, At, B0); PG8_BAR; PG8_SCHED;
            PG8_STAGE(PG8_SB(0, 1), b2 + hstep, voffB);
            PG8_WAIT_V(6); PG8_BAR; PG8_MMA(1, 1, At, B1); PG8_BAR;
            PG8_LDB(B0, 1, 0); PG8_SCHED; PG8_LDA(At, 1, 0); PG8_STAGE(PG8_SA(0, 1), a2 + hstep, voffA);
            PG8_WAIT_L(8); PG8_BAR; PG8_WAIT_L(0); PG8_MMA(0, 0, At, B0); PG8_BAR; PG8_SCHED;
            PG8_LDB(B1, 1, 1); PG8_STAGE(PG8_SB(1, 0), b3, voffB);
            PG8_BAR; PG8_WAIT_L(0); PG8_MMA(0, 1, At, B1); PG8_BAR;
            PG8_LDA(At, 1, 1); PG8_STAGE(PG8_SA(1, 0), a3, voffA);
            PG8_BAR; PG8_WAIT_L(0); PG8_MMA(1, 0, At, B0); PG8_BAR; PG8_SCHED;
            PG8_STAGE(PG8_SB(1, 1), b3 + hstep, voffB);
            PG8_WAIT_V(6); PG8_BAR; PG8_MMA(1, 1, At, B1); PG8_BAR;
            }
        }
        if constexpr (ALIGN_EPI) { if (wr == 0) PG8_BAR; }
        if constexpr (!Epi::AFTER_DRAIN) { E(acc, cur, wr, wc, fr, fq); S.done(cur); }
        if (!has_next) break;
#pragma unroll
        for (int a = 0; a < 2; ++a)
#pragma unroll
            for (int b = 0; b < 2; ++b)
#pragma unroll
                for (int m = 0; m < 4; ++m)
#pragma unroll
                    for (int n = 0; n < 2; ++n) acc[a][b][m][n] = (f32x4){0.f, 0.f, 0.f, 0.f};
        cur = nxt; cA = nA; cB = nB; ++ui;
        if constexpr (ALIGN_EPI) { if (wr == 1) PG8_BAR; }
    }
    PG8_WAIT_V(0);
    if constexpr (!ALIGN_EPI) { if (wr == 0) PG8_BAR; }
    PG8_BAR;
    if constexpr (Epi::AFTER_DRAIN) { E.fused(acc, cur, wr, wc, fr, fq, lds, wid, lane); S.done(cur); }
#undef PG8_SA
#undef PG8_SB
#undef PG8_STAGE
#undef PG8_LDA
#undef PG8_LDB
#undef PG8_MMA
#undef PG8_WAIT_V
#undef PG8_WAIT_L
#undef PG8_BAR
#undef PG8_SCHED
}
}

#ifndef PG8_SP2
#define PG8_SP2 true
#endif
#ifndef PG8_ALIGN
#define PG8_ALIGN true
#endif
#ifndef MK_PER_PHASE
#define MK_PER_PHASE 0
#endif

constexpr int NB = 2, SEQ = 4096, D = 2048, M = NB * SEQ;
constexpr int AW = 1024, NQH = 16, NKVH = 4, HD = 64, KVW = 256, CW = 1024, INW = 4608;
constexpr int COL_K = 1024, COL_V = 1280, COL_CB = 1536, COL_CC = 2560, COL_CH = 3584;
constexpr int NE = 64, TOPK = 8, DE = 512, NSLOT = NE + 1;
constexpr int MAXT = 32 + 256 + 64, MAXR = MAXT * 256;
constexpr float ALPHA = 1.189207115002721f;
constexpr float LN_EPS = 1e-5f, RSCALE = 2.5f;
constexpr int NWAVES = 8, NTHR = 512;
constexpr int KSL = 8;

constexpr size_t MiB = 1u << 20;
constexpr size_t WS_CTL = 0, CTL_ZERO_BYTES = 1 * MiB;
constexpr size_t WS_PART = 1 * MiB;
constexpr size_t WS_MODF = 2 * MiB;
constexpr size_t WS_WRT = 3 * MiB;
constexpr size_t WS_ROWTOK = 4 * MiB;
constexpr size_t WS_ROWW = 6 * MiB;
constexpr size_t WS_TOKSLOT = 8 * MiB;
constexpr size_t WS_WROW = 9 * MiB;
constexpr size_t WS_WINT = 10 * MiB;
constexpr size_t WS_WOUTT = 28 * MiB;
constexpr size_t WS_WGUT = 36 * MiB;
constexpr size_t WS_WDT = 296 * MiB;
constexpr size_t WS_X1 = 426 * MiB;
constexpr size_t WS_H = 490 * MiB;
constexpr size_t WS_XG = 578 * MiB;
constexpr size_t WS_HB = 610 * MiB;
constexpr size_t WS_PROJ = 642 * MiB;
constexpr size_t WS_MIX = 714 * MiB;
constexpr size_t WS_Y1 = 746 * MiB;
constexpr size_t WS_END = 930 * MiB;
static_assert(WS_XG + (size_t)MAXR * D * 2 <= WS_END && WS_H + (size_t)MAXR * DE * 2 <= WS_XG && WS_Y1 + (size_t)M * D * 4 <= WS_END, "ws map");
static_assert(WS_WGUT + (size_t)NSLOT * 1024 * D * 2 <= WS_WDT && WS_WDT + (size_t)NSLOT * D * DE * 2 <= WS_X1 && WS_X1 + (size_t)M * D * 4 <= WS_H, "ws map 2");
constexpr int CW_TMO = 0;
constexpr int CW_BAR = 4096;
constexpr int CW_CNT = 16384;

constexpr int RING_OFF = 0, RING_BYTES = 131072;
constexpr int LDSCTL_OFF = RING_BYTES, MISC_OFF = LDSCTL_OFF + 320;
constexpr int TS_OFF = LDSCTL_OFF + 512;
constexpr int POFF_OFF = LDSCTL_OFF + 1280;
constexpr int LDS_BYTES = 147456;

#define GAS __attribute__((address_space(1)))
#define LAS __attribute__((address_space(3)))
typedef unsigned short bf16;
typedef unsigned v4u __attribute__((ext_vector_type(4)));
typedef unsigned v2u __attribute__((ext_vector_type(2)));
typedef float f32x4 __attribute__((ext_vector_type(4)));
typedef short bf16x8 __attribute__((ext_vector_type(8)));
typedef GAS unsigned gu32;
#define RLX_AGENT __ATOMIC_RELAXED, __HIP_MEMORY_SCOPE_AGENT
#define LDS_WAIT() asm volatile("s_waitcnt lgkmcnt(0)" ::: "memory")
#define VM_WAIT() asm volatile("s_waitcnt vmcnt(0)" ::: "memory")
__device__ __forceinline__ unsigned f2bf(float f) { unsigned u = __builtin_bit_cast(unsigned, f); return (u + 0x7fffu + ((u >> 16) & 1u)) >> 16; }
__device__ __forceinline__ unsigned pk2(float lo, float hi) { return f2bf(lo) | (f2bf(hi) << 16); }
__device__ __forceinline__ float bf2f(unsigned h) { return __builtin_bit_cast(float, h << 16); }
__device__ __forceinline__ float bflo(unsigned w) { return __builtin_bit_cast(float, w << 16); }
__device__ __forceinline__ float bfhi(unsigned w) { return __builtin_bit_cast(float, w & 0xffff0000u); }

#define XB_TMO      128
#define XB_XCNT(j)  (256  + 64 * (j))
#define XB_XSUB(j)  (1280 + 64 * (j))
#define XB_XGEN(j)  (2304 + 64 * (j))
#define XB_TOP      3328
#define XB_TOPGEN   3392
#define XCD_BAR_WORDS 3456
#define XB_SPIN_CAP (1u << 18)
__device__ __forceinline__ unsigned xb_ld(unsigned* p)              { return __hip_atomic_load(p, __ATOMIC_RELAXED, __HIP_MEMORY_SCOPE_AGENT); }
__device__ __forceinline__ unsigned xb_add(unsigned* p, unsigned v) { return __hip_atomic_fetch_add(p, v, __ATOMIC_RELAXED, __HIP_MEMORY_SCOPE_AGENT); }
__device__ __forceinline__ unsigned xb_xcc_id() { return (unsigned)__builtin_amdgcn_s_getreg((3 << 11) | 20) & 0xFu; }
#define XB_SPIN(cond, bar) do { unsigned _sp = 0; while (cond) { __builtin_amdgcn_s_sleep(1); \
    if ((++_sp & 255u) == 0u) { if (xb_ld(&(bar)[XB_TMO])) break; if (_sp > XB_SPIN_CAP) { atomicAdd(&(bar)[XB_TMO], 1u); break; } } } } while (0)
struct XcdBarrier { unsigned* bar; unsigned x; volatile LAS unsigned* st; };
__device__ __forceinline__ XcdBarrier xcd_barrier_post(unsigned* bar, volatile LAS unsigned* st) {
    XcdBarrier b; b.bar = bar; b.x = xb_xcc_id(); b.st = st;
    if (threadIdx.x == 0) (void)xb_add(&bar[XB_XCNT(b.x)], 1u);
    return b;
}
__device__ __forceinline__ void xcd_barrier_complete(unsigned* bar, unsigned x, unsigned& nloc, unsigned& nx) {
    const unsigned G = gridDim.x * gridDim.y * gridDim.z;
    unsigned sum, cnt, mine, sp = 0u;
    for (;;) {
        sum = 0u; cnt = 0u; mine = 0u;
#pragma unroll
        for (unsigned j = 0; j < 16; ++j) { const unsigned c = xb_ld(&bar[XB_XCNT(j)]); sum += c; cnt += (c > 0u) ? 1u : 0u; mine = (j == x) ? c : mine; }
        if (sum == G) break;
        __builtin_amdgcn_s_sleep(1);
        if ((++sp & 255u) == 0u) { if (xb_ld(&bar[XB_TMO])) break; if (sp > XB_SPIN_CAP) { atomicAdd(&bar[XB_TMO], 1u); break; } }
    }
    nloc = mine > 0u ? mine : 1u; nx = cnt > 0u ? cnt : 1u;
}
__device__ __forceinline__ void xcd_barrier(const XcdBarrier& b) {
    asm volatile("s_waitcnt vmcnt(0)" ::: "memory");
    __syncthreads();
    if (threadIdx.x == 0) {
        unsigned* bar = b.bar;
        __builtin_amdgcn_s_waitcnt(0);
        unsigned nloc = b.st[0], nx = b.st[1];
        if (nloc == 0u) { xcd_barrier_complete(bar, b.x, nloc, nx); b.st[0] = nloc; b.st[1] = nx; }
        const unsigned old = xb_add(&bar[XB_XSUB(b.x)], 1u);
        const unsigned gen = old / nloc;
        if (old + 1u == (gen + 1u) * nloc) {
            __builtin_amdgcn_fence(__ATOMIC_RELEASE, "agent");
            asm volatile("s_waitcnt vmcnt(0)" ::: "memory");
            const unsigned og = xb_add(&bar[XB_TOP], 1u);
            const unsigned tg = og / nx;
            if (og + 1u == (tg + 1u) * nx) xb_add(&bar[XB_TOPGEN], 1u);
            else XB_SPIN(xb_ld(&bar[XB_TOPGEN]) == tg, bar);
            __builtin_amdgcn_fence(__ATOMIC_ACQUIRE, "agent");
            xb_add(&bar[XB_XGEN(b.x)], 1u);
            asm volatile("s_waitcnt vmcnt(0)" ::: "memory");
        } else {
            XB_SPIN(xb_ld(&bar[XB_XGEN(b.x)]) == gen, bar);
            __builtin_amdgcn_fence(__ATOMIC_ACQUIRE, "agent");
            asm volatile("s_waitcnt vmcnt(0)" ::: "memory");
        }
    }
    __syncthreads();
}

struct Frame {
    LAS unsigned char* lds;
    volatile LAS unsigned* MISC;
    gu32* ctl;
    int tid, lane, wave;
    int vcu, G;
    unsigned char* ws;
    const float *x, *c, *w_mod, *b_mod, *w_in, *conv_w, *sinks, *w_out, *ln1_g, *ln1_b, *w_router, *router_bias, *w_gate, *w_up, *w_down, *ws_gate, *ws_up, *ws_down, *ln2_g, *ln2_b;
    float* out;
};
__device__ __forceinline__ float wave_sum(float v) {
#pragma unroll
    for (int o = 1; o < 64; o <<= 1) v += __shfl_xor(v, o);
    return v;
}

__device__ __forceinline__ void p0_transpose_item(const float* src, int ldw, bf16* dst, int ldt, LAS float* scr, int lane) {
#pragma unroll 8
    for (int i = 0; i < 32; ++i) { const int kk = 2 * i + (lane >> 5); scr[kk * 33 + (lane & 31)] = src[(size_t)kk * ldw + (lane & 31)]; }
    LDS_WAIT(); asm volatile("" ::: "memory");
    const int c = lane & 7;
#pragma unroll
    for (int j = 0; j < 4; ++j) { const int n = (lane >> 3) + 8 * j; const LAS float* s = scr + (8 * c) * 33 + n;
        v4u o; o.x = pk2(s[0 * 33], s[1 * 33]); o.y = pk2(s[2 * 33], s[3 * 33]); o.z = pk2(s[4 * 33], s[5 * 33]); o.w = pk2(s[6 * 33], s[7 * 33]);
        *(GAS v4u*)(dst + (size_t)n * ldt + 8 * c) = o; }
    LDS_WAIT(); asm volatile("" ::: "memory");
}
__device__ __forceinline__ void p0_transpose_item_hilo(const float* src, int ldw, bf16* dhi, bf16* dlo, int ldt, LAS float* scr, int lane) {
#pragma unroll 8
    for (int i = 0; i < 32; ++i) { const int kk = 2 * i + (lane >> 5); scr[kk * 33 + (lane & 31)] = src[(size_t)kk * ldw + (lane & 31)]; }
    LDS_WAIT(); asm volatile("" ::: "memory");
    const int c = lane & 7;
#pragma unroll
    for (int j = 0; j < 4; ++j) { const int n = (lane >> 3) + 8 * j; const LAS float* s = scr + (8 * c) * 33 + n;
        float v[8]; unsigned h[8], l[8];
#pragma unroll
        for (int q = 0; q < 8; ++q) { v[q] = s[q * 33]; h[q] = f2bf(v[q]); l[q] = f2bf(v[q] - bf2f(h[q])); }
        v4u o; o.x = h[0] | (h[1] << 16); o.y = h[2] | (h[3] << 16); o.z = h[4] | (h[5] << 16); o.w = h[6] | (h[7] << 16);
        *(GAS v4u*)(dhi + (size_t)n * ldt + 8 * c) = o;
        o.x = l[0] | (l[1] << 16); o.y = l[2] | (l[3] << 16); o.z = l[4] | (l[5] << 16); o.w = l[6] | (l[7] << 16);
        *(GAS v4u*)(dlo + (size_t)n * ldt + 8 * c) = o; }
    LDS_WAIT(); asm volatile("" ::: "memory");
}
__device__ __forceinline__ void p0_prologue(Frame& F) {
    {
        LAS float* cs = (LAS float*)(F.lds + RING_OFF);
        LAS float* red = (LAS float*)(F.lds + RING_OFF + 16384);
        for (int i = F.tid; i < NB * D; i += NTHR) { const float v = F.c[i]; cs[i] = v / (1.0f + __expf(-v)); }
        __syncthreads();
        float* part = (float*)(F.ws + WS_PART);
        for (int it = blockIdx.x; it < 48 * KSL; it += F.G) {
            const int chunk = it % 48, sl = it / 48, k0 = sl * (D / KSL) + F.wave * 32;
            const float* wp = F.w_mod + (size_t)k0 * (6 * D) + chunk * 256 + F.lane * 4;
            f32x4 a0 = {0.f, 0.f, 0.f, 0.f}, a1 = {0.f, 0.f, 0.f, 0.f};
#pragma unroll 8
            for (int k = 0; k < 32; ++k) { const f32x4 w = *(const GAS f32x4*)(wp + (size_t)k * (6 * D)); const float c0 = cs[k0 + k], c1 = cs[D + k0 + k]; a0 += w * c0; a1 += w * c1; }
            *(LAS f32x4*)(red + (F.wave * 2 + 0) * 256 + F.lane * 4) = a0;
            *(LAS f32x4*)(red + (F.wave * 2 + 1) * 256 + F.lane * 4) = a1;
            __syncthreads();
            { const int b = F.tid >> 8, col = F.tid & 255; float s = 0.f;
#pragma unroll
              for (int w = 0; w < 8; ++w) s += red[(w * 2 + b) * 256 + col];
              part[((size_t)sl * 2 + b) * (6 * D) + chunk * 256 + col] = s; }
            __syncthreads();
        }
    }
    LAS float* scr = (LAS float*)(F.lds + RING_OFF + 32768 + F.wave * 12288);
    const int gw = F.vcu * NWAVES + F.wave, NGW = F.G * NWAVES;
    constexpr int I_IN = (D / 64) * (INW / 32), I_OUT = (D / 64) * (D / 32), I_G = (D / 64) * (DE / 32), I_D = (DE / 64) * (D / 32), I_R = (D / 64) * (NE / 32);
    constexpr int NITEMS = I_IN + I_OUT + NSLOT * (2 * I_G + I_D) + I_R;
    bf16* WinT = (bf16*)(F.ws + WS_WINT); bf16* WoutT = (bf16*)(F.ws + WS_WOUTT); bf16* WguT = (bf16*)(F.ws + WS_WGUT); bf16* WdT = (bf16*)(F.ws + WS_WDT);
    bf16* WrHi = (bf16*)(F.ws + WS_WRT); bf16* WrLo = WrHi + NE * D;
    for (int it = gw; it < NITEMS; it += NGW) {
        int r = it;
        if (r < I_IN) { const int nblk = INW / 32, kb = r / nblk, nb = r % nblk; p0_transpose_item(F.w_in + (size_t)(64 * kb) * INW + 32 * nb, INW, WinT + (size_t)(32 * nb) * D + 64 * kb, D, scr, F.lane); continue; } r -= I_IN;
        if (r < I_OUT) { const int nblk = D / 32, kb = r / nblk, nb = r % nblk; p0_transpose_item(F.w_out + (size_t)(64 * kb) * D + 32 * nb, D, WoutT + (size_t)(32 * nb) * D + 64 * kb, D, scr, F.lane); continue; } r -= I_OUT;
        if (r < NSLOT * 2 * I_G) {
            const int s = r / (2 * I_G), q = r % (2 * I_G), up = q / I_G, q2 = q % I_G, nblk = DE / 32, kb = q2 / nblk, nb = q2 % nblk, n0 = 32 * nb;
            const float* W = up ? (s == 0 ? F.ws_up : F.w_up + (size_t)(s - 1) * D * DE) : (s == 0 ? F.ws_gate : F.w_gate + (size_t)(s - 1) * D * DE);
            const int drow = s * 1024 + (n0 >> 7) * 256 + up * 128 + (n0 & 127);
            p0_transpose_item(W + (size_t)(64 * kb) * DE + n0, DE, WguT + (size_t)drow * D + 64 * kb, D, scr, F.lane); continue; } r -= NSLOT * 2 * I_G;
        if (r < NSLOT * I_D) {
            const int s = r / I_D, q = r % I_D, nblk = D / 32, kb = q / nblk, nb = q % nblk;
            const float* W = (s == 0 ? F.ws_down : F.w_down + (size_t)(s - 1) * DE * D);
            p0_transpose_item(W + (size_t)(64 * kb) * D + 32 * nb, D, WdT + (size_t)(s * D + 32 * nb) * DE + 64 * kb, DE, scr, F.lane); continue; } r -= NSLOT * I_D;
        { const int nblk = NE / 32, kb = r / nblk, nb = r % nblk;
          p0_transpose_item_hilo(F.w_router + (size_t)(64 * kb) * NE + 32 * nb, NE, WrHi + (size_t)(32 * nb) * D + 64 * kb, WrLo + (size_t)(32 * nb) * D + 64 * kb, D, scr, F.lane); }
    }
}

__device__ __forceinline__ void p1a_modulate(Frame& F) {
    const float* part = (const float*)(F.ws + WS_PART); float* modf = (float*)(F.ws + WS_MODF);
    { const int idx = blockIdx.x * NTHR + F.tid;
      if (idx < NB * 6 * D) { const int b = idx / (6 * D), j = idx % (6 * D); float s = F.b_mod[j];
#pragma unroll
          for (int sl = 0; sl < KSL; ++sl) s += part[((size_t)sl * 2 + b) * (6 * D) + j];
          modf[idx] = s; } }
    LAS float* sm = (LAS float*)(F.lds + RING_OFF);
    for (int i = F.tid; i < NB * 2 * D; i += NTHR) { const int b = i / (2 * D), j = i % (2 * D); float s = F.b_mod[j];
#pragma unroll
        for (int sl = 0; sl < KSL; ++sl) s += part[((size_t)sl * 2 + b) * (6 * D) + j];
        sm[i] = s; }
    __syncthreads();
    const int gw = F.vcu * NWAVES + F.wave, NGW = F.G * NWAVES;
    bf16* hb = (bf16*)(F.ws + WS_HB);
    for (int m = gw; m < M; m += NGW) {
        const int b = m / SEQ; const GAS f32x4* xr = (const GAS f32x4*)(F.x + (size_t)m * D) + F.lane;
        const LAS f32x4* sh = (const LAS f32x4*)(sm + b * 2 * D) + F.lane; const LAS f32x4* sc = (const LAS f32x4*)(sm + b * 2 * D + D) + F.lane;
        GAS v2u* o = (GAS v2u*)(hb + (size_t)m * D) + F.lane;
#pragma unroll
        for (int j = 0; j < 8; ++j) { const f32x4 v = xr[64 * j], a = sc[64 * j], s = sh[64 * j]; const f32x4 h = v * (a + 1.0f) + s;
            v2u w; w.x = pk2(h.x, h.y); w.y = pk2(h.z, h.w); o[64 * j] = w; }
    }
}

constexpr int KS_PITCH = 144, VT_PITCH = 528, LDS_KS = 0, LDS_VT = 256 * KS_PITCH;
__device__ __forceinline__ void p2_attn_conv(Frame& F) {
    const bf16* proj = (const bf16*)(F.ws + WS_PROJ); bf16* mix = (bf16*)(F.ws + WS_MIX);
    const int fr = F.lane & 15, fq = F.lane >> 4;
    for (int unit = blockIdx.x; unit < NB * (SEQ / 128) * NKVH; unit += F.G) {
        const int hkv = unit % NKVH, nb = (unit / NKVH) % (SEQ / 128), b = unit / (NKVH * (SEQ / 128));
        const int rowbase = b * SEQ + nb * 128 - 128;
        __syncthreads();
#pragma unroll
        for (int it = 0; it < 4; ++it) {
            const int idx = F.tid + NTHR * it, j = idx >> 3, c = idx & 7;
            v4u kv = {0u, 0u, 0u, 0u};
            if (nb > 0 || j >= 128) kv = *(const GAS v4u*)(proj + (size_t)(rowbase + j) * INW + COL_K + hkv * HD + c * 8);
            *(LAS v4u*)(F.lds + LDS_KS + j * KS_PITCH + c * 16) = kv;
        }
#pragma unroll
        for (int it = 0; it < 4; ++it) {
            const int idx = F.tid + NTHR * it, j = idx & 255, c = idx >> 8;
            v4u vv = {0u, 0u, 0u, 0u};
            if (nb > 0 || j >= 128) vv = *(const GAS v4u*)(proj + (size_t)(rowbase + j) * INW + COL_V + hkv * HD + c * 8);
            LAS unsigned short* vt = (LAS unsigned short*)(F.lds + LDS_VT + (c * 8) * VT_PITCH + j * 2);
            vt[0 * (VT_PITCH / 2)] = (unsigned short)(vv.x & 0xffffu); vt[1 * (VT_PITCH / 2)] = (unsigned short)(vv.x >> 16);
            vt[2 * (VT_PITCH / 2)] = (unsigned short)(vv.y & 0xffffu); vt[3 * (VT_PITCH / 2)] = (unsigned short)(vv.y >> 16);
            vt[4 * (VT_PITCH / 2)] = (unsigned short)(vv.z & 0xffffu); vt[5 * (VT_PITCH / 2)] = (unsigned short)(vv.z >> 16);
            vt[6 * (VT_PITCH / 2)] = (unsigned short)(vv.w & 0xffffu); vt[7 * (VT_PITCH / 2)] = (unsigned short)(vv.w >> 16);
        }
        __syncthreads();
        const int g = F.wave & 3, half = F.wave >> 2, h = hkv * 4 + g;
        const float slope2 = exp2f(-0.5f * (float)(h + 1)) * 1.4426950408889634f;
        const float sink2 = F.sinks[h] * 1.4426950408889634f;
        const float qk2 = 0.125f * 1.4426950408889634f;
#pragma unroll 1
        for (int mi = 0; mi < 4; ++mi) {
            const int i = half * 4 + mi, j0 = i >> 1;
            const size_t qrow = (size_t)(b * SEQ + nb * 128 + 16 * i + fr);
            const bf16x8 q0 = *(const GAS bf16x8*)(proj + qrow * INW + h * HD + 8 * fq), q1 = *(const GAS bf16x8*)(proj + qrow * INW + h * HD + 32 + 8 * fq);
            f32x4 s[10];
#pragma unroll
            for (int x = 0; x < 10; ++x) {
                const int tt = 2 * j0 + x;
                const bf16x8 k0 = *(const LAS bf16x8*)(F.lds + LDS_KS + (16 * tt + fr) * KS_PITCH + 16 * fq), k1 = *(const LAS bf16x8*)(F.lds + LDS_KS + (16 * tt + fr) * KS_PITCH + 64 + 16 * fq);
                f32x4 a = {0.f, 0.f, 0.f, 0.f};
                a = __builtin_amdgcn_mfma_f32_16x16x32_bf16(k0, q0, a, 0, 0, 0);
                a = __builtin_amdgcn_mfma_f32_16x16x32_bf16(k1, q1, a, 0, 0, 0);
                s[x] = a;
            }
            float mx = sink2;
#pragma unroll
            for (int x = 0; x < 10; ++x) {
#pragma unroll
                for (int r = 0; r < 4; ++r) {
                    const int kj = 16 * (2 * j0 + x) + 4 * fq + r, dist = 16 * i + fr + 128 - kj;
                    const bool valid = (dist >= 0) && (dist < 128) && (nb > 0 || kj >= 128);
                    const float v = valid ? (s[x][r] * qk2 - slope2 * (float)dist) : -INFINITY;
                    s[x][r] = v; mx = fmaxf(mx, v);
                }
            }
            mx = fmaxf(mx, __shfl_xor(mx, 16)); mx = fmaxf(mx, __shfl_xor(mx, 32));
            float l = 0.f;
#pragma unroll
            for (int x = 0; x < 10; ++x) {
#pragma unroll
                for (int r = 0; r < 4; ++r) { const float p = __builtin_amdgcn_exp2f(s[x][r] - mx); s[x][r] = p; l += p; }
            }
            l += __shfl_xor(l, 16); l += __shfl_xor(l, 32);
            const float inv = 1.0f / (l + __builtin_amdgcn_exp2f(sink2 - mx));
            f32x4 o[4];
#pragma unroll
            for (int dt = 0; dt < 4; ++dt) o[dt] = (f32x4){0.f, 0.f, 0.f, 0.f};
#pragma unroll
            for (int pp = 0; pp < 5; ++pp) {
                const int tt0 = 2 * (j0 + pp);
                v4u pw; pw.x = pk2(s[2 * pp][0] * inv, s[2 * pp][1] * inv); pw.y = pk2(s[2 * pp][2] * inv, s[2 * pp][3] * inv);
                pw.z = pk2(s[2 * pp + 1][0] * inv, s[2 * pp + 1][1] * inv); pw.w = pk2(s[2 * pp + 1][2] * inv, s[2 * pp + 1][3] * inv);
                const bf16x8 pf = __builtin_bit_cast(bf16x8, pw);
#pragma unroll
                for (int dt = 0; dt < 4; ++dt) {
                    const LAS unsigned char* vp = F.lds + LDS_VT + (16 * dt + fr) * VT_PITCH + 32 * tt0 + 8 * fq;
                    const v2u lo = *(const LAS v2u*)vp, hi = *(const LAS v2u*)(vp + 32);
                    v4u vw; vw.x = lo.x; vw.y = lo.y; vw.z = hi.x; vw.w = hi.y;
                    o[dt] = __builtin_amdgcn_mfma_f32_16x16x32_bf16(__builtin_bit_cast(bf16x8, vw), pf, o[dt], 0, 0, 0);
                }
            }
#pragma unroll
            for (int dt = 0; dt < 4; ++dt) { v2u w; w.x = pk2(o[dt][0], o[dt][1]); w.y = pk2(o[dt][2], o[dt][3]);
                *(GAS v2u*)(mix + qrow * D + h * HD + 16 * dt + 4 * fq) = w; }
        }
    }
    for (int item = F.vcu * NTHR + F.tid; item < (M / 8) * (CW / 8); item += F.G * NTHR) {
        const int cch = item % (CW / 8), rb = item / (CW / 8), r0 = rb * 8, t0 = r0 % SEQ, c0 = cch * 8;
        float w0[8], w1[8], w2[8], u1[8], u2[8];
        { const f32x4 a = *(const GAS f32x4*)(F.conv_w + c0), b2 = *(const GAS f32x4*)(F.conv_w + c0 + 4);
          w0[0] = a.x; w0[1] = a.y; w0[2] = a.z; w0[3] = a.w; w0[4] = b2.x; w0[5] = b2.y; w0[6] = b2.z; w0[7] = b2.w; }
        { const f32x4 a = *(const GAS f32x4*)(F.conv_w + CW + c0), b2 = *(const GAS f32x4*)(F.conv_w + CW + c0 + 4);
          w1[0] = a.x; w1[1] = a.y; w1[2] = a.z; w1[3] = a.w; w1[4] = b2.x; w1[5] = b2.y; w1[6] = b2.z; w1[7] = b2.w; }
        { const f32x4 a = *(const GAS f32x4*)(F.conv_w + 2 * CW + c0), b2 = *(const GAS f32x4*)(F.conv_w + 2 * CW + c0 + 4);
          w2[0] = a.x; w2[1] = a.y; w2[2] = a.z; w2[3] = a.w; w2[4] = b2.x; w2[5] = b2.y; w2[6] = b2.z; w2[7] = b2.w; }
        if (t0 == 0) {
#pragma unroll
            for (int q = 0; q < 8; ++q) { u1[q] = 0.f; u2[q] = 0.f; }
        } else {
            const v4u c1 = *(const GAS v4u*)(proj + (size_t)(r0 - 1) * INW + COL_CC + c0), h1 = *(const GAS v4u*)(proj + (size_t)(r0 - 1) * INW + COL_CH + c0);
            const v4u c2 = *(const GAS v4u*)(proj + (size_t)(r0 - 2) * INW + COL_CC + c0), h2 = *(const GAS v4u*)(proj + (size_t)(r0 - 2) * INW + COL_CH + c0);
            u1[0] = bflo(c1.x) * bflo(h1.x); u1[1] = bfhi(c1.x) * bfhi(h1.x); u1[2] = bflo(c1.y) * bflo(h1.y); u1[3] = bfhi(c1.y) * bfhi(h1.y);
            u1[4] = bflo(c1.z) * bflo(h1.z); u1[5] = bfhi(c1.z) * bfhi(h1.z); u1[6] = bflo(c1.w) * bflo(h1.w); u1[7] = bfhi(c1.w) * bfhi(h1.w);
            u2[0] = bflo(c2.x) * bflo(h2.x); u2[1] = bfhi(c2.x) * bfhi(h2.x); u2[2] = bflo(c2.y) * bflo(h2.y); u2[3] = bfhi(c2.y) * bfhi(h2.y);
            u2[4] = bflo(c2.z) * bflo(h2.z); u2[5] = bfhi(c2.z) * bfhi(h2.z); u2[6] = bflo(c2.w) * bflo(h2.w); u2[7] = bfhi(c2.w) * bfhi(h2.w);
        }
#pragma unroll
        for (int rr = 0; rr < 8; ++rr) {
            const size_t ro = (size_t)(r0 + rr) * INW;
            const v4u bv = *(const GAS v4u*)(proj + ro + COL_CB + c0), cv = *(const GAS v4u*)(proj + ro + COL_CC + c0), hv = *(const GAS v4u*)(proj + ro + COL_CH + c0);
            float u0[8], cb[8], y[8];
            u0[0] = bflo(cv.x) * bflo(hv.x); u0[1] = bfhi(cv.x) * bfhi(hv.x); u0[2] = bflo(cv.y) * bflo(hv.y); u0[3] = bfhi(cv.y) * bfhi(hv.y);
            u0[4] = bflo(cv.z) * bflo(hv.z); u0[5] = bfhi(cv.z) * bfhi(hv.z); u0[6] = bflo(cv.w) * bflo(hv.w); u0[7] = bfhi(cv.w) * bfhi(hv.w);
            cb[0] = bflo(bv.x); cb[1] = bfhi(bv.x); cb[2] = bflo(bv.y); cb[3] = bfhi(bv.y); cb[4] = bflo(bv.z); cb[5] = bfhi(bv.z); cb[6] = bflo(bv.w); cb[7] = bfhi(bv.w);
#pragma unroll
            for (int q = 0; q < 8; ++q) { y[q] = cb[q] * (w0[q] * u2[q] + w1[q] * u1[q] + w2[q] * u0[q]); u2[q] = u1[q]; u1[q] = u0[q]; }
            v4u ov; ov.x = pk2(y[0], y[1]); ov.y = pk2(y[2], y[3]); ov.z = pk2(y[4], y[5]); ov.w = pk2(y[6], y[7]);
            *(GAS v4u*)(mix + (size_t)(r0 + rr) * D + AW + c0) = ov;
        }
    }
}

constexpr int P4_STAT = 0, P4_GB = 1024, P4_PART = P4_GB + 2 * D * 4, P4_END = P4_PART + 8 * 32 * 64 * 4;
static_assert(P4_END <= RING_BYTES, "P4 LDS");
__device__ __forceinline__ void p4_ln_router(Frame& F) {
    const float* y1 = (const float*)(F.ws + WS_Y1); float* x1 = (float*)(F.ws + WS_X1); bf16* xg = (bf16*)(F.ws + WS_XG);
    const float* modf = (const float*)(F.ws + WS_MODF);
    const bf16* WrHi = (const bf16*)(F.ws + WS_WRT); const bf16* WrLo = WrHi + NE * D;
    int* rowtok = (int*)(F.ws + WS_ROWTOK); float* roww = (float*)(F.ws + WS_ROWW); int* tokslot = (int*)(F.ws + WS_TOKSLOT);
    LAS float* stat = (LAS float*)(F.lds + P4_STAT); LAS float* GB = (LAS float*)(F.lds + P4_GB); LAS float* lpart = (LAS float*)(F.lds + P4_PART);
    const int fr = F.lane & 15, fq = F.lane >> 4;
    for (int unit = blockIdx.x; unit < M / 32; unit += F.G) {
        const int row0 = unit * 32, b = row0 / SEQ;
        const float* sh2 = modf + (size_t)b * 6 * D + 3 * D; const float* sc2 = modf + (size_t)b * 6 * D + 4 * D;
        __syncthreads();
        for (int k = F.tid; k < D; k += NTHR) { const float a = 1.0f + sc2[k]; GB[k] = F.ln1_g[k] * a; GB[D + k] = F.ln1_b[k] * a + sh2[k]; }
#pragma unroll 1
        for (int rr = 0; rr < 4; ++rr) {
            const int r = F.wave * 4 + rr; const size_t m = (size_t)(row0 + r);
            const GAS f32x4* yr = (const GAS f32x4*)(y1 + m * D) + F.lane;
            f32x4 v[8]; float s = 0.f;
#pragma unroll
            for (int j = 0; j < 8; ++j) { v[j] = yr[64 * j]; s += (v[j].x + v[j].y) + (v[j].z + v[j].w); }
            const float mean = wave_sum(s) * (1.f / D); float s2 = 0.f;
#pragma unroll
            for (int j = 0; j < 8; ++j) { v[j] = v[j] - mean; s2 += (v[j].x * v[j].x + v[j].y * v[j].y) + (v[j].z * v[j].z + v[j].w * v[j].w); }
            const float rstd = 1.f / sqrtf(wave_sum(s2) * (1.f / D) + LN_EPS);
            if (F.lane == 0) { stat[2 * r] = mean; stat[2 * r + 1] = rstd; }
            GAS f32x4* xo = (GAS f32x4*)(x1 + m * D) + F.lane; GAS v2u* ho = (GAS v2u*)(xg + m * D) + F.lane;
#pragma unroll
            for (int j = 0; j < 8; ++j) {
                const f32x4 g = *((const GAS f32x4*)F.ln1_g + F.lane + 64 * j), bb = *((const GAS f32x4*)F.ln1_b + F.lane + 64 * j);
                const f32x4 a = *((const GAS f32x4*)sc2 + F.lane + 64 * j), sft = *((const GAS f32x4*)sh2 + F.lane + 64 * j);
                const f32x4 xv = v[j] * rstd * g + bb; xo[64 * j] = xv;
                const f32x4 hv = xv * (a + 1.0f) + sft; v2u w; w.x = pk2(hv.x, hv.y); w.y = pk2(hv.z, hv.w); ho[64 * j] = w;
            }
        }
        __syncthreads();
        {
            f32x4 acc[2][4];
#pragma unroll
            for (int mt = 0; mt < 2; ++mt)
#pragma unroll
                for (int nt = 0; nt < 4; ++nt) acc[mt][nt] = (f32x4){0.f, 0.f, 0.f, 0.f};
            const float mu0 = stat[2 * fr], rs0 = stat[2 * fr + 1], mu1 = stat[2 * (16 + fr)], rs1 = stat[2 * (16 + fr) + 1];
#pragma unroll 1
            for (int ks = F.wave * 8; ks < F.wave * 8 + 8; ++ks) {
                const int k0 = 32 * ks + 8 * fq;
                const f32x4 g0 = *(const LAS f32x4*)(GB + k0), g1 = *(const LAS f32x4*)(GB + k0 + 4), b0 = *(const LAS f32x4*)(GB + D + k0), b1 = *(const LAS f32x4*)(GB + D + k0 + 4);
                bf16x8 whi[4], wlo[4];
#pragma unroll
                for (int nt = 0; nt < 4; ++nt) { whi[nt] = *(const GAS bf16x8*)(WrHi + (size_t)(16 * nt + fr) * D + k0); wlo[nt] = *(const GAS bf16x8*)(WrLo + (size_t)(16 * nt + fr) * D + k0); }
#pragma unroll
                for (int mt = 0; mt < 2; ++mt) {
                    const float mu = mt ? mu1 : mu0, rs = mt ? rs1 : rs0;
                    const float* yp = y1 + (size_t)(row0 + 16 * mt + fr) * D + k0;
                    const f32x4 ya = *(const GAS f32x4*)yp, yb = *(const GAS f32x4*)(yp + 4);
                    const f32x4 ha = (ya - mu) * rs * g0 + b0, hb2 = (yb - mu) * rs * g1 + b1;
                    unsigned hh[8], ll[8];
                    { const float t[8] = {ha.x, ha.y, ha.z, ha.w, hb2.x, hb2.y, hb2.z, hb2.w};
#pragma unroll
                      for (int q = 0; q < 8; ++q) { hh[q] = f2bf(t[q]); ll[q] = f2bf(t[q] - bf2f(hh[q])); } }
                    v4u ah, al; ah.x = hh[0] | (hh[1] << 16); ah.y = hh[2] | (hh[3] << 16); ah.z = hh[4] | (hh[5] << 16); ah.w = hh[6] | (hh[7] << 16);
                    al.x = ll[0] | (ll[1] << 16); al.y = ll[2] | (ll[3] << 16); al.z = ll[4] | (ll[5] << 16); al.w = ll[6] | (ll[7] << 16);
                    const bf16x8 fh = __builtin_bit_cast(bf16x8, ah), fl = __builtin_bit_cast(bf16x8, al);
#pragma unroll
                    for (int nt = 0; nt < 4; ++nt) {
                        acc[mt][nt] = __builtin_amdgcn_mfma_f32_16x16x32_bf16(fh, whi[nt], acc[mt][nt], 0, 0, 0);
                        acc[mt][nt] = __builtin_amdgcn_mfma_f32_16x16x32_bf16(fl, whi[nt], acc[mt][nt], 0, 0, 0);
                        acc[mt][nt] = __builtin_amdgcn_mfma_f32_16x16x32_bf16(fh, wlo[nt], acc[mt][nt], 0, 0, 0);
                    }
                }
            }
#pragma unroll
            for (int mt = 0; mt < 2; ++mt)
#pragma unroll
                for (int nt = 0; nt < 4; ++nt)
#pragma unroll
                    for (int r = 0; r < 4; ++r) lpart[(F.wave * 32 + 16 * mt + 4 * fq + r) * 64 + 16 * nt + fr] = acc[mt][nt][r];
        }
        __syncthreads();
#pragma unroll 1
        for (int rr = 0; rr < 4; ++rr) {
            const int r = F.wave * 4 + rr, tok = row0 + r, e = F.lane;
            float logit = 0.f;
#pragma unroll
            for (int w = 0; w < 8; ++w) logit += lpart[(w * 32 + r) * 64 + e];
            const float score = 1.0f / (1.0f + __expf(-logit));
            const float sel = score + F.router_bias[e];
            int rk = 0;
#pragma unroll
            for (int x = 1; x < 8; ++x) { const float o = __shfl_xor(sel, x); const int e2 = e ^ x; rk += (o > sel || (o == sel && e2 < e)) ? 1 : 0; }
            float gs = rk < 2 ? sel : 0.f;
            gs += __shfl_xor(gs, 1); gs += __shfl_xor(gs, 2); gs += __shfl_xor(gs, 4);
            int grk = 0; const int gi = e >> 3;
#pragma unroll
            for (int x = 1; x < 8; ++x) { const float o = __shfl_xor(gs, 8 * x); const int g2 = gi ^ x; grk += (o > gs || (o == gs && g2 < gi)) ? 1 : 0; }
            const bool gsel = grk < 4;
            const float mv = gsel ? sel : -INFINITY;
            int erk = 0;
#pragma unroll 9
            for (int x = 1; x < 64; ++x) { const float o = __shfl_xor(mv, x); const int e2 = e ^ x; erk += (o > mv || (o == mv && e2 < e)) ? 1 : 0; }
            const bool chosen = gsel && erk < TOPK;
            const float wsum = wave_sum(chosen ? score : 0.f);
            if (chosen) {
                const float w = score / wsum * RSCALE;
                const unsigned pos = __hip_atomic_fetch_add(F.ctl + CW_CNT + 64 * e, 1u, RLX_AGENT);
                rowtok[e * M + pos] = tok; roww[e * M + pos] = w; tokslot[tok * TOPK + erk] = e * M + (int)pos;
            }
        }
    }
}

__device__ __forceinline__ void build_tables(Frame& F) {
    LAS unsigned short* tslot = (LAS unsigned short*)(F.lds + TS_OFF); LAS int* poff = (LAS int*)(F.lds + POFF_OFF); LAS int* cnt = poff + 128; LAS int* nt_p = poff + 256;
    __syncthreads();
    if (F.tid < NE) cnt[F.tid] = (int)__hip_atomic_load(F.ctl + CW_CNT + 64 * F.tid, RLX_AGENT);
    __syncthreads();
    if (F.tid == 0) {
        int t = M / 256; poff[0] = 0;
        for (int i = 0; i < M / 256; ++i) tslot[i] = 0;
        for (int e = 0; e < NE; ++e) { poff[1 + e] = t * 256; int c = cnt[e]; c = c < 0 ? 0 : (c > M ? M : c); const int n = (c + 255) >> 8; for (int i = 0; i < n && t < MAXT; ++i) tslot[t++] = (unsigned short)(1 + e); }
        nt_p[0] = t;
    }
    __syncthreads();
}

__device__ __forceinline__ void p4c_gather(Frame& F) {
    build_tables(F);
    const LAS unsigned short* tslot = (const LAS unsigned short*)(F.lds + TS_OFF); const LAS int* poff = (const LAS int*)(F.lds + POFF_OFF); const LAS int* cnt = poff + 128; const int ntiles = poff[256];
    bf16* xg = (bf16*)(F.ws + WS_XG); float* wrow = (float*)(F.ws + WS_WROW);
    const int* rowtok = (const int*)(F.ws + WS_ROWTOK); const float* roww = (const float*)(F.ws + WS_ROWW);
    const int gw = F.vcu * NWAVES + F.wave, NGW = F.G * NWAVES, R = ntiles * 256;
    for (int r = gw; r < R; r += NGW) {
        if (r < M) { if (F.lane == 0) wrow[r] = 1.0f; continue; }
        const int s = tslot[r >> 8], e = s - 1, pos = r - poff[s];
        GAS v4u* dst = (GAS v4u*)(xg + (size_t)r * D) + F.lane;
        if (pos < cnt[e]) {
            const int tok = rowtok[e * M + pos]; const GAS v4u* src = (const GAS v4u*)(xg + (size_t)tok * D) + F.lane;
            const v4u a = src[0], b2 = src[64], c2 = src[128], d2 = src[192];
            dst[0] = a; dst[64] = b2; dst[128] = c2; dst[192] = d2;
            if (F.lane == 0) wrow[r] = roww[e * M + pos];
        } else {
            const v4u z = {0u, 0u, 0u, 0u}; dst[0] = z; dst[64] = z; dst[128] = z; dst[192] = z;
            if (F.lane == 0) wrow[r] = 0.f;
        }
    }
}

__device__ __forceinline__ void p7_combine(Frame& F) {
    build_tables(F);
    const LAS int* poff = (const LAS int*)(F.lds + POFF_OFF);
    const bf16* Y = (const bf16*)(F.ws + WS_XG); const float* x1 = (const float*)(F.ws + WS_X1); const float* modf = (const float*)(F.ws + WS_MODF);
    const int* tokslot = (const int*)(F.ws + WS_TOKSLOT);
    const int gw = F.vcu * NWAVES + F.wave, NGW = F.G * NWAVES;
    for (int m = gw; m < M; m += NGW) {
        const int b = m / SEQ; const float* g2 = modf + (size_t)b * 6 * D + 5 * D;
        int rows[9]; rows[0] = m;
#pragma unroll
        for (int k = 0; k < TOPK; ++k) { const int sl = tokslot[m * TOPK + k], e = sl / M, pos = sl % M; rows[1 + k] = poff[1 + e] + pos; }
        f32x4 v[8];
#pragma unroll
        for (int j = 0; j < 8; ++j) v[j] = (f32x4){0.f, 0.f, 0.f, 0.f};
#pragma unroll
        for (int k = 0; k < 9; ++k) {
            const GAS v2u* yr = (const GAS v2u*)(Y + (size_t)rows[k] * D) + F.lane;
#pragma unroll
            for (int j = 0; j < 8; ++j) { const v2u w = yr[64 * j]; v[j].x += bflo(w.x); v[j].y += bfhi(w.x); v[j].z += bflo(w.y); v[j].w += bfhi(w.y); }
        }
        const GAS f32x4* xr = (const GAS f32x4*)(x1 + (size_t)m * D) + F.lane; float s = 0.f;
#pragma unroll
        for (int j = 0; j < 8; ++j) { const f32x4 gg = *((const GAS f32x4*)g2 + F.lane + 64 * j); v[j] = xr[64 * j] * ALPHA + (gg + 1.0f) * v[j]; s += (v[j].x + v[j].y) + (v[j].z + v[j].w); }
        const float mean = wave_sum(s) * (1.f / D); float s2 = 0.f;
#pragma unroll
        for (int j = 0; j < 8; ++j) { v[j] = v[j] - mean; s2 += (v[j].x * v[j].x + v[j].y * v[j].y) + (v[j].z * v[j].z + v[j].w * v[j].w); }
        const float rstd = 1.f / sqrtf(wave_sum(s2) * (1.f / D) + LN_EPS);
        GAS f32x4* o = (GAS f32x4*)(F.out + (size_t)m * D) + F.lane;
#pragma unroll
        for (int j = 0; j < 8; ++j) { const f32x4 g = *((const GAS f32x4*)F.ln2_g + F.lane + 64 * j), bb = *((const GAS f32x4*)F.ln2_b + F.lane + 64 * j); o[64 * j] = v[j] * rstd * g + bb; }
    }
}

constexpr int NPHASE = 10;
struct Args { const float* in[20]; float* out; unsigned char* ws; int ph_lo, ph_hi; };
__global__ void __launch_bounds__(NWAVES * 64, 2) mk_fwd(Args args) {
    extern __shared__ __attribute__((aligned(16))) unsigned char lds[];
    Frame F;
    F.lds = (LAS unsigned char*)lds;
    F.MISC = (volatile LAS unsigned*)(F.lds + MISC_OFF);
    F.tid = threadIdx.x; F.lane = F.tid & 63; F.wave = __builtin_amdgcn_readfirstlane(F.tid >> 6);
    F.G = gridDim.x; { const int bx = blockIdx.x; F.vcu = (F.G % 8 == 0) ? (bx % 8) * (F.G / 8) + bx / 8 : bx; }
    F.ws = args.ws; F.ctl = (gu32*)(args.ws + WS_CTL);
    F.x = args.in[0]; F.c = args.in[1]; F.w_mod = args.in[2]; F.b_mod = args.in[3]; F.w_in = args.in[4]; F.conv_w = args.in[5]; F.sinks = args.in[6]; F.w_out = args.in[7];
    F.ln1_g = args.in[8]; F.ln1_b = args.in[9]; F.w_router = args.in[10]; F.router_bias = args.in[11]; F.w_gate = args.in[12]; F.w_up = args.in[13]; F.w_down = args.in[14];
    F.ws_gate = args.in[15]; F.ws_up = args.in[16]; F.ws_down = args.in[17]; F.ln2_g = args.in[18]; F.ln2_b = args.in[19]; F.out = args.out;
    for (int u = F.tid; u < (LDS_BYTES - LDSCTL_OFF) / 4; u += NWAVES * 64) ((LAS unsigned*)(F.lds + LDSCTL_OFF))[u] = 0u;
    __syncthreads();
    XcdBarrier bar; bar.bar = (unsigned*)(F.ctl + CW_BAR); bar.x = 0; bar.st = nullptr;
    if (!MK_PER_PHASE) bar = xcd_barrier_post((unsigned*)(F.ctl + CW_BAR), F.MISC + 8);
#define GRID_BAR() do { if (!MK_PER_PHASE) xcd_barrier(bar); } while (0)
    const int lo = args.ph_lo, hi = args.ph_hi;
#define IN(k) (lo <= (k) && (k) < hi)
#define BOTH(k) (IN(k) && IN((k) + 1))
    if (IN(0)) { p0_prologue(F); if (BOTH(0)) GRID_BAR(); }
    if (IN(1)) { p1a_modulate(F); if (BOTH(1)) GRID_BAR(); }
    if (IN(2)) {
        __syncthreads();
        pg8::Gemm g{(const pg8::bf16_t*)(F.ws + WS_HB), (const pg8::bf16_t*)(F.ws + WS_WINT), M, INW, D}; pg8::StaticOrder S; S.init(M, INW, F.G, (int)blockIdx.x);
        pg8::EpiBf16<0> E{(pg8::bf16_t*)(F.ws + WS_PROJ), INW, nullptr, 0, 0, 1.f};
        pg8::gemm_phase<pg8::EpiBf16<0>, pg8::StaticOrder, PG8_ALIGN, PG8_SP2>(F.lds + RING_OFF, g, S, E);
        if (BOTH(2)) GRID_BAR();
    }
    if (IN(3)) { p2_attn_conv(F); if (BOTH(3)) GRID_BAR(); }
    if (IN(4)) {
        __syncthreads();
        pg8::Gemm g{(const pg8::bf16_t*)(F.ws + WS_MIX), (const pg8::bf16_t*)(F.ws + WS_WOUTT), M, D, D}; pg8::StaticOrder S; S.init(M, D, F.G, (int)blockIdx.x);
        pg8::EpiResF32 E{F.x, (float*)(F.ws + WS_Y1), (const float*)(F.ws + WS_MODF) + 2 * D, D, SEQ, 6 * D, ALPHA};
        pg8::gemm_phase<pg8::EpiResF32, pg8::StaticOrder, PG8_ALIGN, PG8_SP2>(F.lds + RING_OFF, g, S, E);
        if (BOTH(4)) GRID_BAR();
    }
    if (IN(5)) { p4_ln_router(F); if (BOTH(5)) GRID_BAR(); }
    if (IN(6)) { p4c_gather(F); if (BOTH(6)) GRID_BAR(); }
    if (IN(7)) {
        build_tables(F);
        const int ntiles = ((const LAS int*)(F.lds + POFF_OFF))[256];
        pg8::Gemm g{(const pg8::bf16_t*)(F.ws + WS_XG), (const pg8::bf16_t*)(F.ws + WS_WGUT), MAXR, NSLOT * 1024, D};
        pg8::GroupedOrder S{(const PG8_LAS unsigned short*)(F.lds + TS_OFF), ntiles, 4, F.G, F.vcu};
        pg8::EpiSwiGLU E{(pg8::bf16_t*)(F.ws + WS_H), DE, 4};
        pg8::gemm_phase<pg8::EpiSwiGLU, pg8::GroupedOrder, PG8_ALIGN, PG8_SP2>(F.lds + RING_OFF, g, S, E);
        if (BOTH(7)) GRID_BAR();
    }
    if (IN(8)) {
        build_tables(F);
        const int ntiles = ((const LAS int*)(F.lds + POFF_OFF))[256];
        pg8::Gemm g{(const pg8::bf16_t*)(F.ws + WS_H), (const pg8::bf16_t*)(F.ws + WS_WDT), MAXR, NSLOT * D, DE};
        pg8::GroupedOrder S{(const PG8_LAS unsigned short*)(F.lds + TS_OFF), ntiles, 8, F.G, F.vcu};
        pg8::EpiDown E{(pg8::bf16_t*)(F.ws + WS_XG), (const float*)(F.ws + WS_WROW), D, 8};
        pg8::gemm_phase<pg8::EpiDown, pg8::GroupedOrder, PG8_ALIGN, PG8_SP2>(F.lds + RING_OFF, g, S, E);
        if (BOTH(8)) GRID_BAR();
    }
    if (IN(9)) { p7_combine(F); }
#undef IN
#undef BOTH
}

extern "C" void kernel_launch(void* const* d_in, const int* in_sizes, int n_in, void* d_out, int out_size, void* d_ws, size_t ws_size, hipStream_t stream) {
    static int grid = 0;
    if (grid == 0) {
        if (n_in != 20 || in_sizes[0] != M * D || out_size != M * D || ws_size < WS_END) { fprintf(stderr, "kernel_launch: unexpected shapes (n_in %d, in0 %d, out %d, ws %zu)\n", n_in, n_in > 0 ? in_sizes[0] : -1, out_size, ws_size); grid = -1; return; }
        int dev = 0, cus = 0, per_cu = 0;
        if (hipGetDevice(&dev) != hipSuccess || hipDeviceGetAttribute(&cus, hipDeviceAttributeMultiprocessorCount, dev) != hipSuccess) { grid = -1; return; }
        if (hipFuncSetAttribute((const void*)mk_fwd, hipFuncAttributeMaxDynamicSharedMemorySize, LDS_BYTES) != hipSuccess) { fprintf(stderr, "kernel_launch: hipFuncSetAttribute failed\n"); grid = -1; return; }
        if (hipOccupancyMaxActiveBlocksPerMultiprocessor(&per_cu, (const void*)mk_fwd, NWAVES * 64, LDS_BYTES) != hipSuccess || per_cu < 1) fprintf(stderr, "kernel_launch: occupancy query reports %d\n", per_cu);
        (void)hipGetLastError();
        grid = cus;
    }
    if (grid < 0) return;
    if (hipMemsetAsync((char*)d_ws + WS_CTL, 0, CTL_ZERO_BYTES, stream) != hipSuccess) return;
    Args a{};
    for (int i = 0; i < 20; ++i) a.in[i] = (const float*)d_in[i];
    a.out = (float*)d_out; a.ws = (unsigned char*)d_ws;
#if MK_PER_PHASE
    for (int p = 0; p < NPHASE; ++p) { a.ph_lo = p; a.ph_hi = p + 1; hipLaunchKernelGGL(mk_fwd, dim3(grid), dim3(NWAVES * 64), LDS_BYTES, stream, a); }
#else
    a.ph_lo = 0; a.ph_hi = NPHASE; hipLaunchKernelGGL(mk_fwd, dim3(grid), dim3(NWAVES * 64), LDS_BYTES, stream, a);
#endif
}
```

```cpp
#include <hip/hip_runtime.h>
#include <cstdio>
#include <cstdint>
#include <cmath>
namespace pg8 {
#define PG8_LAS __attribute__((address_space(3)))
typedef unsigned short bf16_t;
typedef short bf16x8 __attribute__((ext_vector_type(8)));
typedef float f32x4 __attribute__((ext_vector_type(4)));
typedef unsigned u32x4 __attribute__((ext_vector_type(4)));
constexpr int BM = 256, BK = 64, HALF = 128, HTB = HALF * BK * 2  , STAGE_BYTES = 8 * HTB, NXCD = 8, WGM = 8;
constexpr int VT_SLOT = STAGE_BYTES + 4096;

__host__ __device__ __forceinline__ int lds_byte(int r, int c) { const int st = (r >> 4) * 2 + (c >> 5), rr = r & 15, cc = c & 31, ob = rr * 64 + cc * 2; return st * 1024 + (ob ^ (((ob >> 9) & 1) << 5)); }
__host__ __device__ __forceinline__ void stage_rc(int b, int& R, int& C) { const int st = b / 1024, sb = b % 1024, swz = sb ^ (((sb >> 9) & 1) << 5); R = (st >> 1) * 16 + swz / 64; C = (st & 1) * 32 + (swz % 64) / 2; }
__host__ __device__ __forceinline__ int perm32(int rho) { const int n = rho >> 4, i = rho & 15; return 8 * (i >> 2) + 4 * n + (i & 3); }

struct Unit { int pm, pn; };
struct Gemm { const bf16_t* A; const bf16_t* Bt; int M, N, K; };

struct StaticOrder {
    static constexpr bool GATHER = false;
    int nM, nN, nwg, G, c;
    __host__ __device__ void init(int M, int N, int G_, int c_) { nM = M / BM; nN = N / BM; nwg = nM * nN; G = G_; c = c_; }
    __host__ __device__ bool next(int i, Unit& u) const {
        const long L = (long)i * G + c; if (L >= nwg) return false;
        int wgid = (int)L; { const int q = nwg / NXCD, r = nwg % NXCD, xcd = wgid % NXCD, off = wgid / NXCD; wgid = (xcd < r ? xcd * (q + 1) : r * (q + 1) + (xcd - r) * q) + off; }
        const int nig = WGM * nN, gid = wgid / nig, fm = gid * WGM, gsz = (nM - fm) < WGM ? (nM - fm) : WGM;
        u.pm = fm + ((wgid % nig) % gsz); u.pn = (wgid % nig) / gsz; return true;
    }
    __device__ __forceinline__ void a_ready(const Unit&) const {}
    __device__ __forceinline__ void done(const Unit&) const {}
};

__device__ __forceinline__ unsigned cvt_pk_bf16(float lo, float hi) { unsigned r; asm volatile("v_cvt_pk_bf16_f32 %0, %1, %2" : "=v"(r) : "v"(lo), "v"(hi)); return r; }
typedef float f32x2 __attribute__((ext_vector_type(2)));
__device__ __forceinline__ f32x2 gelu_pk(f32x2 v) {
    const f32x2 av = __builtin_elementwise_abs(v), d = av * 0.2316418882f + 1.0f;
    f32x2 t; t.x = __builtin_amdgcn_rcpf(d.x); t.y = __builtin_amdgcn_rcpf(d.y);
    f32x2 q = t * 0.5307027145f + (-0.7265760135f); q = q * t + 0.7107068705f; q = q * t + (-0.142248368f); q = q * t + 0.127414796f; q = q * t;
    const f32x2 s = (v * v) * (-0.72134752044f);
    f32x2 e; e.x = __builtin_amdgcn_exp2f(s.x); e.y = __builtin_amdgcn_exp2f(s.y);
    const f32x2 m = v * (q * e), r = v - m;
    f32x2 o; o.x = v.x < 0.f ? m.x : r.x; o.y = v.y < 0.f ? m.y : r.y; return o;
}

template <int ACT  > struct EpiBf16 {
    static constexpr bool PERM = true, AFTER_DRAIN = false; static_assert(ACT == 0 || ACT == 1, "EpiBf16: ACT is 0 (none) or 1 (gelu_pk)");
    bf16_t* O; int ldc; const float* bias; int split_cols; size_t split_stride; float scale0;
    __device__ __forceinline__ void operator()(const f32x4 (&acc)[2][2][4][2], const Unit& u, int wr, int wc, int fr, int fq) const {
        const int row0 = u.pm * BM + wr * 64 + fr; int colt = u.pn * BM; bf16_t* base = O;
        float sc = 1.f; if (split_cols) { const int t = colt / split_cols; base += (size_t)t * split_stride; colt -= t * split_cols; if (t == 0) sc = scale0; }
        const int col0 = colt + wc * 32 + 8 * fq, bcol0 = u.pn * BM + wc * 32 + 8 * fq;
        f32x4 bv[2][2];
#pragma unroll
        for (int bj = 0; bj < 2; ++bj)
#pragma unroll
            for (int n = 0; n < 2; ++n) bv[bj][n] = bias ? *(const f32x4*)(bias + bcol0 + bj * HALF + 4 * n) : (f32x4){0.f, 0.f, 0.f, 0.f};
#pragma unroll
        for (int ai = 0; ai < 2; ++ai)
#pragma unroll
            for (int m = 0; m < 4; ++m) { bf16_t* rowp = base + (size_t)(row0 + ai * HALF + m * 16) * ldc + col0;
#pragma unroll
                for (int bj = 0; bj < 2; ++bj) { f32x4 v0 = acc[ai][bj][m][0] + bv[bj][0], v1 = acc[ai][bj][m][1] + bv[bj][1];
                    if (ACT == 1) { f32x2 a = gelu_pk((f32x2){v0[0], v0[1]}), b = gelu_pk((f32x2){v0[2], v0[3]}), c = gelu_pk((f32x2){v1[0], v1[1]}), d = gelu_pk((f32x2){v1[2], v1[3]});
                        v0 = (f32x4){a.x, a.y, b.x, b.y}; v1 = (f32x4){c.x, c.y, d.x, d.y}; }
                    v0 = v0 * sc; v1 = v1 * sc; u32x4 w; w.x = cvt_pk_bf16(v0[0], v0[1]); w.y = cvt_pk_bf16(v0[2], v0[3]); w.z = cvt_pk_bf16(v1[0], v1[1]); w.w = cvt_pk_bf16(v1[2], v1[3]);
                    *(u32x4*)(rowp + bj * HALF) = w; } }
    }
};

__device__ __forceinline__ float silu_f(float g) { return g * __builtin_amdgcn_rcpf(1.0f + __builtin_amdgcn_exp2f(-1.4426950408889634f * g)); }
struct EpiResF32 {
    static constexpr bool PERM = false, AFTER_DRAIN = false;
    const float* x; float* y; const float* gate; int ldc; int rows_per_batch; int gate_stride; float alpha;
    __device__ __forceinline__ void operator()(const f32x4 (&acc)[2][2][4][2], const Unit& u, int wr, int wc, int fr, int fq) const {
        const int row0 = u.pm * BM + wr * 64 + fr, col0 = u.pn * BM + wc * 32 + 4 * fq;
        const float* gp = gate + (size_t)((u.pm * BM) / rows_per_batch) * gate_stride + col0;
        f32x4 gv[2][2];
#pragma unroll
        for (int bj = 0; bj < 2; ++bj)
#pragma unroll
            for (int n = 0; n < 2; ++n) gv[bj][n] = *(const f32x4*)(gp + bj * HALF + n * 16) + 1.0f;
#pragma unroll
        for (int ai = 0; ai < 2; ++ai)
#pragma unroll
            for (int m = 0; m < 4; ++m) { const size_t off = (size_t)(row0 + ai * HALF + m * 16) * ldc + col0;
#pragma unroll
                for (int bj = 0; bj < 2; ++bj)
#pragma unroll
                    for (int n = 0; n < 2; ++n) { const f32x4 xv = *(const f32x4*)(x + off + bj * HALF + n * 16);
                        *(f32x4*)(y + off + bj * HALF + n * 16) = xv * alpha + gv[bj][n] * acc[ai][bj][m][n]; } }
    }
};
struct EpiSwiGLU {
    static constexpr bool PERM = true, AFTER_DRAIN = false;
    bf16_t* H; const float* wrow; int ldh; int npn;
    __device__ __forceinline__ void operator()(const f32x4 (&acc)[2][2][4][2], const Unit& u, int wr, int wc, int fr, int fq) const {
        const int row0 = u.pm * BM + wr * 64 + fr, col0 = (u.pn % npn) * HALF + wc * 32 + 8 * fq;
#pragma unroll
        for (int ai = 0; ai < 2; ++ai)
#pragma unroll
            for (int m = 0; m < 4; ++m) { const int r = row0 + ai * HALF + m * 16; bf16_t* rowp = H + (size_t)r * ldh + col0; const float w8 = wrow[r];
                const f32x4 g0 = acc[ai][0][m][0], g1 = acc[ai][0][m][1], u0 = acc[ai][1][m][0] * w8, u1 = acc[ai][1][m][1] * w8;
                u32x4 w; w.x = cvt_pk_bf16(silu_f(g0[0]) * u0[0], silu_f(g0[1]) * u0[1]); w.y = cvt_pk_bf16(silu_f(g0[2]) * u0[2], silu_f(g0[3]) * u0[3]);
                w.z = cvt_pk_bf16(silu_f(g1[0]) * u1[0], silu_f(g1[1]) * u1[1]); w.w = cvt_pk_bf16(silu_f(g1[2]) * u1[2], silu_f(g1[3]) * u1[3]);
                *(u32x4*)rowp = w; }
    }
};
struct EpiDown {
    static constexpr bool PERM = true, AFTER_DRAIN = false;
    bf16_t* Y; int ldc; int npn;
    __device__ __forceinline__ void operator()(const f32x4 (&acc)[2][2][4][2], const Unit& u, int wr, int wc, int fr, int fq) const {
        const int row0 = u.pm * BM + wr * 64 + fr, col0 = (u.pn % npn) * BM + wc * 32 + 8 * fq;
#pragma unroll
        for (int ai = 0; ai < 2; ++ai)
#pragma unroll
            for (int m = 0; m < 4; ++m) { const int r = row0 + ai * HALF + m * 16; bf16_t* rowp = Y + (size_t)r * ldc + col0;
#pragma unroll
                for (int bj = 0; bj < 2; ++bj) { const f32x4 v0 = acc[ai][bj][m][0], v1 = acc[ai][bj][m][1];
                    u32x4 w; w.x = cvt_pk_bf16(v0[0], v0[1]); w.y = cvt_pk_bf16(v0[2], v0[3]); w.z = cvt_pk_bf16(v1[0], v1[1]); w.w = cvt_pk_bf16(v1[2], v1[3]);
                    *(u32x4*)(rowp + bj * HALF) = w; } }
    }
};
template <bool GATHER_> struct GroupedOrder {
    static constexpr bool GATHER = GATHER_;
    const PG8_LAS unsigned short* tslot; int ntiles, npn, G, c; const unsigned* vtab;
    __device__ __forceinline__ bool next(int i, Unit& u) const {
        const int L = i * G + c; if (L >= ntiles * npn) return false;
        const int t = L / npn, p = L - t * npn; u.pm = t; u.pn = (int)tslot[t] * npn + p; return true;
    }
    __device__ __forceinline__ void a_ready(const Unit&) const {}
    __device__ __forceinline__ void done(const Unit&) const {}
};


template <class Epi, class Sched, bool ALIGN_EPI = false, bool SP2 = false>
__device__ __forceinline__ void gemm_phase(PG8_LAS unsigned char* lds, const Gemm g, const Sched& S, const Epi& E) {
    const int tid = threadIdx.x, wid = __builtin_amdgcn_readfirstlane(tid >> 6), lane = tid & 63, wr = wid >> 2, wc = wid & 3, fr = lane & 15, fq = lane >> 4;
    const int K = g.K, nt = K / BK;
    unsigned voffA[2], voffA1[2], voffB[2];
#pragma unroll
    for (int i = 0; i < 2; ++i) { int R, C; stage_rc(tid * 16 + i * 8192, R, C); const int Rb = Epi::PERM ? ((R & ~31) + perm32(R & 31)) : R;
        voffA[i] = (unsigned)(R * K + C) * 2u; voffA1[i] = voffA[i] + (unsigned)(HALF * K * 2); voffB[i] = (unsigned)(Rb * K + C) * 2u; }
    const size_t kstep = (size_t)(BK * 2);
    const size_t hstep = (size_t)HALF * K * 2;
    const size_t tstep = 2 * hstep;
    const unsigned ldsw = (unsigned)wid * 1024u;
    const int aoff = lds_byte(wr * 64 + fr, fq * 8), boff = lds_byte(wc * 32 + fr, fq * 8);
#define PG8_SA(b, h) (((b) * 2 + (h)) * HTB)
#define PG8_SB(b, h) ((4 + (b) * 2 + (h)) * HTB)
#define PG8_STAGE(bufoff, gbase, voff) do { _Pragma("unroll") for (int _i = 0; _i < 2; ++_i) \
        __builtin_amdgcn_global_load_lds((const unsigned*)((const char*)(gbase) + (voff)[_i]), (PG8_LAS unsigned*)(lds + (bufoff) + ldsw + _i * 8192), 16, 0, 0); } while (0)
#define PG8_LDA(dst, b, h) do { _Pragma("unroll") for (int m = 0; m < 4; ++m) _Pragma("unroll") for (int k = 0; k < 2; ++k) dst[m][k] = *(const PG8_LAS bf16x8*)(lds + PG8_SA(b, h) + aoff + m * 2048 + k * 1024); } while (0)
#define PG8_LDB(dst, b, h) do { _Pragma("unroll") for (int n = 0; n < 2; ++n) _Pragma("unroll") for (int k = 0; k < 2; ++k) dst[n][k] = *(const PG8_LAS bf16x8*)(lds + PG8_SB(b, h) + boff + n * 2048 + k * 1024); } while (0)
#define PG8_MMA(ai, bj, At, Bt) do { __builtin_amdgcn_s_setprio(1); _Pragma("unroll") for (int m = 0; m < 4; ++m) _Pragma("unroll") for (int n = 0; n < 2; ++n) _Pragma("unroll") for (int k = 0; k < 2; ++k) \
        acc[ai][bj][m][n] = __builtin_amdgcn_mfma_f32_16x16x32_bf16(Bt[n][k], At[m][k], acc[ai][bj][m][n], 0, 0, 0); __builtin_amdgcn_s_setprio(0); } while (0)
#define PG8_WAIT_V(n) asm volatile("s_waitcnt vmcnt(" #n ")" ::: "memory")
#define PG8_WAIT_L(n) asm volatile("s_waitcnt lgkmcnt(" #n ")" ::: "memory")
#define PG8_BAR __builtin_amdgcn_s_barrier()
#define PG8_SCHED __builtin_amdgcn_sched_barrier(0)
    Unit cur, nxt; int ui = 0;
    if (!S.next(0, cur)) return;
    f32x4 acc[2][2][4][2];
#pragma unroll
    for (int a = 0; a < 2; ++a)
#pragma unroll
        for (int b = 0; b < 2; ++b)
#pragma unroll
            for (int m = 0; m < 4; ++m)
#pragma unroll
                for (int n = 0; n < 2; ++n) acc[a][b][m][n] = (f32x4){0.f, 0.f, 0.f, 0.f};
    bf16x8 At[4][2], B0[2][2], B1[2][2];
    const char* cA = Sched::GATHER ? (const char*)g.A : (const char*)g.A + (size_t)cur.pm * tstep; const char* cB = (const char*)g.Bt + (size_t)cur.pn * tstep;
    S.a_ready(cur);
    if constexpr (Sched::GATHER) {
        static_assert(SP2, "gather: SP2 loop only");
        __builtin_amdgcn_global_load_lds((const unsigned*)(S.vtab + ((size_t)0 * 512 + tid) * 4), (PG8_LAS unsigned*)(lds + VT_SLOT + wid * 1024), 16, 0, 0);
        PG8_WAIT_V(0);
        const u32x4 e4 = *(const PG8_LAS u32x4*)(lds + VT_SLOT + tid * 16); voffA[0] = e4.x; voffA[1] = e4.y; voffA1[0] = e4.z; voffA1[1] = e4.w;
    }
    if constexpr (SP2) {
        PG8_STAGE(PG8_SB(0, 0), cB, voffB); PG8_STAGE(PG8_SB(0, 1), cB + hstep, voffB); PG8_STAGE(PG8_SA(0, 0), cA, voffA); PG8_STAGE(PG8_SA(0, 1), cA, voffA1);
        if (wr == 1) PG8_BAR;
        PG8_WAIT_V(2); PG8_BAR;
        PG8_STAGE(PG8_SB(1, 0), cB + kstep, voffB); PG8_STAGE(PG8_SA(1, 0), cA + kstep, voffA); PG8_STAGE(PG8_SB(1, 1), cB + hstep + kstep, voffB);
        PG8_WAIT_V(6); PG8_BAR;
    } else {
        PG8_STAGE(PG8_SB(0, 0), cB, voffB); PG8_STAGE(PG8_SA(0, 0), cA, voffA); PG8_STAGE(PG8_SB(0, 1), cB + hstep, voffB); PG8_STAGE(PG8_SA(0, 1), cA + hstep, voffA);
        if (wr == 1) PG8_BAR;
        PG8_WAIT_V(4); PG8_BAR;
        PG8_STAGE(PG8_SB(1, 0), cB + kstep, voffB); PG8_STAGE(PG8_SA(1, 0), cA + kstep, voffA); PG8_STAGE(PG8_SB(1, 1), cB + hstep + kstep, voffB);
        PG8_WAIT_V(6); PG8_BAR;
    }
    for (;;) {
        const bool has_next = S.next(ui + 1, nxt);
        const char* nA = (has_next && !Sched::GATHER) ? (const char*)g.A + (size_t)nxt.pm * tstep : cA; const char* nB = has_next ? (const char*)g.Bt + (size_t)nxt.pn * tstep : cB;
        for (int t = 0; t < nt; t += 2) {
            const bool last = (t == nt - 2);
            const char* a1 = cA + (size_t)(t + 1) * kstep;
            const char* a2 = last ? nA : cA + (size_t)(t + 2) * kstep; const char* b2 = last ? nB : cB + (size_t)(t + 2) * kstep;
            const char* a3 = a2 + kstep; const char* b3 = b2 + kstep;
            if (last && has_next) S.a_ready(nxt);
            if constexpr (SP2) {
            if constexpr (Sched::GATHER) { if (t == 0 && has_next)
                __builtin_amdgcn_global_load_lds((const unsigned*)(S.vtab + ((size_t)(ui + 1) * 512 + tid) * 4), (PG8_LAS unsigned*)(lds + VT_SLOT + wid * 1024), 16, 0, 0); }
            PG8_LDB(B0, 0, 0); PG8_LDB(B1, 0, 1); PG8_SCHED; PG8_LDA(At, 0, 0); PG8_STAGE(PG8_SA(1, 1), a1, voffA1);
            PG8_WAIT_V(8); PG8_WAIT_L(0); PG8_BAR; PG8_MMA(0, 0, At, B0); PG8_MMA(0, 1, At, B1); PG8_BAR; PG8_SCHED;
            if constexpr (Sched::GATHER) { if (last && has_next) {
                const u32x4 e4 = *(const PG8_LAS u32x4*)(lds + VT_SLOT + tid * 16); voffA[0] = e4.x; voffA[1] = e4.y; voffA1[0] = e4.z; voffA1[1] = e4.w; } }
            PG8_LDA(At, 0, 1); PG8_STAGE(PG8_SB(0, 0), b2, voffB); PG8_STAGE(PG8_SB(0, 1), b2 + hstep, voffB); PG8_STAGE(PG8_SA(0, 0), a2, voffA);
            PG8_WAIT_V(8); PG8_WAIT_L(0); PG8_BAR; PG8_MMA(1, 0, At, B0); PG8_MMA(1, 1, At, B1); PG8_BAR; PG8_SCHED;
            PG8_LDB(B0, 1, 0); PG8_LDB(B1, 1, 1); PG8_SCHED; PG8_LDA(At, 1, 0); PG8_STAGE(PG8_SA(0, 1), a2, voffA1);
            PG8_WAIT_V(8); PG8_WAIT_L(0); PG8_BAR; PG8_MMA(0, 0, At, B0); PG8_MMA(0, 1, At, B1); PG8_BAR; PG8_SCHED;
            PG8_LDA(At, 1, 1); PG8_STAGE(PG8_SB(1, 0), b3, voffB); PG8_STAGE(PG8_SB(1, 1), b3 + hstep, voffB); PG8_STAGE(PG8_SA(1, 0), a3, voffA);
            PG8_WAIT_V(8); PG8_WAIT_L(0); PG8_BAR; PG8_MMA(1, 0, At, B0); PG8_MMA(1, 1, At, B1); PG8_BAR; PG8_SCHED;
            } else {
            PG8_LDB(B0, 0, 0); PG8_SCHED; PG8_LDA(At, 0, 0); PG8_STAGE(PG8_SA(1, 1), a1 + hstep, voffA);
            PG8_WAIT_L(8); PG8_BAR; PG8_WAIT_L(0); PG8_MMA(0, 0, At, B0); PG8_BAR; PG8_SCHED;
            PG8_LDB(B1, 0, 1); PG8_STAGE(PG8_SB(0, 0), b2, voffB);
            PG8_BAR; PG8_WAIT_L(0); PG8_MMA(0, 1, At, B1); PG8_BAR;
            PG8_LDA(At, 0, 1); PG8_STAGE(PG8_SA(0, 0), a2, voffA);
            PG8_BAR; PG8_WAIT_L(0); PG8_MMA(1, 0, At, B0); PG8_BAR; PG8_SCHED;
            PG8_STAGE(PG8_SB(0, 1), b2 + hstep, voffB);
            PG8_WAIT_V(6); PG8_BAR; PG8_MMA(1, 1, At, B1); PG8_BAR;
            PG8_LDB(B0, 1, 0); PG8_SCHED; PG8_LDA(At, 1, 0); PG8_STAGE(PG8_SA(0, 1), a2 + hstep, voffA);
            PG8_WAIT_L(8); PG8_BAR; PG8_WAIT_L(0); PG8_MMA(0, 0, At, B0); PG8_BAR; PG8_SCHED;
            PG8_LDB(B1, 1, 1); PG8_STAGE(PG8_SB(1, 0), b3, voffB);
            PG8_BAR; PG8_WAIT_L(0); PG8_MMA(0, 1, At, B1); PG8_BAR;
            PG8_LDA(At, 1, 1); PG8_STAGE(PG8_SA(1, 0), a3, voffA);
            PG8_BAR; PG8_WAIT_L(0); PG8_MMA(1, 0, At, B0); PG8_BAR; PG8_SCHED;
            PG8_STAGE(PG8_SB(1, 1), b3 + hstep, voffB);
            PG8_WAIT_V(6); PG8_BAR; PG8_MMA(1, 1, At, B1); PG8_BAR;
            }
        }
        if constexpr (ALIGN_EPI) { if (wr == 0) PG8_BAR; }
        if constexpr (!Epi::AFTER_DRAIN) { E(acc, cur, wr, wc, fr, fq); S.done(cur); }
        if (!has_next) break;
#pragma unroll
        for (int a = 0; a < 2; ++a)
#pragma unroll
            for (int b = 0; b < 2; ++b)
#pragma unroll
                for (int m = 0; m < 4; ++m)
#pragma unroll
                    for (int n = 0; n < 2; ++n) acc[a][b][m][n] = (f32x4){0.f, 0.f, 0.f, 0.f};
        cur = nxt; cA = nA; cB = nB; ++ui;
        if constexpr (ALIGN_EPI) { if (wr == 1) PG8_BAR; }
    }
    PG8_WAIT_V(0);
    if constexpr (!ALIGN_EPI) { if (wr == 0) PG8_BAR; }
    PG8_BAR;
    if constexpr (Epi::AFTER_DRAIN) { E.fused(acc, cur, wr, wc, fr, fq, lds, wid, lane); S.done(cur); }
#undef PG8_SA
#undef PG8_SB
#undef PG8_STAGE
#undef PG8_LDA
#undef PG8_LDB
#undef PG8_MMA
#undef PG8_WAIT_V
#undef PG8_WAIT_L
#undef PG8_BAR
#undef PG8_SCHED
}
}

#ifndef PG8_SP2
#define PG8_SP2 true
#endif
#ifndef PG8_ALIGN
#define PG8_ALIGN true
#endif
#ifndef REP_PHASE
#define REP_PHASE -1
#endif
#ifndef MK_PER_PHASE
#define MK_PER_PHASE 0
#endif

constexpr int NB = 2, SEQ = 4096, D = 2048, M = NB * SEQ;
constexpr int AW = 1024, NQH = 16, NKVH = 4, HD = 64, KVW = 256, CW = 1024, INW = 4608;
constexpr int COL_K = 1024, COL_V = 1280, COL_CB = 1536, COL_CC = 2560, COL_CH = 3584;
constexpr int NE = 64, TOPK = 8, DE = 512, NSLOT = NE + 1;
constexpr int MAXT = 32 + 256 + 64, MAXR = MAXT * 256;
constexpr float ALPHA = 1.189207115002721f;
constexpr float LN_EPS = 1e-5f, RSCALE = 2.5f;
constexpr int NWAVES = 8, NTHR = 512;
constexpr int KSL = 8;

constexpr size_t MiB = 1u << 20;
constexpr size_t WS_CTL = 0, CTL_ZERO_BYTES = 1 * MiB;
constexpr size_t WS_PART = 1 * MiB;
constexpr size_t WS_MODF = 2 * MiB;
constexpr size_t WS_WRT = 3 * MiB;
constexpr size_t WS_ROWTOK = 4 * MiB;
constexpr size_t WS_ROWW = 6 * MiB;
constexpr size_t WS_TOKSLOT = 8 * MiB;
constexpr size_t WS_WROW = 9 * MiB;
constexpr size_t WS_WINT = 10 * MiB;
constexpr size_t WS_WOUTT = 28 * MiB;
constexpr size_t WS_WGUT = 36 * MiB;
constexpr size_t WS_WDT = 296 * MiB;
constexpr size_t WS_X1 = 426 * MiB;
constexpr size_t WS_H = 490 * MiB;
constexpr size_t WS_XG = 578 * MiB;
constexpr size_t WS_HB = 610 * MiB;
constexpr size_t WS_PROJ = 642 * MiB;
constexpr size_t WS_MIX = 714 * MiB;
constexpr size_t WS_Y1 = 746 * MiB;
constexpr size_t WS_VTAB = 930 * MiB;
constexpr size_t WS_END = 946 * MiB;
static_assert(WS_XG + (size_t)MAXR * D * 2 <= WS_VTAB && WS_H + (size_t)MAXR * DE * 2 <= WS_XG && WS_Y1 + (size_t)M * D * 4 <= WS_VTAB, "ws map");
static_assert(WS_WGUT + (size_t)NSLOT * 1024 * D * 2 <= WS_WDT && WS_WDT + (size_t)NSLOT * D * DE * 2 <= WS_X1 && WS_X1 + (size_t)M * D * 4 <= WS_H, "ws map 2");
constexpr int CW_TMO = 0;
constexpr int CW_BAR = 4096;
constexpr int CW_CNT = 16384;

constexpr int RING_OFF = 0, RING_BYTES = 131072;
constexpr int LDSCTL_OFF = RING_BYTES, MISC_OFF = LDSCTL_OFF + 320;
constexpr int TS_OFF = LDSCTL_OFF + 512;
constexpr int POFF_OFF = LDSCTL_OFF + 1280;
constexpr int LDS_BYTES = 147456;

#define GAS __attribute__((address_space(1)))
#define LAS __attribute__((address_space(3)))
typedef unsigned short bf16;
typedef unsigned v4u __attribute__((ext_vector_type(4)));
typedef unsigned v2u __attribute__((ext_vector_type(2)));
typedef float f32x4 __attribute__((ext_vector_type(4)));
typedef short bf16x8 __attribute__((ext_vector_type(8)));
typedef GAS unsigned gu32;
#define RLX_AGENT __ATOMIC_RELAXED, __HIP_MEMORY_SCOPE_AGENT
#define LDS_WAIT() asm volatile("s_waitcnt lgkmcnt(0)" ::: "memory")
#define VM_WAIT() asm volatile("s_waitcnt vmcnt(0)" ::: "memory")
__device__ __forceinline__ unsigned f2bf(float f) { unsigned u = __builtin_bit_cast(unsigned, f); return (u + 0x7fffu + ((u >> 16) & 1u)) >> 16; }
__device__ __forceinline__ unsigned pk2(float lo, float hi) { return f2bf(lo) | (f2bf(hi) << 16); }
__device__ __forceinline__ float bf2f(unsigned h) { return __builtin_bit_cast(float, h << 16); }
__device__ __forceinline__ float bflo(unsigned w) { return __builtin_bit_cast(float, w << 16); }
__device__ __forceinline__ float bfhi(unsigned w) { return __builtin_bit_cast(float, w & 0xffff0000u); }

#define XB_TMO      128
#define XB_XCNT(j)  (256  + 64 * (j))
#define XB_XSUB(j)  (1280 + 64 * (j))
#define XB_XGEN(j)  (2304 + 64 * (j))
#define XB_TOP      3328
#define XB_TOPGEN   3392
#define XCD_BAR_WORDS 3456
#define XB_SPIN_CAP (1u << 18)
__device__ __forceinline__ unsigned xb_ld(unsigned* p)              { return __hip_atomic_load(p, __ATOMIC_RELAXED, __HIP_MEMORY_SCOPE_AGENT); }
__device__ __forceinline__ unsigned xb_add(unsigned* p, unsigned v) { return __hip_atomic_fetch_add(p, v, __ATOMIC_RELAXED, __HIP_MEMORY_SCOPE_AGENT); }
__device__ __forceinline__ unsigned xb_xcc_id() { return (unsigned)__builtin_amdgcn_s_getreg((3 << 11) | 20) & 0xFu; }
#define XB_SPIN(cond, bar) do { unsigned _sp = 0; while (cond) { __builtin_amdgcn_s_sleep(1); \
    if ((++_sp & 255u) == 0u) { if (xb_ld(&(bar)[XB_TMO])) break; if (_sp > XB_SPIN_CAP) { atomicAdd(&(bar)[XB_TMO], 1u); break; } } } } while (0)
struct XcdBarrier { unsigned* bar; unsigned x; volatile LAS unsigned* st; };
__device__ __forceinline__ XcdBarrier xcd_barrier_post(unsigned* bar, volatile LAS unsigned* st) {
    XcdBarrier b; b.bar = bar; b.x = xb_xcc_id(); b.st = st;
    if (threadIdx.x == 0) (void)xb_add(&bar[XB_XCNT(b.x)], 1u);
    return b;
}
__device__ __forceinline__ void xcd_barrier_complete(unsigned* bar, unsigned x, unsigned& nloc, unsigned& nx) {
    const unsigned G = gridDim.x * gridDim.y * gridDim.z;
    unsigned sum, cnt, mine, sp = 0u;
    for (;;) {
        sum = 0u; cnt = 0u; mine = 0u;
#pragma unroll
        for (unsigned j = 0; j < 16; ++j) { const unsigned c = xb_ld(&bar[XB_XCNT(j)]); sum += c; cnt += (c > 0u) ? 1u : 0u; mine = (j == x) ? c : mine; }
        if (sum == G) break;
        __builtin_amdgcn_s_sleep(1);
        if ((++sp & 255u) == 0u) { if (xb_ld(&bar[XB_TMO])) break; if (sp > XB_SPIN_CAP) { atomicAdd(&bar[XB_TMO], 1u); break; } }
    }
    nloc = mine > 0u ? mine : 1u; nx = cnt > 0u ? cnt : 1u;
}
__device__ __forceinline__ void xcd_barrier(const XcdBarrier& b) {
    asm volatile("s_waitcnt vmcnt(0)" ::: "memory");
    __syncthreads();
    if (threadIdx.x == 0) {
        unsigned* bar = b.bar;
        __builtin_amdgcn_s_waitcnt(0);
        unsigned nloc = b.st[0], nx = b.st[1];
        if (nloc == 0u) { xcd_barrier_complete(bar, b.x, nloc, nx); b.st[0] = nloc; b.st[1] = nx; }
        const unsigned old = xb_add(&bar[XB_XSUB(b.x)], 1u);
        const unsigned gen = old / nloc;
        if (old + 1u == (gen + 1u) * nloc) {
            __builtin_amdgcn_fence(__ATOMIC_RELEASE, "agent");
            asm volatile("s_waitcnt vmcnt(0)" ::: "memory");
            const unsigned og = xb_add(&bar[XB_TOP], 1u);
            const unsigned tg = og / nx;
            if (og + 1u == (tg + 1u) * nx) xb_add(&bar[XB_TOPGEN], 1u);
            else XB_SPIN(xb_ld(&bar[XB_TOPGEN]) == tg, bar);
            __builtin_amdgcn_fence(__ATOMIC_ACQUIRE, "agent");
            xb_add(&bar[XB_XGEN(b.x)], 1u);
            asm volatile("s_waitcnt vmcnt(0)" ::: "memory");
        } else {
            XB_SPIN(xb_ld(&bar[XB_XGEN(b.x)]) == gen, bar);
            __builtin_amdgcn_fence(__ATOMIC_ACQUIRE, "agent");
            asm volatile("s_waitcnt vmcnt(0)" ::: "memory");
        }
    }
    __syncthreads();
}

struct Frame {
    LAS unsigned char* lds;
    volatile LAS unsigned* MISC;
    gu32* ctl;
    int tid, lane, wave;
    int vcu, G;
    unsigned char* ws;
    const float *x, *c, *w_mod, *b_mod, *w_in, *conv_w, *sinks, *w_out, *ln1_g, *ln1_b, *w_router, *router_bias, *w_gate, *w_up, *w_down, *ws_gate, *ws_up, *ws_down, *ln2_g, *ln2_b;
    float* out;
};
__device__ __forceinline__ float wave_sum(float v) {
#pragma unroll
    for (int o = 1; o < 64; o <<= 1) v += __shfl_xor(v, o);
    return v;
}

__device__ __forceinline__ void p0_transpose_item(const float* src, int ldw, bf16* dst, int ldt, LAS float* scr, int lane) {
#pragma unroll 8
    for (int i = 0; i < 32; ++i) { const int kk = 2 * i + (lane >> 5); scr[kk * 33 + (lane & 31)] = src[(size_t)kk * ldw + (lane & 31)]; }
    LDS_WAIT(); asm volatile("" ::: "memory");
    const int c = lane & 7;
#pragma unroll
    for (int j = 0; j < 4; ++j) { const int n = (lane >> 3) + 8 * j; const LAS float* s = scr + (8 * c) * 33 + n;
        v4u o; o.x = pk2(s[0 * 33], s[1 * 33]); o.y = pk2(s[2 * 33], s[3 * 33]); o.z = pk2(s[4 * 33], s[5 * 33]); o.w = pk2(s[6 * 33], s[7 * 33]);
        *(GAS v4u*)(dst + (size_t)n * ldt + 8 * c) = o; }
    LDS_WAIT(); asm volatile("" ::: "memory");
}
__device__ __forceinline__ void p0_transpose_item_hilo(const float* src, int ldw, bf16* dhi, bf16* dlo, int ldt, LAS float* scr, int lane) {
#pragma unroll 8
    for (int i = 0; i < 32; ++i) { const int kk = 2 * i + (lane >> 5); scr[kk * 33 + (lane & 31)] = src[(size_t)kk * ldw + (lane & 31)]; }
    LDS_WAIT(); asm volatile("" ::: "memory");
    const int c = lane & 7;
#pragma unroll
    for (int j = 0; j < 4; ++j) { const int n = (lane >> 3) + 8 * j; const LAS float* s = scr + (8 * c) * 33 + n;
        float v[8]; unsigned h[8], l[8];
#pragma unroll
        for (int q = 0; q < 8; ++q) { v[q] = s[q * 33]; h[q] = f2bf(v[q]); l[q] = f2bf(v[q] - bf2f(h[q])); }
        v4u o; o.x = h[0] | (h[1] << 16); o.y = h[2] | (h[3] << 16); o.z = h[4] | (h[5] << 16); o.w = h[6] | (h[7] << 16);
        *(GAS v4u*)(dhi + (size_t)n * ldt + 8 * c) = o;
        o.x = l[0] | (l[1] << 16); o.y = l[2] | (l[3] << 16); o.z = l[4] | (l[5] << 16); o.w = l[6] | (l[7] << 16);
        *(GAS v4u*)(dlo + (size_t)n * ldt + 8 * c) = o; }
    LDS_WAIT(); asm volatile("" ::: "memory");
}
__device__ __forceinline__ void p0_prologue(Frame& F) {
    {
        LAS float* cs = (LAS float*)(F.lds + RING_OFF);
        LAS float* red = (LAS float*)(F.lds + RING_OFF + 16384);
        for (int i = F.tid; i < NB * D; i += NTHR) { const float v = F.c[i]; cs[i] = v / (1.0f + __expf(-v)); }
        __syncthreads();
        float* part = (float*)(F.ws + WS_PART);
        for (int it = blockIdx.x; it < 48 * KSL; it += F.G) {
            const int chunk = it % 48, sl = it / 48, k0 = sl * (D / KSL) + F.wave * 32;
            const float* wp = F.w_mod + (size_t)k0 * (6 * D) + chunk * 256 + F.lane * 4;
            f32x4 a0 = {0.f, 0.f, 0.f, 0.f}, a1 = {0.f, 0.f, 0.f, 0.f};
#pragma unroll 8
            for (int k = 0; k < 32; ++k) { const f32x4 w = *(const GAS f32x4*)(wp + (size_t)k * (6 * D)); const float c0 = cs[k0 + k], c1 = cs[D + k0 + k]; a0 += w * c0; a1 += w * c1; }
            *(LAS f32x4*)(red + (F.wave * 2 + 0) * 256 + F.lane * 4) = a0;
            *(LAS f32x4*)(red + (F.wave * 2 + 1) * 256 + F.lane * 4) = a1;
            __syncthreads();
            { const int b = F.tid >> 8, col = F.tid & 255; float s = 0.f;
#pragma unroll
              for (int w = 0; w < 8; ++w) s += red[(w * 2 + b) * 256 + col];
              part[((size_t)sl * 2 + b) * (6 * D) + chunk * 256 + col] = s; }
            __syncthreads();
        }
    }
    LAS float* scr = (LAS float*)(F.lds + RING_OFF + 32768 + F.wave * 12288);
    const int gw = F.vcu * NWAVES + F.wave, NGW = F.G * NWAVES;
    constexpr int I_IN = (D / 64) * (INW / 32), I_OUT = (D / 64) * (D / 32), I_G = (D / 64) * (DE / 32), I_D = (DE / 64) * (D / 32), I_R = (D / 64) * (NE / 32);
    constexpr int NITEMS = I_IN + I_OUT + NSLOT * (2 * I_G + I_D) + I_R;
    bf16* WinT = (bf16*)(F.ws + WS_WINT); bf16* WoutT = (bf16*)(F.ws + WS_WOUTT); bf16* WguT = (bf16*)(F.ws + WS_WGUT); bf16* WdT = (bf16*)(F.ws + WS_WDT);
    bf16* WrHi = (bf16*)(F.ws + WS_WRT); bf16* WrLo = WrHi + NE * D;
    for (int it = gw; it < NITEMS; it += NGW) {
        int r = it;
        if (r < I_IN) { const int nblk = INW / 32, kb = r / nblk, nb = r % nblk; p0_transpose_item(F.w_in + (size_t)(64 * kb) * INW + 32 * nb, INW, WinT + (size_t)(32 * nb) * D + 64 * kb, D, scr, F.lane); continue; } r -= I_IN;
        if (r < I_OUT) { const int nblk = D / 32, kb = r / nblk, nb = r % nblk; p0_transpose_item(F.w_out + (size_t)(64 * kb) * D + 32 * nb, D, WoutT + (size_t)(32 * nb) * D + 64 * kb, D, scr, F.lane); continue; } r -= I_OUT;
        if (r < NSLOT * 2 * I_G) {
            const int s = r / (2 * I_G), q = r % (2 * I_G), up = q / I_G, q2 = q % I_G, nblk = DE / 32, kb = q2 / nblk, nb = q2 % nblk, n0 = 32 * nb;
            const float* W = up ? (s == 0 ? F.ws_up : F.w_up + (size_t)(s - 1) * D * DE) : (s == 0 ? F.ws_gate : F.w_gate + (size_t)(s - 1) * D * DE);
            const int drow = s * 1024 + (n0 >> 7) * 256 + up * 128 + (n0 & 127);
            p0_transpose_item(W + (size_t)(64 * kb) * DE + n0, DE, WguT + (size_t)drow * D + 64 * kb, D, scr, F.lane); continue; } r -= NSLOT * 2 * I_G;
        if (r < NSLOT * I_D) {
            const int s = r / I_D, q = r % I_D, nblk = D / 32, kb = q / nblk, nb = q % nblk;
            const float* W = (s == 0 ? F.ws_down : F.w_down + (size_t)(s - 1) * DE * D);
            p0_transpose_item(W + (size_t)(64 * kb) * D + 32 * nb, D, WdT + (size_t)(s * D + 32 * nb) * DE + 64 * kb, DE, scr, F.lane); continue; } r -= NSLOT * I_D;
        { const int nblk = NE / 32, kb = r / nblk, nb = r % nblk;
          p0_transpose_item_hilo(F.w_router + (size_t)(64 * kb) * NE + 32 * nb, NE, WrHi + (size_t)(32 * nb) * D + 64 * kb, WrLo + (size_t)(32 * nb) * D + 64 * kb, D, scr, F.lane); }
    }
}

__device__ __forceinline__ void p1a_modulate(Frame& F) {
    const float* part = (const float*)(F.ws + WS_PART); float* modf = (float*)(F.ws + WS_MODF);
    { const int idx = blockIdx.x * NTHR + F.tid;
      if (idx < NB * 6 * D) { const int b = idx / (6 * D), j = idx % (6 * D); float s = F.b_mod[j];
#pragma unroll
          for (int sl = 0; sl < KSL; ++sl) s += part[((size_t)sl * 2 + b) * (6 * D) + j];
          modf[idx] = s; } }
    LAS float* sm = (LAS float*)(F.lds + RING_OFF);
    for (int i = F.tid; i < NB * 2 * D; i += NTHR) { const int b = i / (2 * D), j = i % (2 * D); float s = F.b_mod[j];
#pragma unroll
        for (int sl = 0; sl < KSL; ++sl) s += part[((size_t)sl * 2 + b) * (6 * D) + j];
        sm[i] = s; }
    __syncthreads();
    const int gw = F.vcu * NWAVES + F.wave, NGW = F.G * NWAVES;
    bf16* hb = (bf16*)(F.ws + WS_HB);
    for (int m = gw; m < M; m += NGW) {
        const int b = m / SEQ; const GAS f32x4* xr = (const GAS f32x4*)(F.x + (size_t)m * D) + F.lane;
        const LAS f32x4* sh = (const LAS f32x4*)(sm + b * 2 * D) + F.lane; const LAS f32x4* sc = (const LAS f32x4*)(sm + b * 2 * D + D) + F.lane;
        GAS v2u* o = (GAS v2u*)(hb + (size_t)m * D) + F.lane;
#pragma unroll
        for (int j = 0; j < 8; ++j) { const f32x4 v = xr[64 * j], a = sc[64 * j], s = sh[64 * j]; const f32x4 h = v * (a + 1.0f) + s;
            v2u w; w.x = pk2(h.x, h.y); w.y = pk2(h.z, h.w); o[64 * j] = w; }
    }
}

constexpr int KS_PITCH = 144, VT_PITCH = 528, LDS_KS = 0, LDS_VT = 256 * KS_PITCH;
__device__ __forceinline__ void p2_attn_conv(Frame& F) {
    const bf16* proj = (const bf16*)(F.ws + WS_PROJ); bf16* mix = (bf16*)(F.ws + WS_MIX);
    const int fr = F.lane & 15, fq = F.lane >> 4;
    for (int unit = blockIdx.x; unit < NB * (SEQ / 128) * NKVH; unit += F.G) {
        const int hkv = unit % NKVH, nb = (unit / NKVH) % (SEQ / 128), b = unit / (NKVH * (SEQ / 128));
        const int rowbase = b * SEQ + nb * 128 - 128;
        __syncthreads();
#pragma unroll
        for (int it = 0; it < 4; ++it) {
            const int idx = F.tid + NTHR * it, j = idx >> 3, c = idx & 7;
            v4u kv = {0u, 0u, 0u, 0u};
            if (nb > 0 || j >= 128) kv = *(const GAS v4u*)(proj + (size_t)(rowbase + j) * INW + COL_K + hkv * HD + c * 8);
            *(LAS v4u*)(F.lds + LDS_KS + j * KS_PITCH + c * 16) = kv;
        }
#pragma unroll
        for (int it = 0; it < 4; ++it) {
            const int idx = F.tid + NTHR * it, j = idx & 255, c = idx >> 8;
            v4u vv = {0u, 0u, 0u, 0u};
            if (nb > 0 || j >= 128) vv = *(const GAS v4u*)(proj + (size_t)(rowbase + j) * INW + COL_V + hkv * HD + c * 8);
            LAS unsigned short* vt = (LAS unsigned short*)(F.lds + LDS_VT + (c * 8) * VT_PITCH + j * 2);
            vt[0 * (VT_PITCH / 2)] = (unsigned short)(vv.x & 0xffffu); vt[1 * (VT_PITCH / 2)] = (unsigned short)(vv.x >> 16);
            vt[2 * (VT_PITCH / 2)] = (unsigned short)(vv.y & 0xffffu); vt[3 * (VT_PITCH / 2)] = (unsigned short)(vv.y >> 16);
            vt[4 * (VT_PITCH / 2)] = (unsigned short)(vv.z & 0xffffu); vt[5 * (VT_PITCH / 2)] = (unsigned short)(vv.z >> 16);
            vt[6 * (VT_PITCH / 2)] = (unsigned short)(vv.w & 0xffffu); vt[7 * (VT_PITCH / 2)] = (unsigned short)(vv.w >> 16);
        }
        __syncthreads();
        const int g = F.wave & 3, half = F.wave >> 2, h = hkv * 4 + g;
        const float slope2 = exp2f(-0.5f * (float)(h + 1)) * 1.4426950408889634f;
        const float sink2 = F.sinks[h] * 1.4426950408889634f;
        const float qk2 = 0.125f * 1.4426950408889634f;
#pragma unroll 1
        for (int mi = 0; mi < 4; ++mi) {
            const int i = half * 4 + mi, j0 = i >> 1;
            const size_t qrow = (size_t)(b * SEQ + nb * 128 + 16 * i + fr);
            const bf16x8 q0 = *(const GAS bf16x8*)(proj + qrow * INW + h * HD + 8 * fq), q1 = *(const GAS bf16x8*)(proj + qrow * INW + h * HD + 32 + 8 * fq);
            f32x4 s[10];
#pragma unroll
            for (int x = 0; x < 10; ++x) {
                const int tt = 2 * j0 + x;
                const bf16x8 k0 = *(const LAS bf16x8*)(F.lds + LDS_KS + (16 * tt + fr) * KS_PITCH + 16 * fq), k1 = *(const LAS bf16x8*)(F.lds + LDS_KS + (16 * tt + fr) * KS_PITCH + 64 + 16 * fq);
                f32x4 a = {0.f, 0.f, 0.f, 0.f};
                a = __builtin_amdgcn_mfma_f32_16x16x32_bf16(k0, q0, a, 0, 0, 0);
                a = __builtin_amdgcn_mfma_f32_16x16x32_bf16(k1, q1, a, 0, 0, 0);
                s[x] = a;
            }
            float mx = sink2;
#pragma unroll
            for (int x = 0; x < 10; ++x) {
#pragma unroll
                for (int r = 0; r < 4; ++r) {
                    const int kj = 16 * (2 * j0 + x) + 4 * fq + r, dist = 16 * i + fr + 128 - kj;
                    const bool valid = (dist >= 0) && (dist < 128) && (nb > 0 || kj >= 128);
                    const float v = valid ? (s[x][r] * qk2 - slope2 * (float)dist) : -INFINITY;
                    s[x][r] = v; mx = fmaxf(mx, v);
                }
            }
            mx = fmaxf(mx, __shfl_xor(mx, 16)); mx = fmaxf(mx, __shfl_xor(mx, 32));
            float l = 0.f;
#pragma unroll
            for (int x = 0; x < 10; ++x) {
#pragma unroll
                for (int r = 0; r < 4; ++r) { const float p = __builtin_amdgcn_exp2f(s[x][r] - mx); s[x][r] = p; l += p; }
            }
            l += __shfl_xor(l, 16); l += __shfl_xor(l, 32);
            const float inv = 1.0f / (l + __builtin_amdgcn_exp2f(sink2 - mx));
            f32x4 o[4];
#pragma unroll
            for (int dt = 0; dt < 4; ++dt) o[dt] = (f32x4){0.f, 0.f, 0.f, 0.f};
#pragma unroll
            for (int pp = 0; pp < 5; ++pp) {
                const int tt0 = 2 * (j0 + pp);
                v4u pw; pw.x = pk2(s[2 * pp][0] * inv, s[2 * pp][1] * inv); pw.y = pk2(s[2 * pp][2] * inv, s[2 * pp][3] * inv);
                pw.z = pk2(s[2 * pp + 1][0] * inv, s[2 * pp + 1][1] * inv); pw.w = pk2(s[2 * pp + 1][2] * inv, s[2 * pp + 1][3] * inv);
                const bf16x8 pf = __builtin_bit_cast(bf16x8, pw);
#pragma unroll
                for (int dt = 0; dt < 4; ++dt) {
                    const LAS unsigned char* vp = F.lds + LDS_VT + (16 * dt + fr) * VT_PITCH + 32 * tt0 + 8 * fq;
                    const v2u lo = *(const LAS v2u*)vp, hi = *(const LAS v2u*)(vp + 32);
                    v4u vw; vw.x = lo.x; vw.y = lo.y; vw.z = hi.x; vw.w = hi.y;
                    o[dt] = __builtin_amdgcn_mfma_f32_16x16x32_bf16(__builtin_bit_cast(bf16x8, vw), pf, o[dt], 0, 0, 0);
                }
            }
#pragma unroll
            for (int dt = 0; dt < 4; ++dt) { v2u w; w.x = pk2(o[dt][0], o[dt][1]); w.y = pk2(o[dt][2], o[dt][3]);
                *(GAS v2u*)(mix + qrow * D + h * HD + 16 * dt + 4 * fq) = w; }
        }
    }
    for (int item = F.vcu * NTHR + F.tid; item < (M / 8) * (CW / 8); item += F.G * NTHR) {
        const int cch = item % (CW / 8), rb = item / (CW / 8), r0 = rb * 8, t0 = r0 % SEQ, c0 = cch * 8;
        float w0[8], w1[8], w2[8], u1[8], u2[8];
        { const f32x4 a = *(const GAS f32x4*)(F.conv_w + c0), b2 = *(const GAS f32x4*)(F.conv_w + c0 + 4);
          w0[0] = a.x; w0[1] = a.y; w0[2] = a.z; w0[3] = a.w; w0[4] = b2.x; w0[5] = b2.y; w0[6] = b2.z; w0[7] = b2.w; }
        { const f32x4 a = *(const GAS f32x4*)(F.conv_w + CW + c0), b2 = *(const GAS f32x4*)(F.conv_w + CW + c0 + 4);
          w1[0] = a.x; w1[1] = a.y; w1[2] = a.z; w1[3] = a.w; w1[4] = b2.x; w1[5] = b2.y; w1[6] = b2.z; w1[7] = b2.w; }
        { const f32x4 a = *(const GAS f32x4*)(F.conv_w + 2 * CW + c0), b2 = *(const GAS f32x4*)(F.conv_w + 2 * CW + c0 + 4);
          w2[0] = a.x; w2[1] = a.y; w2[2] = a.z; w2[3] = a.w; w2[4] = b2.x; w2[5] = b2.y; w2[6] = b2.z; w2[7] = b2.w; }
        if (t0 == 0) {
#pragma unroll
            for (int q = 0; q < 8; ++q) { u1[q] = 0.f; u2[q] = 0.f; }
        } else {
            const v4u c1 = *(const GAS v4u*)(proj + (size_t)(r0 - 1) * INW + COL_CC + c0), h1 = *(const GAS v4u*)(proj + (size_t)(r0 - 1) * INW + COL_CH + c0);
            const v4u c2 = *(const GAS v4u*)(proj + (size_t)(r0 - 2) * INW + COL_CC + c0), h2 = *(const GAS v4u*)(proj + (size_t)(r0 - 2) * INW + COL_CH + c0);
            u1[0] = bflo(c1.x) * bflo(h1.x); u1[1] = bfhi(c1.x) * bfhi(h1.x); u1[2] = bflo(c1.y) * bflo(h1.y); u1[3] = bfhi(c1.y) * bfhi(h1.y);
            u1[4] = bflo(c1.z) * bflo(h1.z); u1[5] = bfhi(c1.z) * bfhi(h1.z); u1[6] = bflo(c1.w) * bflo(h1.w); u1[7] = bfhi(c1.w) * bfhi(h1.w);
            u2[0] = bflo(c2.x) * bflo(h2.x); u2[1] = bfhi(c2.x) * bfhi(h2.x); u2[2] = bflo(c2.y) * bflo(h2.y); u2[3] = bfhi(c2.y) * bfhi(h2.y);
            u2[4] = bflo(c2.z) * bflo(h2.z); u2[5] = bfhi(c2.z) * bfhi(h2.z); u2[6] = bflo(c2.w) * bflo(h2.w); u2[7] = bfhi(c2.w) * bfhi(h2.w);
        }
#pragma unroll
        for (int rr = 0; rr < 8; ++rr) {
            const size_t ro = (size_t)(r0 + rr) * INW;
            const v4u bv = *(const GAS v4u*)(proj + ro + COL_CB + c0), cv = *(const GAS v4u*)(proj + ro + COL_CC + c0), hv = *(const GAS v4u*)(proj + ro + COL_CH + c0);
            float u0[8], cb[8], y[8];
            u0[0] = bflo(cv.x) * bflo(hv.x); u0[1] = bfhi(cv.x) * bfhi(hv.x); u0[2] = bflo(cv.y) * bflo(hv.y); u0[3] = bfhi(cv.y) * bfhi(hv.y);
            u0[4] = bflo(cv.z) * bflo(hv.z); u0[5] = bfhi(cv.z) * bfhi(hv.z); u0[6] = bflo(cv.w) * bflo(hv.w); u0[7] = bfhi(cv.w) * bfhi(hv.w);
            cb[0] = bflo(bv.x); cb[1] = bfhi(bv.x); cb[2] = bflo(bv.y); cb[3] = bfhi(bv.y); cb[4] = bflo(bv.z); cb[5] = bfhi(bv.z); cb[6] = bflo(bv.w); cb[7] = bfhi(bv.w);
#pragma unroll
            for (int q = 0; q < 8; ++q) { y[q] = cb[q] * (w0[q] * u2[q] + w1[q] * u1[q] + w2[q] * u0[q]); u2[q] = u1[q]; u1[q] = u0[q]; }
            v4u ov; ov.x = pk2(y[0], y[1]); ov.y = pk2(y[2], y[3]); ov.z = pk2(y[4], y[5]); ov.w = pk2(y[6], y[7]);
            *(GAS v4u*)(mix + (size_t)(r0 + rr) * D + AW + c0) = ov;
        }
    }
}

constexpr int P4_STAT = 0, P4_GB = 1024, P4_PART = P4_GB + 2 * D * 4, P4_END = P4_PART + 8 * 32 * 64 * 4;
static_assert(P4_END <= RING_BYTES, "P4 LDS");
__device__ __forceinline__ void p4_ln_router(Frame& F) {
    const float* y1 = (const float*)(F.ws + WS_Y1); float* x1 = (float*)(F.ws + WS_X1); bf16* xg = (bf16*)(F.ws + WS_XG);
    const float* modf = (const float*)(F.ws + WS_MODF);
    const bf16* WrHi = (const bf16*)(F.ws + WS_WRT); const bf16* WrLo = WrHi + NE * D;
    int* rowtok = (int*)(F.ws + WS_ROWTOK); float* roww = (float*)(F.ws + WS_ROWW); int* tokslot = (int*)(F.ws + WS_TOKSLOT);
    LAS float* stat = (LAS float*)(F.lds + P4_STAT); LAS float* GB = (LAS float*)(F.lds + P4_GB); LAS float* lpart = (LAS float*)(F.lds + P4_PART);
    const int fr = F.lane & 15, fq = F.lane >> 4;
    for (int unit = blockIdx.x; unit < M / 32; unit += F.G) {
        const int row0 = unit * 32, b = row0 / SEQ;
        const float* sh2 = modf + (size_t)b * 6 * D + 3 * D; const float* sc2 = modf + (size_t)b * 6 * D + 4 * D;
        __syncthreads();
        for (int k = F.tid; k < D; k += NTHR) { const float a = 1.0f + sc2[k]; GB[k] = F.ln1_g[k] * a; GB[D + k] = F.ln1_b[k] * a + sh2[k]; }
#pragma unroll 1
        for (int rr = 0; rr < 4; ++rr) {
            const int r = F.wave * 4 + rr; const size_t m = (size_t)(row0 + r);
            const GAS f32x4* yr = (const GAS f32x4*)(y1 + m * D) + F.lane;
            f32x4 v[8]; float s = 0.f;
#pragma unroll
            for (int j = 0; j < 8; ++j) { v[j] = yr[64 * j]; s += (v[j].x + v[j].y) + (v[j].z + v[j].w); }
            const float mean = wave_sum(s) * (1.f / D); float s2 = 0.f;
#pragma unroll
            for (int j = 0; j < 8; ++j) { v[j] = v[j] - mean; s2 += (v[j].x * v[j].x + v[j].y * v[j].y) + (v[j].z * v[j].z + v[j].w * v[j].w); }
            const float rstd = 1.f / sqrtf(wave_sum(s2) * (1.f / D) + LN_EPS);
            if (F.lane == 0) { stat[2 * r] = mean; stat[2 * r + 1] = rstd; }
            GAS f32x4* xo = (GAS f32x4*)(x1 + m * D) + F.lane; GAS v2u* ho = (GAS v2u*)(xg + m * D) + F.lane;
#pragma unroll
            for (int j = 0; j < 8; ++j) {
                const f32x4 g = *((const GAS f32x4*)F.ln1_g + F.lane + 64 * j), bb = *((const GAS f32x4*)F.ln1_b + F.lane + 64 * j);
                const f32x4 a = *((const GAS f32x4*)sc2 + F.lane + 64 * j), sft = *((const GAS f32x4*)sh2 + F.lane + 64 * j);
                const f32x4 xv = v[j] * rstd * g + bb; xo[64 * j] = xv;
                const f32x4 hv = xv * (a + 1.0f) + sft; v2u w; w.x = pk2(hv.x, hv.y); w.y = pk2(hv.z, hv.w); ho[64 * j] = w;
            }
        }
        __syncthreads();
        {
            f32x4 acc[2][4];
#pragma unroll
            for (int mt = 0; mt < 2; ++mt)
#pragma unroll
                for (int nt = 0; nt < 4; ++nt) acc[mt][nt] = (f32x4){0.f, 0.f, 0.f, 0.f};
            const float mu0 = stat[2 * fr], rs0 = stat[2 * fr + 1], mu1 = stat[2 * (16 + fr)], rs1 = stat[2 * (16 + fr) + 1];
#pragma unroll 1
            for (int ks = F.wave * 8; ks < F.wave * 8 + 8; ++ks) {
                const int k0 = 32 * ks + 8 * fq;
                const f32x4 g0 = *(const LAS f32x4*)(GB + k0), g1 = *(const LAS f32x4*)(GB + k0 + 4), b0 = *(const LAS f32x4*)(GB + D + k0), b1 = *(const LAS f32x4*)(GB + D + k0 + 4);
                bf16x8 whi[4], wlo[4];
#pragma unroll
                for (int nt = 0; nt < 4; ++nt) { whi[nt] = *(const GAS bf16x8*)(WrHi + (size_t)(16 * nt + fr) * D + k0); wlo[nt] = *(const GAS bf16x8*)(WrLo + (size_t)(16 * nt + fr) * D + k0); }
#pragma unroll
                for (int mt = 0; mt < 2; ++mt) {
                    const float mu = mt ? mu1 : mu0, rs = mt ? rs1 : rs0;
                    const float* yp = y1 + (size_t)(row0 + 16 * mt + fr) * D + k0;
                    const f32x4 ya = *(const GAS f32x4*)yp, yb = *(const GAS f32x4*)(yp + 4);
                    const f32x4 ha = (ya - mu) * rs * g0 + b0, hb2 = (yb - mu) * rs * g1 + b1;
                    unsigned hh[8], ll[8];
                    { const float t[8] = {ha.x, ha.y, ha.z, ha.w, hb2.x, hb2.y, hb2.z, hb2.w};
#pragma unroll
                      for (int q = 0; q < 8; ++q) { hh[q] = f2bf(t[q]); ll[q] = f2bf(t[q] - bf2f(hh[q])); } }
                    v4u ah, al; ah.x = hh[0] | (hh[1] << 16); ah.y = hh[2] | (hh[3] << 16); ah.z = hh[4] | (hh[5] << 16); ah.w = hh[6] | (hh[7] << 16);
                    al.x = ll[0] | (ll[1] << 16); al.y = ll[2] | (ll[3] << 16); al.z = ll[4] | (ll[5] << 16); al.w = ll[6] | (ll[7] << 16);
                    const bf16x8 fh = __builtin_bit_cast(bf16x8, ah), fl = __builtin_bit_cast(bf16x8, al);
#pragma unroll
                    for (int nt = 0; nt < 4; ++nt) {
                        acc[mt][nt] = __builtin_amdgcn_mfma_f32_16x16x32_bf16(fh, whi[nt], acc[mt][nt], 0, 0, 0);
                        acc[mt][nt] = __builtin_amdgcn_mfma_f32_16x16x32_bf16(fl, whi[nt], acc[mt][nt], 0, 0, 0);
                        acc[mt][nt] = __builtin_amdgcn_mfma_f32_16x16x32_bf16(fh, wlo[nt], acc[mt][nt], 0, 0, 0);
                    }
                }
            }
#pragma unroll
            for (int mt = 0; mt < 2; ++mt)
#pragma unroll
                for (int nt = 0; nt < 4; ++nt)
#pragma unroll
                    for (int r = 0; r < 4; ++r) lpart[(F.wave * 32 + 16 * mt + 4 * fq + r) * 64 + 16 * nt + fr] = acc[mt][nt][r];
        }
        __syncthreads();
#pragma unroll 1
        for (int rr = 0; rr < 4; ++rr) {
            const int r = F.wave * 4 + rr, tok = row0 + r, e = F.lane;
            float logit = 0.f;
#pragma unroll
            for (int w = 0; w < 8; ++w) logit += lpart[(w * 32 + r) * 64 + e];
            const float score = 1.0f / (1.0f + __expf(-logit));
            const float sel = score + F.router_bias[e];
            int rk = 0;
#pragma unroll
            for (int x = 1; x < 8; ++x) { const float o = __shfl_xor(sel, x); const int e2 = e ^ x; rk += (o > sel || (o == sel && e2 < e)) ? 1 : 0; }
            float gs = rk < 2 ? sel : 0.f;
            gs += __shfl_xor(gs, 1); gs += __shfl_xor(gs, 2); gs += __shfl_xor(gs, 4);
            int grk = 0; const int gi = e >> 3;
#pragma unroll
            for (int x = 1; x < 8; ++x) { const float o = __shfl_xor(gs, 8 * x); const int g2 = gi ^ x; grk += (o > gs || (o == gs && g2 < gi)) ? 1 : 0; }
            const bool gsel = grk < 4;
            const float mv = gsel ? sel : -INFINITY;
            int erk = 0;
#pragma unroll 9
            for (int x = 1; x < 64; ++x) { const float o = __shfl_xor(mv, x); const int e2 = e ^ x; erk += (o > mv || (o == mv && e2 < e)) ? 1 : 0; }
            const bool chosen = gsel && erk < TOPK;
            const float wsum = wave_sum(chosen ? score : 0.f);
            if (chosen) {
                const float w = score / wsum * RSCALE;
                const unsigned pos = __hip_atomic_fetch_add(F.ctl + CW_CNT + 64 * e, 1u, RLX_AGENT);
                rowtok[e * M + pos] = tok; roww[e * M + pos] = w; tokslot[tok * TOPK + erk] = e * M + (int)pos;
            }
        }
    }
}

__device__ __forceinline__ void build_tables(Frame& F) {
    LAS unsigned short* tslot = (LAS unsigned short*)(F.lds + TS_OFF); LAS int* poff = (LAS int*)(F.lds + POFF_OFF); LAS int* cnt = poff + 128; LAS int* nt_p = poff + 256;
    __syncthreads();
    if (F.tid < NE) cnt[F.tid] = (int)__hip_atomic_load(F.ctl + CW_CNT + 64 * F.tid, RLX_AGENT);
    __syncthreads();
    if (F.tid == 0) {
        int t = M / 256; poff[0] = 0;
        for (int i = 0; i < M / 256; ++i) tslot[i] = 0;
        for (int e = 0; e < NE; ++e) { poff[1 + e] = t * 256; int c = cnt[e]; c = c < 0 ? 0 : (c > M ? M : c); const int n = (c + 255) >> 8; for (int i = 0; i < n && t < MAXT; ++i) tslot[t++] = (unsigned short)(1 + e); }
        nt_p[0] = t;
    }
    __syncthreads();
}

__device__ __forceinline__ void p6_setup(Frame& F) {
    const LAS unsigned short* tslot = (const LAS unsigned short*)(F.lds + TS_OFF); const LAS int* poff = (const LAS int*)(F.lds + POFF_OFF); const LAS int* cnt = poff + 128; const int ntiles = poff[256];
    const int* rowtok = (const int*)(F.ws + WS_ROWTOK); const float* roww = (const float*)(F.ws + WS_ROWW); float* wrow = (float*)(F.ws + WS_WROW);
    v4u* vt = (v4u*)(F.ws + WS_VTAB) + (size_t)blockIdx.x * 8 * NTHR;
    int R0, C0, R1, C1; pg8::stage_rc(F.tid * 16, R0, C0); pg8::stage_rc(F.tid * 16 + 8192, R1, C1);
#pragma unroll 1
    for (int i = 0; i < 8; ++i) {
        const int L = i * F.G + F.vcu; if (L >= ntiles * 4) break;
        const int t = L >> 2, s = tslot[t], e = s - 1, pos0 = t * 256 - poff[s], ce = s ? cnt[e] : 0;
        int rr[4] = {R0, R1, 128 + R0, 128 + R1}; const int cc[4] = {C0, C1, C0, C1}; unsigned off[4];
#pragma unroll
        for (int q = 0; q < 4; ++q) { int tok = t * 256 + rr[q]; if (s) { const int pos = pos0 + rr[q]; tok = pos < ce ? rowtok[e * M + pos] : 0; } off[q] = (unsigned)(tok * D + cc[q]) * 2u; }
        v4u o; o.x = off[0]; o.y = off[1]; o.z = off[2]; o.w = off[3]; vt[i * NTHR + F.tid] = o;
        if (F.tid < 256) { float w = 1.0f; if (s) { const int pos = pos0 + F.tid; w = pos < ce ? roww[e * M + pos] : 0.f; } wrow[t * 256 + F.tid] = w; }
    }
    VM_WAIT(); __syncthreads();
}

__device__ __forceinline__ void p7_combine(Frame& F) {
    build_tables(F);
    const LAS int* poff = (const LAS int*)(F.lds + POFF_OFF);
    const bf16* Y = (const bf16*)(F.ws + WS_XG); const float* x1 = (const float*)(F.ws + WS_X1); const float* modf = (const float*)(F.ws + WS_MODF);
    const int* tokslot = (const int*)(F.ws + WS_TOKSLOT);
    const int gw = F.vcu * NWAVES + F.wave, NGW = F.G * NWAVES;
    for (int m = gw; m < M; m += NGW) {
        const int b = m / SEQ; const float* g2 = modf + (size_t)b * 6 * D + 5 * D;
        int rows[9]; rows[0] = m;
#pragma unroll
        for (int k = 0; k < TOPK; ++k) { const int sl = tokslot[m * TOPK + k], e = sl / M, pos = sl % M; rows[1 + k] = poff[1 + e] + pos; }
        f32x4 v[8];
#pragma unroll
        for (int j = 0; j < 8; ++j) v[j] = (f32x4){0.f, 0.f, 0.f, 0.f};
#pragma unroll
        for (int k = 0; k < 9; ++k) {
            const GAS v2u* yr = (const GAS v2u*)(Y + (size_t)rows[k] * D) + F.lane;
#pragma unroll
            for (int j = 0; j < 8; ++j) { const v2u w = yr[64 * j]; v[j].x += bflo(w.x); v[j].y += bfhi(w.x); v[j].z += bflo(w.y); v[j].w += bfhi(w.y); }
        }
        const GAS f32x4* xr = (const GAS f32x4*)(x1 + (size_t)m * D) + F.lane; float s = 0.f;
#pragma unroll
        for (int j = 0; j < 8; ++j) { const f32x4 gg = *((const GAS f32x4*)g2 + F.lane + 64 * j); v[j] = xr[64 * j] * ALPHA + (gg + 1.0f) * v[j]; s += (v[j].x + v[j].y) + (v[j].z + v[j].w); }
        const float mean = wave_sum(s) * (1.f / D); float s2 = 0.f;
#pragma unroll
        for (int j = 0; j < 8; ++j) { v[j] = v[j] - mean; s2 += (v[j].x * v[j].x + v[j].y * v[j].y) + (v[j].z * v[j].z + v[j].w * v[j].w); }
        const float rstd = 1.f / sqrtf(wave_sum(s2) * (1.f / D) + LN_EPS);
        GAS f32x4* o = (GAS f32x4*)(F.out + (size_t)m * D) + F.lane;
#pragma unroll
        for (int j = 0; j < 8; ++j) { const f32x4 g = *((const GAS f32x4*)F.ln2_g + F.lane + 64 * j), bb = *((const GAS f32x4*)F.ln2_b + F.lane + 64 * j); o[64 * j] = v[j] * rstd * g + bb; }
    }
}

constexpr int NPHASE = 9;
struct Args { const float* in[20]; float* out; unsigned char* ws; int ph_lo, ph_hi; };
__global__ void __launch_bounds__(NWAVES * 64, 2) mk_fwd(Args args) {
    extern __shared__ __attribute__((aligned(16))) unsigned char lds[];
    Frame F;
    F.lds = (LAS unsigned char*)lds;
    F.MISC = (volatile LAS unsigned*)(F.lds + MISC_OFF);
    F.tid = threadIdx.x; F.lane = F.tid & 63; F.wave = __builtin_amdgcn_readfirstlane(F.tid >> 6);
    F.G = gridDim.x; { const int bx = blockIdx.x; F.vcu = (F.G % 8 == 0) ? (bx % 8) * (F.G / 8) + bx / 8 : bx; }
    F.ws = args.ws; F.ctl = (gu32*)(args.ws + WS_CTL);
    F.x = args.in[0]; F.c = args.in[1]; F.w_mod = args.in[2]; F.b_mod = args.in[3]; F.w_in = args.in[4]; F.conv_w = args.in[5]; F.sinks = args.in[6]; F.w_out = args.in[7];
    F.ln1_g = args.in[8]; F.ln1_b = args.in[9]; F.w_router = args.in[10]; F.router_bias = args.in[11]; F.w_gate = args.in[12]; F.w_up = args.in[13]; F.w_down = args.in[14];
    F.ws_gate = args.in[15]; F.ws_up = args.in[16]; F.ws_down = args.in[17]; F.ln2_g = args.in[18]; F.ln2_b = args.in[19]; F.out = args.out;
    for (int u = F.tid; u < (LDS_BYTES - LDSCTL_OFF) / 4; u += NWAVES * 64) ((LAS unsigned*)(F.lds + LDSCTL_OFF))[u] = 0u;
    __syncthreads();
    XcdBarrier bar; bar.bar = (unsigned*)(F.ctl + CW_BAR); bar.x = 0; bar.st = nullptr;
    if (!MK_PER_PHASE) bar = xcd_barrier_post((unsigned*)(F.ctl + CW_BAR), F.MISC + 8);
#define GRID_BAR() do { if (!MK_PER_PHASE) xcd_barrier(bar); } while (0)
    const int lo = args.ph_lo, hi = args.ph_hi;
#define IN(k) (lo <= (k) && (k) < hi)
#define BOTH(k) (IN(k) && IN((k) + 1))
    if (IN(0)) { if (REP_PHASE == 0) { p0_prologue(F); GRID_BAR(); } p0_prologue(F); if (BOTH(0)) GRID_BAR(); }
    if (IN(1)) { if (REP_PHASE == 1) { p1a_modulate(F); GRID_BAR(); } p1a_modulate(F); if (BOTH(1)) GRID_BAR(); }
    if (IN(2)) {
        _Pragma("unroll") for (int rep = (REP_PHASE == 2 ? 0 : 1); rep < 2; ++rep) {
        __syncthreads();
        pg8::Gemm g{(const pg8::bf16_t*)(F.ws + WS_HB), (const pg8::bf16_t*)(F.ws + WS_WINT), M, INW, D}; pg8::StaticOrder S; S.init(M, INW, F.G, (int)blockIdx.x);
        pg8::EpiBf16<0> E{(pg8::bf16_t*)(F.ws + WS_PROJ), INW, nullptr, 0, 0, 1.f};
        pg8::gemm_phase<pg8::EpiBf16<0>, pg8::StaticOrder, PG8_ALIGN, PG8_SP2>(F.lds + RING_OFF, g, S, E);
        if (rep == 0) GRID_BAR(); }
        if (BOTH(2)) GRID_BAR();
    }
    if (IN(3)) { if (REP_PHASE == 3) { p2_attn_conv(F); GRID_BAR(); } p2_attn_conv(F); if (BOTH(3)) GRID_BAR(); }
    if (IN(4)) {
        _Pragma("unroll") for (int rep = (REP_PHASE == 4 ? 0 : 1); rep < 2; ++rep) {
        __syncthreads();
        pg8::Gemm g{(const pg8::bf16_t*)(F.ws + WS_MIX), (const pg8::bf16_t*)(F.ws + WS_WOUTT), M, D, D}; pg8::StaticOrder S; S.init(M, D, F.G, (int)blockIdx.x);
        pg8::EpiResF32 E{F.x, (float*)(F.ws + WS_Y1), (const float*)(F.ws + WS_MODF) + 2 * D, D, SEQ, 6 * D, ALPHA};
        pg8::gemm_phase<pg8::EpiResF32, pg8::StaticOrder, PG8_ALIGN, PG8_SP2>(F.lds + RING_OFF, g, S, E);
        if (rep == 0) GRID_BAR(); }
        if (BOTH(4)) GRID_BAR();
    }
    if (IN(5)) { p4_ln_router(F); if (BOTH(5)) GRID_BAR(); }
    if (IN(6)) {
        _Pragma("unroll") for (int rep = (REP_PHASE == 6 ? 0 : 1); rep < 2; ++rep) {
        build_tables(F);
        p6_setup(F);
        const int ntiles = ((const LAS int*)(F.lds + POFF_OFF))[256];
        pg8::Gemm g{(const pg8::bf16_t*)(F.ws + WS_XG), (const pg8::bf16_t*)(F.ws + WS_WGUT), M, NSLOT * 1024, D};
        pg8::GroupedOrder<true> S{(const PG8_LAS unsigned short*)(F.lds + TS_OFF), ntiles, 4, F.G, F.vcu, (const unsigned*)(F.ws + WS_VTAB) + (size_t)blockIdx.x * 8 * NTHR * 4};
        pg8::EpiSwiGLU E{(pg8::bf16_t*)(F.ws + WS_H), (const float*)(F.ws + WS_WROW), DE, 4};
        pg8::gemm_phase<pg8::EpiSwiGLU, pg8::GroupedOrder<true>, PG8_ALIGN, PG8_SP2>(F.lds + RING_OFF, g, S, E);
        if (rep == 0) GRID_BAR(); }
        if (BOTH(6)) GRID_BAR();
    }
    if (IN(7)) {
        _Pragma("unroll") for (int rep = (REP_PHASE == 7 ? 0 : 1); rep < 2; ++rep) {
        build_tables(F);
        const int ntiles = ((const LAS int*)(F.lds + POFF_OFF))[256];
        pg8::Gemm g{(const pg8::bf16_t*)(F.ws + WS_H), (const pg8::bf16_t*)(F.ws + WS_WDT), MAXR, NSLOT * D, DE};
        pg8::GroupedOrder<false> S{(const PG8_LAS unsigned short*)(F.lds + TS_OFF), ntiles, 8, F.G, F.vcu, nullptr};
        pg8::EpiDown E{(pg8::bf16_t*)(F.ws + WS_XG), D, 8};
        pg8::gemm_phase<pg8::EpiDown, pg8::GroupedOrder<false>, PG8_ALIGN, PG8_SP2>(F.lds + RING_OFF, g, S, E);
        if (rep == 0) GRID_BAR(); }
        if (BOTH(7)) GRID_BAR();
    }
    if (IN(8)) { if (REP_PHASE == 8) { p7_combine(F); GRID_BAR(); } p7_combine(F); }
#undef IN
#undef BOTH
}

extern "C" void kernel_launch(void* const* d_in, const int* in_sizes, int n_in, void* d_out, int out_size, void* d_ws, size_t ws_size, hipStream_t stream) {
    static int grid = 0;
    if (grid == 0) {
        if (n_in != 20 || in_sizes[0] != M * D || out_size != M * D || ws_size < WS_END) { fprintf(stderr, "kernel_launch: unexpected shapes (n_in %d, in0 %d, out %d, ws %zu)\n", n_in, n_in > 0 ? in_sizes[0] : -1, out_size, ws_size); grid = -1; return; }
        int dev = 0, cus = 0, per_cu = 0;
        if (hipGetDevice(&dev) != hipSuccess || hipDeviceGetAttribute(&cus, hipDeviceAttributeMultiprocessorCount, dev) != hipSuccess) { grid = -1; return; }
        if (hipFuncSetAttribute((const void*)mk_fwd, hipFuncAttributeMaxDynamicSharedMemorySize, LDS_BYTES) != hipSuccess) { fprintf(stderr, "kernel_launch: hipFuncSetAttribute failed\n"); grid = -1; return; }
        if (hipOccupancyMaxActiveBlocksPerMultiprocessor(&per_cu, (const void*)mk_fwd, NWAVES * 64, LDS_BYTES) != hipSuccess || per_cu < 1) fprintf(stderr, "kernel_launch: occupancy query reports %d\n", per_cu);
        (void)hipGetLastError();
        grid = cus;
    }
    if (grid < 0) return;
    if (hipMemsetAsync((char*)d_ws + WS_CTL, 0, CTL_ZERO_BYTES, stream) != hipSuccess) return;
    Args a{};
    for (int i = 0; i < 20; ++i) a.in[i] = (const float*)d_in[i];
    a.out = (float*)d_out; a.ws = (unsigned char*)d_ws;
#if MK_PER_PHASE
    for (int p = 0; p < NPHASE; ++p) { a.ph_lo = p; a.ph_hi = p + 1; hipLaunchKernelGGL(mk_fwd, dim3(grid), dim3(NWAVES * 64), LDS_BYTES, stream, a); }
#else
    a.ph_lo = 0; a.ph_hi = NPHASE; hipLaunchKernelGGL(mk_fwd, dim3(grid), dim3(NWAVES * 64), LDS_BYTES, stream, a);
#endif
}
```

```cpp
#include <hip/hip_runtime.h>
#include <cstdio>
#include <cstdint>
#include <cmath>
#ifndef MOE_F8
#define MOE_F8 1
#endif
#ifndef Y_BF8
#define Y_BF8 2
#endif
namespace pg8 {
constexpr float F8_SX = 8.0f, F8_SWG = 64.0f, F8_SH = 16.0f, F8_SWD = 32.0f;
#define PG8_LAS __attribute__((address_space(3)))
typedef unsigned short bf16_t;
typedef short bf16x8 __attribute__((ext_vector_type(8)));
typedef float f32x4 __attribute__((ext_vector_type(4)));
typedef unsigned u32x4 __attribute__((ext_vector_type(4)));
constexpr int BM = 256, BK = 64, HALF = 128, HTB = HALF * BK * 2  , STAGE_BYTES = 8 * HTB, NXCD = 8, WGM = 8;
constexpr int VT_SLOT = STAGE_BYTES + 4096;

__host__ __device__ __forceinline__ int lds_byte(int r, int c) { const int st = (r >> 4) * 2 + (c >> 5), rr = r & 15, cc = c & 31, ob = rr * 64 + cc * 2; return st * 1024 + (ob ^ (((ob >> 9) & 1) << 5)); }
__host__ __device__ __forceinline__ void stage_rc(int b, int& R, int& C) { const int st = b / 1024, sb = b % 1024, swz = sb ^ (((sb >> 9) & 1) << 5); R = (st >> 1) * 16 + swz / 64; C = (st & 1) * 32 + (swz % 64) / 2; }
__host__ __device__ __forceinline__ int perm32(int rho) { const int n = rho >> 4, i = rho & 15; return 8 * (i >> 2) + 4 * n + (i & 3); }

__device__ __forceinline__ int lane_id_v() { int l; asm volatile("v_mbcnt_lo_u32_b32 %0, -1, 0\n\tv_mbcnt_hi_u32_b32 %0, -1, %0" : "=v"(l)); return l; }
struct Unit { int pm, pn; };
struct Gemm { const bf16_t* A; const bf16_t* Bt; int M, N, K; const void* base; };

struct StaticOrder {
    static constexpr bool GATHER = false;
    int nM, nN, nwg, G, c;
    __host__ __device__ void init(int M, int N, int G_, int c_) { nM = M / BM; nN = N / BM; nwg = nM * nN; G = G_; c = c_; }
    __host__ __device__ bool next(int i, Unit& u) const {
        const long L = (long)i * G + c; if (L >= nwg) return false;
        int wgid = (int)L; { const int q = nwg / NXCD, r = nwg % NXCD, xcd = wgid % NXCD, off = wgid / NXCD; wgid = (xcd < r ? xcd * (q + 1) : r * (q + 1) + (xcd - r) * q) + off; }
        const int nig = WGM * nN, gid = wgid / nig, fm = gid * WGM, gsz = (nM - fm) < WGM ? (nM - fm) : WGM;
        u.pm = fm + ((wgid % nig) % gsz); u.pn = (wgid % nig) / gsz; return true;
    }
    __device__ __forceinline__ void a_ready(const Unit&) const {}
    __device__ __forceinline__ void done(const Unit&) const {}
};

__device__ __forceinline__ unsigned cvt_pk_bf16(float lo, float hi) { unsigned r; asm volatile("v_cvt_pk_bf16_f32 %0, %1, %2" : "=v"(r) : "v"(lo), "v"(hi)); return r; }
typedef float f32x2 __attribute__((ext_vector_type(2)));
__device__ __forceinline__ f32x2 gelu_pk(f32x2 v) {
    const f32x2 av = __builtin_elementwise_abs(v), d = av * 0.2316418882f + 1.0f;
    f32x2 t; t.x = __builtin_amdgcn_rcpf(d.x); t.y = __builtin_amdgcn_rcpf(d.y);
    f32x2 q = t * 0.5307027145f + (-0.7265760135f); q = q * t + 0.7107068705f; q = q * t + (-0.142248368f); q = q * t + 0.127414796f; q = q * t;
    const f32x2 s = (v * v) * (-0.72134752044f);
    f32x2 e; e.x = __builtin_amdgcn_exp2f(s.x); e.y = __builtin_amdgcn_exp2f(s.y);
    const f32x2 m = v * (q * e), r = v - m;
    f32x2 o; o.x = v.x < 0.f ? m.x : r.x; o.y = v.y < 0.f ? m.y : r.y; return o;
}

template <int ACT  > struct EpiBf16 {
    static constexpr bool PERM = true, AFTER_DRAIN = false, F8 = false; static_assert(ACT == 0 || ACT == 1, "EpiBf16: ACT is 0 (none) or 1 (gelu_pk)");
    bf16_t* O; int ldc; const float* bias; int split_cols; size_t split_stride; float scale0;
    __device__ __forceinline__ void operator()(const f32x4 (&acc)[2][2][4][2], const Unit& u, int wr, int wc, int fr, int fq) const {
        const int row0 = u.pm * BM + wr * 64 + fr; int colt = u.pn * BM; bf16_t* base = O;
        float sc = 1.f; if (split_cols) { const int t = colt / split_cols; base += (size_t)t * split_stride; colt -= t * split_cols; if (t == 0) sc = scale0; }
        const int col0 = colt + wc * 32 + 8 * fq, bcol0 = u.pn * BM + wc * 32 + 8 * fq;
        f32x4 bv[2][2];
#pragma unroll
        for (int bj = 0; bj < 2; ++bj)
#pragma unroll
            for (int n = 0; n < 2; ++n) bv[bj][n] = bias ? *(const f32x4*)(bias + bcol0 + bj * HALF + 4 * n) : (f32x4){0.f, 0.f, 0.f, 0.f};
#pragma unroll
        for (int ai = 0; ai < 2; ++ai)
#pragma unroll
            for (int m = 0; m < 4; ++m) { bf16_t* rowp = base + (size_t)(row0 + ai * HALF + m * 16) * ldc + col0;
#pragma unroll
                for (int bj = 0; bj < 2; ++bj) { f32x4 v0 = acc[ai][bj][m][0] + bv[bj][0], v1 = acc[ai][bj][m][1] + bv[bj][1];
                    if (ACT == 1) { f32x2 a = gelu_pk((f32x2){v0[0], v0[1]}), b = gelu_pk((f32x2){v0[2], v0[3]}), c = gelu_pk((f32x2){v1[0], v1[1]}), d = gelu_pk((f32x2){v1[2], v1[3]});
                        v0 = (f32x4){a.x, a.y, b.x, b.y}; v1 = (f32x4){c.x, c.y, d.x, d.y}; }
                    v0 = v0 * sc; v1 = v1 * sc; u32x4 w; w.x = cvt_pk_bf16(v0[0], v0[1]); w.y = cvt_pk_bf16(v0[2], v0[3]); w.z = cvt_pk_bf16(v1[0], v1[1]); w.w = cvt_pk_bf16(v1[2], v1[3]);
                    *(u32x4*)(rowp + bj * HALF) = w; } }
    }
};

__device__ __forceinline__ float silu_f(float g) { return g * __builtin_amdgcn_rcpf(1.0f + __builtin_amdgcn_exp2f(-1.4426950408889634f * g)); }
struct EpiResF32 {
    static constexpr bool PERM = true, AFTER_DRAIN = false, F8 = false;
    const float* x; bf16_t* y; const float* gate; int ldc; int rows_per_batch; int gate_stride; float alpha;
    __device__ __forceinline__ void operator()(const f32x4 (&acc)[2][2][4][2], const Unit& u, int wr, int wc, int fr, int fq) const {
        const int row0 = u.pm * BM + wr * 64 + fr, col0 = u.pn * BM + wc * 32 + 8 * fq;
        const float* gp = gate + (size_t)((u.pm * BM) / rows_per_batch) * gate_stride + col0;
        f32x4 gv[2][2];
#pragma unroll
        for (int bj = 0; bj < 2; ++bj)
#pragma unroll
            for (int n = 0; n < 2; ++n) gv[bj][n] = *(const f32x4*)(gp + bj * HALF + n * 4) + 1.0f;
#pragma unroll
        for (int ai = 0; ai < 2; ++ai)
#pragma unroll
            for (int m = 0; m < 4; ++m) { const size_t off = (size_t)(row0 + ai * HALF + m * 16) * ldc + col0;
#pragma unroll
                for (int bj = 0; bj < 2; ++bj) { const f32x4 x0 = *(const f32x4*)(x + off + bj * HALF), x1v = *(const f32x4*)(x + off + bj * HALF + 4);
                    const f32x4 v0 = x0 * alpha + gv[bj][0] * acc[ai][bj][m][0], v1 = x1v * alpha + gv[bj][1] * acc[ai][bj][m][1];
                    u32x4 w; w.x = cvt_pk_bf16(v0[0], v0[1]); w.y = cvt_pk_bf16(v0[2], v0[3]); w.z = cvt_pk_bf16(v1[0], v1[1]); w.w = cvt_pk_bf16(v1[2], v1[3]);
                    *(u32x4*)(y + off + bj * HALF) = w; } }
    }
};
struct EpiSwiGLU {
    static constexpr bool PERM = true, AFTER_DRAIN = false, F8 = (MOE_F8 != 0);
    bf16_t* H; const float* wrow; int ldh; int npn;
    __device__ __forceinline__ void operator()(const f32x4 (&acc)[2][2][4][2], const Unit& u, int wr, int wc, int fr, int fq) const {
        const int row0 = u.pm * BM + wr * 64 + fr, col0 = (u.pn % npn) * HALF + wc * 32 + 8 * fq;
        constexpr float inv = F8 ? 1.0f / (F8_SX * F8_SWG) : 1.0f;
#pragma unroll
        for (int ai = 0; ai < 2; ++ai)
#pragma unroll
            for (int m = 0; m < 4; ++m) { const int r = row0 + ai * HALF + m * 16; const float w8 = wrow[r] * inv * (F8 ? F8_SH : 1.0f);
                const f32x4 g0 = acc[ai][0][m][0] * inv, g1 = acc[ai][0][m][1] * inv, u0 = acc[ai][1][m][0] * w8, u1 = acc[ai][1][m][1] * w8;
                float h[8];
#pragma unroll
                for (int q = 0; q < 4; ++q) { h[q] = silu_f(g0[q]) * u0[q]; h[4 + q] = silu_f(g1[q]) * u1[q]; }
                if (F8) {
                    typedef unsigned u32x2 __attribute__((ext_vector_type(2)));
#pragma unroll
                    for (int q = 0; q < 8; ++q) h[q] = __builtin_fminf(__builtin_fmaxf(h[q], -440.0f), 440.0f);
                    int a = __builtin_amdgcn_cvt_pk_fp8_f32(h[0], h[1], 0, false); a = __builtin_amdgcn_cvt_pk_fp8_f32(h[2], h[3], a, true);
                    int b = __builtin_amdgcn_cvt_pk_fp8_f32(h[4], h[5], 0, false); b = __builtin_amdgcn_cvt_pk_fp8_f32(h[6], h[7], b, true);
                    u32x2 w; w.x = (unsigned)a; w.y = (unsigned)b; *(u32x2*)((unsigned char*)H + (size_t)r * ldh + col0) = w;
                } else {
                    u32x4 w; w.x = cvt_pk_bf16(h[0], h[1]); w.y = cvt_pk_bf16(h[2], h[3]); w.z = cvt_pk_bf16(h[4], h[5]); w.w = cvt_pk_bf16(h[6], h[7]);
                    *(u32x4*)(H + (size_t)r * ldh + col0) = w; } }
    }
};
struct EpiDown {
    static constexpr int PERM = Y_BF8 ? 2 : 1; static constexpr bool AFTER_DRAIN = false, F8 = (MOE_F8 != 0);
    bf16_t* Y; int ldc; int npn; int nostore;
    __device__ __forceinline__ void operator()(const f32x4 (&acc)[2][2][4][2], const Unit& u, int wr, int wc, int fr, int fq) const {
        const int row0 = u.pm * BM + wr * 64 + fr;
        if (Y_BF8) {
            const int col0 = (u.pn % npn) * BM + wc * 64 + 16 * fq;
#pragma unroll
            for (int ai = 0; ai < 2; ++ai)
#pragma unroll
                for (int m = 0; m < 4; ++m) { const int r = row0 + ai * HALF + m * 16; u32x4 w;
#pragma unroll
                    for (int bj = 0; bj < 2; ++bj)
#pragma unroll
                        for (int n = 0; n < 2; ++n) { const f32x4 v = acc[ai][bj][m][n] * (F8 ? 1.0f / (F8_SH * F8_SWD) : 1.0f); int a;
                            if (Y_BF8 == 2) { f32x4 sv = v * 64.0f;
#pragma unroll
                                for (int q = 0; q < 4; ++q) sv[q] = __builtin_fminf(__builtin_fmaxf(sv[q], -440.0f), 440.0f);
                                a = __builtin_amdgcn_cvt_pk_fp8_f32(sv[0], sv[1], 0, false); a = __builtin_amdgcn_cvt_pk_fp8_f32(sv[2], sv[3], a, true);
                            } else { a = __builtin_amdgcn_cvt_pk_bf8_f32(v[0], v[1], 0, false); a = __builtin_amdgcn_cvt_pk_bf8_f32(v[2], v[3], a, true); }
                            w[2 * bj + n] = (unsigned)a; }
                    if (!nostore || w.x == 0x12345678u) *(u32x4*)((unsigned char*)Y + (size_t)r * ldc + col0) = w; }
        } else {
            const int col0 = (u.pn % npn) * BM + wc * 32 + 8 * fq;
#pragma unroll
            for (int ai = 0; ai < 2; ++ai)
#pragma unroll
                for (int m = 0; m < 4; ++m) { const int r = row0 + ai * HALF + m * 16;
#pragma unroll
                    for (int bj = 0; bj < 2; ++bj) { const f32x4 v0 = acc[ai][bj][m][0] * (F8 ? 1.0f / (F8_SH * F8_SWD) : 1.0f), v1 = acc[ai][bj][m][1] * (F8 ? 1.0f / (F8_SH * F8_SWD) : 1.0f);
                        u32x4 w; w.x = cvt_pk_bf16(v0[0], v0[1]); w.y = cvt_pk_bf16(v0[2], v0[3]); w.z = cvt_pk_bf16(v1[0], v1[1]); w.w = cvt_pk_bf16(v1[2], v1[3]);
                        if (!nostore || w.x == 0x12345678u) *(u32x4*)(Y + (size_t)r * ldc + col0 + bj * HALF) = w; } }
        }
    }
};
template <bool GATHER_> struct GroupedOrder {
    static constexpr bool GATHER = GATHER_;
    const PG8_LAS unsigned short* tslot; int ntiles, npn, G, c; const unsigned* vtab; int pin = 0;
    __device__ __forceinline__ bool next(int i, Unit& u) const {
        const int L = i * G + c; if (L >= ntiles * npn) return false;
        const int t = L / npn, p = L - t * npn; u.pm = t; u.pn = (int)tslot[t] * npn + p; if (pin) { u.pm = c & 3; u.pn = c & 7; } return true;
    }
    __device__ __forceinline__ void a_ready(const Unit&) const {}
    __device__ __forceinline__ void done(const Unit&) const {}
};


template <class Epi, class Sched, bool ALIGN_EPI = false, bool SP2 = false>
__device__ __forceinline__ void gemm_phase(PG8_LAS unsigned char* lds, const Gemm g, const Sched& S, const Epi& E, const int wid) {
    const int lane = lane_id_v(), tid = wid * 64 + lane, wr = wid >> 2, wc = wid & 3, fr = lane & 15, fq = lane >> 4;
    const int K = g.K, nt = K / BK;
    unsigned voffA[2], voffA1[2], voffB[2];
#pragma unroll
    for (int i = 0; i < 2; ++i) { int R, C; stage_rc(tid * 16 + i * 8192, R, C); const int rho = R & 31;
        const int Rb = ((int)Epi::PERM == 2) ? (64 * (R >> 5) + 16 * ((rho & 15) >> 2) + 4 * (rho >> 4) + (rho & 3)) : (Epi::PERM ? ((R & ~31) + perm32(rho)) : R);
        voffA[i] = (unsigned)(R * K + C) * 2u; voffA1[i] = voffA[i] + (unsigned)(HALF * K * 2); voffB[i] = (unsigned)(Rb * K + C) * 2u; }
    const size_t kstep = (size_t)(BK * 2);
    const size_t hstep = (size_t)HALF * K * 2;
    const size_t tstep = 2 * hstep;
    const size_t bh1 = ((int)Epi::PERM == 2) ? (size_t)8 * K * 2 : hstep;
    const unsigned ldsw = (unsigned)wid * 1024u;
    const int aoff = lds_byte(wr * 64 + fr, fq * 8), boff = lds_byte(wc * 32 + fr, fq * 8);
#define PG8_SA(b, h) (((b) * 2 + (h)) * HTB)
#define PG8_SB(b, h) ((4 + (b) * 2 + (h)) * HTB)
    const __amdgpu_buffer_rsrc_t rs_ = __builtin_amdgcn_make_buffer_rsrc((void*)g.base, (short)0, 0x7ffffff0, 0x00020000);
#define PG8_STAGE(bufoff, gbase, voff) do { _Pragma("unroll") for (int _i = 0; _i < 2; ++_i) \
        __builtin_amdgcn_raw_ptr_buffer_load_lds(rs_, (PG8_LAS unsigned*)(lds + (bufoff) + ldsw + _i * 8192), 16, (int)(voff)[_i], (int)((const char*)(gbase) - (const char*)g.base), 0, 0); } while (0)
#define PG8_STAGE_A1(bufoff, gbase) do { if constexpr (Sched::GATHER) PG8_STAGE(bufoff, gbase, voffA1); else PG8_STAGE(bufoff, (gbase) + hstep, voffA); } while (0)
#define PG8_LDA(dst, b, h) do { if constexpr (Epi::F8) { _Pragma("unroll") for (int m = 0; m < 4; ++m) { const i32x4_ l0_ = *(const PG8_LAS i32x4_*)(lds + PG8_SA(b, h) + aoff + m * 2048), l1_ = *(const PG8_LAS i32x4_*)(lds + PG8_SA(b, h) + aoff + m * 2048 + 1024); dst##8[m] = __builtin_shufflevector(l0_, l1_, 0, 1, 2, 3, 4, 5, 6, 7); } } \
        else { _Pragma("unroll") for (int m = 0; m < 4; ++m) _Pragma("unroll") for (int k = 0; k < 2; ++k) dst[m][k] = *(const PG8_LAS bf16x8*)(lds + PG8_SA(b, h) + aoff + m * 2048 + k * 1024); } } while (0)
#define PG8_LDB(dst, b, h) do { if constexpr (Epi::F8) { _Pragma("unroll") for (int n = 0; n < 2; ++n) { const i32x4_ l0_ = *(const PG8_LAS i32x4_*)(lds + PG8_SB(b, h) + boff + n * 2048), l1_ = *(const PG8_LAS i32x4_*)(lds + PG8_SB(b, h) + boff + n * 2048 + 1024); dst##8[n] = __builtin_shufflevector(l0_, l1_, 0, 1, 2, 3, 4, 5, 6, 7); } } \
        else { _Pragma("unroll") for (int n = 0; n < 2; ++n) _Pragma("unroll") for (int k = 0; k < 2; ++k) dst[n][k] = *(const PG8_LAS bf16x8*)(lds + PG8_SB(b, h) + boff + n * 2048 + k * 1024); } } while (0)
#define PG8_MMA(ai, bj, At, Bt) do { __builtin_amdgcn_s_setprio(1); \
        if constexpr (Epi::F8) { _Pragma("unroll") for (int m = 0; m < 4; ++m) _Pragma("unroll") for (int n = 0; n < 2; ++n) \
                acc[ai][bj][m][n] = __builtin_amdgcn_mfma_scale_f32_16x16x128_f8f6f4(Bt##8[n], At##8[m], acc[ai][bj][m][n], 0, 0, 0, 0x7f7f7f7f, 0, 0x7f7f7f7f); \
        } else { _Pragma("unroll") for (int m = 0; m < 4; ++m) _Pragma("unroll") for (int n = 0; n < 2; ++n) _Pragma("unroll") for (int k = 0; k < 2; ++k) \
        acc[ai][bj][m][n] = __builtin_amdgcn_mfma_f32_16x16x32_bf16(Bt[n][k], At[m][k], acc[ai][bj][m][n], 0, 0, 0); } __builtin_amdgcn_s_setprio(0); } while (0)
#define PG8_WAIT_V(n) asm volatile("s_waitcnt vmcnt(" #n ")" ::: "memory")
#define PG8_WAIT_L(n) asm volatile("s_waitcnt lgkmcnt(" #n ")" ::: "memory")
#define PG8_BAR __builtin_amdgcn_s_barrier()
#define PG8_SCHED __builtin_amdgcn_sched_barrier(0)
    Unit cur, nxt; int ui = 0;
    if (!S.next(0, cur)) return;
    f32x4 acc[2][2][4][2];
#pragma unroll
    for (int a = 0; a < 2; ++a)
#pragma unroll
        for (int b = 0; b < 2; ++b)
#pragma unroll
            for (int m = 0; m < 4; ++m)
#pragma unroll
                for (int n = 0; n < 2; ++n) { acc[a][b][m][n] = (f32x4){0.f, 0.f, 0.f, 0.f}; if constexpr (Epi::F8) asm volatile("" : "+v"(acc[a][b][m][n])); }
    typedef int i32x4_ __attribute__((ext_vector_type(4))); typedef int i32x8_ __attribute__((ext_vector_type(8)));
    bf16x8 At[4][2], B0[2][2], B1[2][2]; i32x8_ At8[4], B08[2], B18[2];
    const char* cA = Sched::GATHER ? (const char*)g.A : (const char*)g.A + (size_t)cur.pm * tstep; const char* cB = (const char*)g.Bt + (size_t)cur.pn * tstep;
    S.a_ready(cur);
    if constexpr (Sched::GATHER) {
        static_assert(SP2, "gather: SP2 loop only");
        __builtin_amdgcn_global_load_lds((const unsigned*)(S.vtab + ((size_t)0 * 512 + tid) * 4), (PG8_LAS unsigned*)(lds + VT_SLOT + wid * 1024), 16, 0, 0);
        PG8_WAIT_V(0);
        const u32x4 e4 = *(const PG8_LAS u32x4*)(lds + VT_SLOT + tid * 16); voffA[0] = e4.x; voffA[1] = e4.y; voffA1[0] = e4.z; voffA1[1] = e4.w;
    }
    if constexpr (SP2) {
        PG8_STAGE(PG8_SB(0, 0), cB, voffB); PG8_STAGE(PG8_SB(0, 1), cB + bh1, voffB); PG8_STAGE(PG8_SA(0, 0), cA, voffA); PG8_STAGE_A1(PG8_SA(0, 1), cA);
        if (wr == 1) PG8_BAR;
        PG8_WAIT_V(2); PG8_BAR;
        PG8_STAGE(PG8_SB(1, 0), cB + kstep, voffB); PG8_STAGE(PG8_SA(1, 0), cA + kstep, voffA); PG8_STAGE(PG8_SB(1, 1), cB + bh1 + kstep, voffB);
        PG8_WAIT_V(6); PG8_BAR;
    } else {
        PG8_STAGE(PG8_SB(0, 0), cB, voffB); PG8_STAGE(PG8_SA(0, 0), cA, voffA); PG8_STAGE(PG8_SB(0, 1), cB + hstep, voffB); PG8_STAGE(PG8_SA(0, 1), cA + hstep, voffA);
        if (wr == 1) PG8_BAR;
        PG8_WAIT_V(4); PG8_BAR;
        PG8_STAGE(PG8_SB(1, 0), cB + kstep, voffB); PG8_STAGE(PG8_SA(1, 0), cA + kstep, voffA); PG8_STAGE(PG8_SB(1, 1), cB + hstep + kstep, voffB);
        PG8_WAIT_V(6); PG8_BAR;
    }
    for (;;) {
        const bool has_next = S.next(ui + 1, nxt);
        const char* nA = (has_next && !Sched::GATHER) ? (const char*)g.A + (size_t)nxt.pm * tstep : cA; const char* nB = has_next ? (const char*)g.Bt + (size_t)nxt.pn * tstep : cB;
        for (int t = 0; t < nt; t += 2) {
            const bool last = (t == nt - 2);
            const char* a1 = cA + (size_t)(t + 1) * kstep;
            const char* a2 = last ? nA : cA + (size_t)(t + 2) * kstep; const char* b2 = last ? nB : cB + (size_t)(t + 2) * kstep;
            const char* a3 = a2 + kstep; const char* b3 = b2 + kstep;
            if (last && has_next) S.a_ready(nxt);
            if constexpr (SP2) {
            if constexpr (Sched::GATHER) { if (t == 0 && has_next)
                __builtin_amdgcn_global_load_lds((const unsigned*)(S.vtab + ((size_t)(ui + 1) * 512 + tid) * 4), (PG8_LAS unsigned*)(lds + VT_SLOT + wid * 1024), 16, 0, 0); }
            PG8_LDB(B0, 0, 0); PG8_LDB(B1, 0, 1); PG8_SCHED; PG8_LDA(At, 0, 0); PG8_STAGE_A1(PG8_SA(1, 1), a1);
            PG8_WAIT_V(8); PG8_WAIT_L(0); PG8_BAR; PG8_MMA(0, 0, At, B0); PG8_MMA(0, 1, At, B1); PG8_BAR; PG8_SCHED;
            if constexpr (Sched::GATHER) { if (last && has_next) {
                const u32x4 e4 = *(const PG8_LAS u32x4*)(lds + VT_SLOT + tid * 16); voffA[0] = e4.x; voffA[1] = e4.y; voffA1[0] = e4.z; voffA1[1] = e4.w; } }
            PG8_LDA(At, 0, 1); PG8_STAGE(PG8_SB(0, 0), b2, voffB); PG8_STAGE(PG8_SB(0, 1), b2 + bh1, voffB); PG8_STAGE(PG8_SA(0, 0), a2, voffA);
            PG8_WAIT_V(8); PG8_WAIT_L(0); PG8_BAR; PG8_MMA(1, 0, At, B0); PG8_MMA(1, 1, At, B1); PG8_BAR; PG8_SCHED;
            PG8_LDB(B0, 1, 0); PG8_LDB(B1, 1, 1); PG8_SCHED; PG8_LDA(At, 1, 0); PG8_STAGE_A1(PG8_SA(0, 1), a2);
            PG8_WAIT_V(8); PG8_WAIT_L(0); PG8_BAR; PG8_MMA(0, 0, At, B0); PG8_MMA(0, 1, At, B1); PG8_BAR; PG8_SCHED;
            PG8_LDA(At, 1, 1); PG8_STAGE(PG8_SB(1, 0), b3, voffB); PG8_STAGE(PG8_SB(1, 1), b3 + bh1, voffB); PG8_STAGE(PG8_SA(1, 0), a3, voffA);
            PG8_WAIT_V(8); PG8_WAIT_L(0); PG8_BAR; PG8_MMA(1, 0, At, B0); PG8_MMA(1, 1, At, B1); PG8_BAR; PG8_SCHED;
            } else {
            PG8_LDB(B0, 0, 0); PG8_SCHED; PG8_LDA(At, 0, 0); PG8_STAGE(PG8_SA(1, 1), a1 + hstep, voffA);
            PG8_WAIT_L(8); PG8_BAR; PG8_WAIT_L(0); PG8_MMA(0, 0, At, B0); PG8_BAR; PG8_SCHED;
            PG8_LDB(B1, 0, 1); PG8_STAGE(PG8_SB(0, 0), b2, voffB);
            PG8_BAR; PG8_WAIT_L(0); PG8_MMA(0, 1, At, B1); PG8_BAR;
            PG8_LDA(At, 0, 1); PG8_STAGE(PG8_SA(0, 0), a2, voffA);
            PG8_BAR; PG8_WAIT_L(0); PG8_MMA(1, 0, At, B0); PG8_BAR; PG8_SCHED;
            PG8_STAGE(PG8_SB(0, 1), b2 + hstep, voffB);
            PG8_WAIT_V(6); PG8_BAR; PG8_MMA(1, 1, At, B1); PG8_BAR;
            PG8_LDB(B0, 1, 0); PG8_SCHED; PG8_LDA(At, 1, 0); PG8_STAGE(PG8_SA(0, 1), a2 + hstep, voffA);
            PG8_WAIT_L(8); PG8_BAR; PG8_WAIT_L(0); PG8_MMA(0, 0, At, B0); PG8_BAR; PG8_SCHED;
            PG8_LDB(B1, 1, 1); PG8_STAGE(PG8_SB(1, 0), b3, voffB);
            PG8_BAR; PG8_WAIT_L(0); PG8_MMA(0, 1, At, B1); PG8_BAR;
            PG8_LDA(At, 1, 1); PG8_STAGE(PG8_SA(1, 0), a3, voffA);
            PG8_BAR; PG8_WAIT_L(0); PG8_MMA(1, 0, At, B0); PG8_BAR; PG8_SCHED;
            PG8_STAGE(PG8_SB(1, 1), b3 + hstep, voffB);
            PG8_WAIT_V(6); PG8_BAR; PG8_MMA(1, 1, At, B1); PG8_BAR;
            }
        }
        if constexpr (ALIGN_EPI) { if (wr == 0) PG8_BAR; }
        if constexpr (!Epi::AFTER_DRAIN) { E(acc, cur, wr, wc, fr, fq); S.done(cur); }
        if (!has_next) break;
#pragma unroll
        for (int a = 0; a < 2; ++a)
#pragma unroll
            for (int b = 0; b < 2; ++b)
#pragma unroll
                for (int m = 0; m < 4; ++m)
#pragma unroll
                    for (int n = 0; n < 2; ++n) acc[a][b][m][n] = (f32x4){0.f, 0.f, 0.f, 0.f};
        cur = nxt; cA = nA; cB = nB; ++ui;
        if constexpr (ALIGN_EPI) { if (wr == 1) PG8_BAR; }
    }
    PG8_WAIT_V(0);
    if constexpr (!ALIGN_EPI) { if (wr == 0) PG8_BAR; }
    PG8_BAR;
    if constexpr (Epi::AFTER_DRAIN) { E.fused(acc, cur, wr, wc, fr, fq, lds, wid, lane); S.done(cur); }
#undef PG8_SA
#undef PG8_SB
#undef PG8_STAGE
#undef PG8_LDA
#undef PG8_LDB
#undef PG8_MMA
#undef PG8_WAIT_V
#undef PG8_WAIT_L
#undef PG8_BAR
#undef PG8_SCHED
}
}

#ifndef PG8_SP2
#define PG8_SP2 true
#endif
#ifndef PG8_ALIGN
#define PG8_ALIGN true
#endif
#ifndef DOWN_STAGGER
#define DOWN_STAGGER 0
#endif
#ifndef CONV_NT
#define CONV_NT 1
#endif
#ifndef P6_MIN_CONV
#define P6_MIN_CONV 32
#endif
#ifndef PROBE_STAMP
#define PROBE_STAMP -1
#endif
#ifndef PROBE_PIN
#define PROBE_PIN 0
#endif
#ifndef PROBE_NOSTORE
#define PROBE_NOSTORE 0
#endif
#ifndef REP_PHASE
#define REP_PHASE -1
#endif
#ifndef MK_PER_PHASE
#define MK_PER_PHASE 0
#endif

constexpr int NB = 2, SEQ = 4096, D = 2048, M = NB * SEQ;
constexpr int AW = 1024, NQH = 16, NKVH = 4, HD = 64, KVW = 256, CW = 1024, INW = 4608;
constexpr int COL_K = 1024, COL_V = 1280, COL_CB = 1536, COL_CC = 2560, COL_CH = 3584;
constexpr int NE = 64, TOPK = 8, DE = 512, NSLOT = NE + 1;
constexpr int MAXT = 32 + 256 + 64, MAXR = MAXT * 256;
constexpr float ALPHA = 1.189207115002721f;
constexpr float LN_EPS = 1e-5f, RSCALE = 2.5f;
constexpr int NWAVES = 8, NTHR = 512;
constexpr int KSL = 8;

constexpr size_t MiB = 1u << 20;
constexpr size_t WS_CTL = 0, CTL_ZERO_BYTES = 1 * MiB;
constexpr size_t WS_PART = 1 * MiB;
constexpr size_t WS_MODF = 2 * MiB;
constexpr size_t WS_WRT = 3 * MiB;
constexpr size_t WS_ROWTOK = 4 * MiB;
constexpr size_t WS_ROWW = 6 * MiB;
constexpr size_t WS_TOKSLOT = 8 * MiB;
constexpr size_t WS_WROW = 9 * MiB;
constexpr size_t WS_WINT = 10 * MiB;
constexpr size_t WS_WOUTT = 28 * MiB;
constexpr size_t WS_WGUT = 36 * MiB;
constexpr size_t WS_WDT = 296 * MiB;
constexpr size_t WS_X1 = 426 * MiB;
constexpr size_t WS_H = 490 * MiB;
constexpr size_t WS_XG = 578 * MiB;
constexpr size_t WS_HB = 610 * MiB;
constexpr size_t WS_PROJ = 642 * MiB;
constexpr size_t WS_MIX = 714 * MiB;
constexpr size_t WS_Y1 = 746 * MiB;
constexpr size_t WS_VTAB = 930 * MiB;
constexpr size_t WS_END = 946 * MiB;
static_assert(WS_XG + (size_t)MAXR * D * 2 <= WS_VTAB && WS_H + (size_t)MAXR * DE * 2 <= WS_XG && WS_Y1 + (size_t)M * D * 4 <= WS_VTAB, "ws map");
static_assert(WS_WGUT + (size_t)NSLOT * 1024 * D * 2 <= WS_WDT && WS_WDT + (size_t)NSLOT * D * DE * 2 <= WS_X1 && WS_X1 + (size_t)M * D * 4 <= WS_H, "ws map 2");
constexpr int CW_TMO = 0;
constexpr int CW_BAR = 4096;
constexpr int CW_Q = 8192;
constexpr int CW_FIN = 8448;
constexpr int CW_CNT = 16384;

constexpr int RING_OFF = 0, RING_BYTES = 131072;
constexpr int LDSCTL_OFF = RING_BYTES, MISC_OFF = LDSCTL_OFF + 320;
constexpr int TS_OFF = LDSCTL_OFF + 512;
constexpr int POFF_OFF = LDSCTL_OFF + 1280;
constexpr int LDS_BYTES = 147456;

#define GAS __attribute__((address_space(1)))
#define LAS __attribute__((address_space(3)))
typedef unsigned short bf16;
typedef unsigned v4u __attribute__((ext_vector_type(4)));
typedef unsigned v2u __attribute__((ext_vector_type(2)));
typedef float f32x4 __attribute__((ext_vector_type(4)));
typedef short bf16x8 __attribute__((ext_vector_type(8)));
typedef GAS unsigned gu32;
#define RLX_AGENT __ATOMIC_RELAXED, __HIP_MEMORY_SCOPE_AGENT
#define LDS_WAIT() asm volatile("s_waitcnt lgkmcnt(0)" ::: "memory")
#define VM_WAIT() asm volatile("s_waitcnt vmcnt(0)" ::: "memory")
__device__ __forceinline__ unsigned f2bf(float f) { unsigned u = __builtin_bit_cast(unsigned, f); return (u + 0x7fffu + ((u >> 16) & 1u)) >> 16; }
__device__ __forceinline__ unsigned pk2(float lo, float hi) { return f2bf(lo) | (f2bf(hi) << 16); }
__device__ __forceinline__ float bf2f(unsigned h) { return __builtin_bit_cast(float, h << 16); }
__device__ __forceinline__ float bflo(unsigned w) { return __builtin_bit_cast(float, w << 16); }
__device__ __forceinline__ float bfhi(unsigned w) { return __builtin_bit_cast(float, w & 0xffff0000u); }

#define XB_TMO      128
#define XB_XCNT(j)  (256  + 64 * (j))
#define XB_XSUB(j)  (1280 + 64 * (j))
#define XB_XGEN(j)  (2304 + 64 * (j))
#define XB_TOP      3328
#define XB_TOPGEN   3392
#define XCD_BAR_WORDS 3456
#define XB_SPIN_CAP (1u << 18)
__device__ __forceinline__ unsigned xb_ld(unsigned* p)              { return __hip_atomic_load(p, __ATOMIC_RELAXED, __HIP_MEMORY_SCOPE_AGENT); }
__device__ __forceinline__ unsigned xb_add(unsigned* p, unsigned v) { return __hip_atomic_fetch_add(p, v, __ATOMIC_RELAXED, __HIP_MEMORY_SCOPE_AGENT); }
__device__ __forceinline__ unsigned xb_xcc_id() { return (unsigned)__builtin_amdgcn_s_getreg((3 << 11) | 20) & 0xFu; }
#define XB_SPIN(cond, bar) do { unsigned _sp = 0; while (cond) { __builtin_amdgcn_s_sleep(1); \
    if ((++_sp & 255u) == 0u) { if (xb_ld(&(bar)[XB_TMO])) break; if (_sp > XB_SPIN_CAP) { atomicAdd(&(bar)[XB_TMO], 1u); break; } } } } while (0)
struct XcdBarrier { unsigned* bar; unsigned x; volatile LAS unsigned* st; };
__device__ __forceinline__ XcdBarrier xcd_barrier_post(unsigned* bar, volatile LAS unsigned* st) {
    XcdBarrier b; b.bar = bar; b.x = xb_xcc_id(); b.st = st;
    if (threadIdx.x == 0) (void)xb_add(&bar[XB_XCNT(b.x)], 1u);
    return b;
}
__device__ __forceinline__ void xcd_barrier_complete(unsigned* bar, unsigned x, unsigned& nloc, unsigned& nx) {
    const unsigned G = gridDim.x * gridDim.y * gridDim.z;
    unsigned sum, cnt, mine, sp = 0u;
    for (;;) {
        sum = 0u; cnt = 0u; mine = 0u;
#pragma unroll
        for (unsigned j = 0; j < 16; ++j) { const unsigned c = xb_ld(&bar[XB_XCNT(j)]); sum += c; cnt += (c > 0u) ? 1u : 0u; mine = (j == x) ? c : mine; }
        if (sum == G) break;
        __builtin_amdgcn_s_sleep(1);
        if ((++sp & 255u) == 0u) { if (xb_ld(&bar[XB_TMO])) break; if (sp > XB_SPIN_CAP) { atomicAdd(&bar[XB_TMO], 1u); break; } }
    }
    nloc = mine > 0u ? mine : 1u; nx = cnt > 0u ? cnt : 1u;
}
__device__ __forceinline__ void xcd_barrier(const XcdBarrier& b) {
    asm volatile("s_waitcnt vmcnt(0)" ::: "memory");
    __syncthreads();
    if (threadIdx.x == 0) {
        unsigned* bar = b.bar;
        __builtin_amdgcn_s_waitcnt(0);
        unsigned nloc = b.st[0], nx = b.st[1];
        if (nloc == 0u) { xcd_barrier_complete(bar, b.x, nloc, nx); b.st[0] = nloc; b.st[1] = nx; }
        const unsigned old = xb_add(&bar[XB_XSUB(b.x)], 1u);
        const unsigned gen = old / nloc;
        if (old + 1u == (gen + 1u) * nloc) {
            __builtin_amdgcn_fence(__ATOMIC_RELEASE, "agent");
            asm volatile("s_waitcnt vmcnt(0)" ::: "memory");
            const unsigned og = xb_add(&bar[XB_TOP], 1u);
            const unsigned tg = og / nx;
            if (og + 1u == (tg + 1u) * nx) xb_add(&bar[XB_TOPGEN], 1u);
            else XB_SPIN(xb_ld(&bar[XB_TOPGEN]) == tg, bar);
            __builtin_amdgcn_fence(__ATOMIC_ACQUIRE, "agent");
            xb_add(&bar[XB_XGEN(b.x)], 1u);
            asm volatile("s_waitcnt vmcnt(0)" ::: "memory");
        } else {
            XB_SPIN(xb_ld(&bar[XB_XGEN(b.x)]) == gen, bar);
            __builtin_amdgcn_fence(__ATOMIC_ACQUIRE, "agent");
            asm volatile("s_waitcnt vmcnt(0)" ::: "memory");
        }
    }
    __syncthreads();
}

struct Frame {
    LAS unsigned char* lds;
    volatile LAS unsigned* MISC;
    gu32* ctl;
    int tid, lane, wave;
    int vcu, G;
    unsigned char* ws;
    const float *x, *c, *w_mod, *b_mod, *w_in, *conv_w, *sinks, *w_out, *ln1_g, *ln1_b, *w_router, *router_bias, *w_gate, *w_up, *w_down, *ws_gate, *ws_up, *ws_down, *ln2_g, *ln2_b;
    float* out;
};
__device__ __forceinline__ float wave_sum(float v) {
#pragma unroll
    for (int o = 1; o < 64; o <<= 1) v += __shfl_xor(v, o);
    return v;
}

__device__ __forceinline__ void p0_transpose_item(const float* src, int ldw, bf16* dst, int ldt, LAS float* scr, int lane) {
    { const float* sp = src + (size_t)(lane >> 5) * ldw + (lane & 31); LAS float* dp = scr + (lane >> 5) * 33 + (lane & 31);
#pragma unroll 1
      for (int h = 0; h < 2; ++h) { float tv[16];
#pragma unroll
        for (int i = 0; i < 16; ++i) tv[i] = sp[(size_t)(2 * i) * ldw];
#pragma unroll
        for (int i = 0; i < 16; ++i) dp[(2 * i) * 33] = tv[i];
        sp += (size_t)32 * ldw; dp += 32 * 33; } }
    LDS_WAIT(); asm volatile("" ::: "memory");
    const int c = lane & 7;
#pragma unroll
    for (int j = 0; j < 4; ++j) { const int n = (lane >> 3) + 8 * j; const LAS float* s = scr + (8 * c) * 33 + n;
        v4u o; o.x = pk2(s[0 * 33], s[1 * 33]); o.y = pk2(s[2 * 33], s[3 * 33]); o.z = pk2(s[4 * 33], s[5 * 33]); o.w = pk2(s[6 * 33], s[7 * 33]);
        *(GAS v4u*)(dst + (size_t)n * ldt + 8 * c) = o; }
    LDS_WAIT(); asm volatile("" ::: "memory");
}
constexpr int SCRP = 136;
__device__ __forceinline__ void conv64(const float* src, int ldw, bf16* dst, int ldt, LAS unsigned char* scr, int lane) {
    const int kr = lane >> 4, nq = lane & 15;
    const float* sp = src + (size_t)kr * ldw + 4 * nq;
    f32x4 tv[16];
#pragma unroll
    for (int i = 0; i < 16; ++i) tv[i] = CONV_NT ? __builtin_nontemporal_load((const GAS f32x4*)(sp + (size_t)(4 * i) * ldw)) : *(const GAS f32x4*)(sp + (size_t)(4 * i) * ldw);
#pragma unroll
    for (int i = 0; i < 16; ++i) { v2u w; w.x = pk2(tv[i].x, tv[i].y); w.y = pk2(tv[i].z, tv[i].w); *(LAS v2u*)(scr + (4 * i + kr) * SCRP + 8 * nq) = w; }
    LDS_WAIT(); asm volatile("" ::: "memory");
    const int c = lane & 7;
#pragma unroll
    for (int j = 0; j < 8; ++j) { const int n = (lane >> 3) + 8 * j; const LAS unsigned short* p = (const LAS unsigned short*)(scr + (8 * c) * SCRP + 2 * n);
        v4u o; o.x = (unsigned)p[0] | ((unsigned)p[SCRP / 2] << 16); o.y = (unsigned)p[2 * (SCRP / 2)] | ((unsigned)p[3 * (SCRP / 2)] << 16);
        o.z = (unsigned)p[4 * (SCRP / 2)] | ((unsigned)p[5 * (SCRP / 2)] << 16); o.w = (unsigned)p[6 * (SCRP / 2)] | ((unsigned)p[7 * (SCRP / 2)] << 16);
        if (CONV_NT) __builtin_nontemporal_store(o, (GAS v4u*)(dst + (size_t)n * ldt + 8 * c)); else *(GAS v4u*)(dst + (size_t)n * ldt + 8 * c) = o; }
    LDS_WAIT(); asm volatile("" ::: "memory");
}
constexpr int SCRP8 = 68;
__device__ __forceinline__ void conv64_f8(const float* src, int ldw, unsigned char* dst, int ldt, LAS unsigned char* scr, int lane, float scale) {
    const int kr = lane >> 4, nq = lane & 15;
    const float* sp = src + (size_t)kr * ldw + 4 * nq;
    f32x4 tv[16];
#pragma unroll
    for (int i = 0; i < 16; ++i) tv[i] = CONV_NT ? __builtin_nontemporal_load((const GAS f32x4*)(sp + (size_t)(4 * i) * ldw)) : *(const GAS f32x4*)(sp + (size_t)(4 * i) * ldw);
#pragma unroll
    for (int i = 0; i < 16; ++i) { const f32x4 t = tv[i] * scale; int a = __builtin_amdgcn_cvt_pk_fp8_f32(t.x, t.y, 0, false); a = __builtin_amdgcn_cvt_pk_fp8_f32(t.z, t.w, a, true);
        *(LAS unsigned*)(scr + (4 * i + kr) * SCRP8 + 4 * nq) = (unsigned)a; }
    LDS_WAIT(); asm volatile("" ::: "memory");
    const int c = lane & 3;
#pragma unroll
    for (int j = 0; j < 4; ++j) { const int n = (lane >> 2) + 16 * j; const LAS unsigned char* p = scr + (16 * c) * SCRP8 + n;
        unsigned o[4];
#pragma unroll
        for (int q = 0; q < 4; ++q) o[q] = (unsigned)p[(4 * q) * SCRP8] | ((unsigned)p[(4 * q + 1) * SCRP8] << 8) | ((unsigned)p[(4 * q + 2) * SCRP8] << 16) | ((unsigned)p[(4 * q + 3) * SCRP8] << 24);
        v4u ov; ov.x = o[0]; ov.y = o[1]; ov.z = o[2]; ov.w = o[3];
        if (CONV_NT) __builtin_nontemporal_store(ov, (GAS v4u*)(dst + (size_t)n * ldt + 16 * c)); else *(GAS v4u*)(dst + (size_t)n * ldt + 16 * c) = ov; }
    LDS_WAIT(); asm volatile("" ::: "memory");
}
__device__ __forceinline__ void p0_transpose_item_hilo(const float* src, int ldw, bf16* dhi, bf16* dlo, int ldt, LAS float* scr, int lane) {
    { const float* sp = src + (size_t)(lane >> 5) * ldw + (lane & 31); LAS float* dp = scr + (lane >> 5) * 33 + (lane & 31);
#pragma unroll 1
      for (int h = 0; h < 2; ++h) { float tv[16];
#pragma unroll
        for (int i = 0; i < 16; ++i) tv[i] = sp[(size_t)(2 * i) * ldw];
#pragma unroll
        for (int i = 0; i < 16; ++i) dp[(2 * i) * 33] = tv[i];
        sp += (size_t)32 * ldw; dp += 32 * 33; } }
    LDS_WAIT(); asm volatile("" ::: "memory");
    const int c = lane & 7;
#pragma unroll
    for (int j = 0; j < 4; ++j) { const int n = (lane >> 3) + 8 * j; const LAS float* s = scr + (8 * c) * 33 + n;
        float v[8]; unsigned h[8], l[8];
#pragma unroll
        for (int q = 0; q < 8; ++q) { v[q] = s[q * 33]; h[q] = f2bf(v[q]); l[q] = f2bf(v[q] - bf2f(h[q])); }
        v4u o; o.x = h[0] | (h[1] << 16); o.y = h[2] | (h[3] << 16); o.z = h[4] | (h[5] << 16); o.w = h[6] | (h[7] << 16);
        *(GAS v4u*)(dhi + (size_t)n * ldt + 8 * c) = o;
        o.x = l[0] | (l[1] << 16); o.y = l[2] | (l[3] << 16); o.z = l[4] | (l[5] << 16); o.w = l[6] | (l[7] << 16);
        *(GAS v4u*)(dlo + (size_t)n * ldt + 8 * c) = o; }
    LDS_WAIT(); asm volatile("" ::: "memory");
}
constexpr int I_G = (D / 64) * (DE / 64), I_D = (DE / 64) * (D / 64);
constexpr int QB_ITEMS = NE * 2 * I_G, QC_ITEMS = NE * I_D, CONV_CH = 8;
__device__ __forceinline__ void conv_item_gu(Frame& F, int s, int q, LAS float* scr) {
    const int up = q / I_G, q2 = q % I_G, nblk = DE / 64, kb = q2 / nblk, nb = q2 % nblk, n0 = 64 * nb;
    const float* W = up ? (s == 0 ? F.ws_up : F.w_up + (size_t)(s - 1) * D * DE) : (s == 0 ? F.ws_gate : F.w_gate + (size_t)(s - 1) * D * DE);
    const int drow = s * 1024 + (n0 >> 7) * 256 + up * 128 + (n0 & 127);
    if (MOE_F8) conv64_f8(W + (size_t)(64 * kb) * DE + n0, DE, (unsigned char*)(F.ws + WS_WGUT) + (size_t)drow * D + 64 * kb, D, (LAS unsigned char*)scr, F.lane, pg8::F8_SWG);
    else conv64(W + (size_t)(64 * kb) * DE + n0, DE, (bf16*)(F.ws + WS_WGUT) + (size_t)drow * D + 64 * kb, D, (LAS unsigned char*)scr, F.lane);
}
__device__ __forceinline__ void conv_item_dn(Frame& F, int s, int q, LAS float* scr) {
    const int nblk = D / 64, kb = q / nblk, nb = q % nblk;
    const float* W = (s == 0 ? F.ws_down : F.w_down + (size_t)(s - 1) * DE * D);
    if (MOE_F8) conv64_f8(W + (size_t)(64 * kb) * D + 64 * nb, D, (unsigned char*)(F.ws + WS_WDT) + (size_t)(s * D + 64 * nb) * DE + 64 * kb, DE, (LAS unsigned char*)scr, F.lane, pg8::F8_SWD);
    else conv64(W + (size_t)(64 * kb) * D + 64 * nb, D, (bf16*)(F.ws + WS_WDT) + (size_t)(s * D + 64 * nb) * DE + 64 * kb, DE, (LAS unsigned char*)scr, F.lane);
}
__device__ __forceinline__ void drain(Frame& F, int which, int fin_idx, unsigned target) {
    LAS float* scr = (LAS float*)(F.lds + RING_OFF + 32768 + F.wave * 12288);
    const unsigned total = which ? (unsigned)QC_ITEMS : (unsigned)QB_ITEMS;
    for (;;) {
        if (F.tid == 0) {
            unsigned base = 0xffffffffu; bool go = true;
            if (fin_idx >= 0) go = __hip_atomic_load(F.ctl + fin_idx, RLX_AGENT) < target;
            if (go) base = __hip_atomic_fetch_add(F.ctl + CW_Q + 64 * which, (unsigned)CONV_CH, RLX_AGENT);
            F.MISC[16] = base;
        }
        __syncthreads();
        const unsigned base = F.MISC[16];
        __syncthreads();
        if (base >= total) break;
        for (int j = F.wave; j < CONV_CH; j += NWAVES) { const unsigned r = base + j; if (r < total) { if (which) conv_item_dn(F, 1 + (int)(r / I_D), (int)(r % I_D), scr); else conv_item_gu(F, 1 + (int)(r / (2 * I_G)), (int)(r % (2 * I_G)), scr); } }
    }
}
__device__ __forceinline__ void phase_fin(Frame& F, int fin_idx) { __syncthreads(); if (F.tid == 0) __hip_atomic_fetch_add(F.ctl + fin_idx, 1u, RLX_AGENT); }

__device__ __forceinline__ void p0_gemv(Frame& F, int c0, int c1) {
    {
        __syncthreads();
        LAS float* cs = (LAS float*)(F.lds + RING_OFF);
        LAS float* red = (LAS float*)(F.lds + RING_OFF + 16384);
        for (int i = F.tid; i < NB * D; i += NTHR) { const float v = F.c[i]; cs[i] = v / (1.0f + __expf(-v)); }
        __syncthreads();
        float* part = (float*)(F.ws + WS_PART);
        const int nch = c1 - c0;
        for (int it = blockIdx.x; it < nch * KSL; it += F.G) {
            const int chunk = c0 + it % nch, sl = it / nch, k0 = sl * (D / KSL) + F.wave * 32;
            const float* wp = F.w_mod + (size_t)k0 * (6 * D) + chunk * 256 + F.lane * 4;
            f32x4 a0 = {0.f, 0.f, 0.f, 0.f}, a1 = {0.f, 0.f, 0.f, 0.f};
#pragma unroll 8
            for (int k = 0; k < 32; ++k) { const f32x4 w = *(const GAS f32x4*)(wp + (size_t)k * (6 * D)); const float c0 = cs[k0 + k], c1 = cs[D + k0 + k]; a0 += w * c0; a1 += w * c1; }
            *(LAS f32x4*)(red + (F.wave * 2 + 0) * 256 + F.lane * 4) = a0;
            *(LAS f32x4*)(red + (F.wave * 2 + 1) * 256 + F.lane * 4) = a1;
            __syncthreads();
            { const int b = F.tid >> 8, col = F.tid & 255; float s = 0.f;
#pragma unroll
              for (int w = 0; w < 8; ++w) s += red[(w * 2 + b) * 256 + col];
              part[((size_t)sl * 2 + b) * (6 * D) + chunk * 256 + col] = s; }
            __syncthreads();
        }
    }
}
__device__ __forceinline__ void p0_static_conv(Frame& F) {
    __syncthreads();
    LAS float* scr = (LAS float*)(F.lds + RING_OFF + 32768 + F.wave * 12288);
    const int gw = F.vcu * NWAVES + F.wave, NGW = F.G * NWAVES;
    constexpr int I_IN = (D / 64) * (INW / 64), I_OUT = (D / 64) * (D / 64), I_R = (D / 64) * (NE / 32);
    constexpr int NITEMS = I_IN + I_OUT + (2 * I_G + I_D) + I_R;
    bf16* WinT = (bf16*)(F.ws + WS_WINT); bf16* WoutT = (bf16*)(F.ws + WS_WOUTT);
    bf16* WrHi = (bf16*)(F.ws + WS_WRT); bf16* WrLo = WrHi + NE * D;
    for (int it = gw; it < NITEMS; it += NGW) {
        int r = it;
        if (r < I_IN) { const int nblk = INW / 64, kb = r / nblk, nb = r % nblk; conv64(F.w_in + (size_t)(64 * kb) * INW + 64 * nb, INW, WinT + (size_t)(64 * nb) * D + 64 * kb, D, (LAS unsigned char*)scr, F.lane); continue; } r -= I_IN;
        if (r < I_OUT) { const int nblk = D / 64, kb = r / nblk, nb = r % nblk; conv64(F.w_out + (size_t)(64 * kb) * D + 64 * nb, D, WoutT + (size_t)(64 * nb) * D + 64 * kb, D, (LAS unsigned char*)scr, F.lane); continue; } r -= I_OUT;
        if (r < 2 * I_G) { conv_item_gu(F, 0, r, scr); continue; } r -= 2 * I_G;
        if (r < I_D) { conv_item_dn(F, 0, r, scr); continue; } r -= I_D;
        { const int nblk = NE / 32, kb = r / nblk, nb = r % nblk;
          p0_transpose_item_hilo(F.w_router + (size_t)(64 * kb) * NE + 32 * nb, NE, WrHi + (size_t)(32 * nb) * D + 64 * kb, WrLo + (size_t)(32 * nb) * D + 64 * kb, D, scr, F.lane); }
    }
}

__device__ __forceinline__ void modf_reduce(Frame& F) {
    const float* part = (const float*)(F.ws + WS_PART); float* modf = (float*)(F.ws + WS_MODF);
    const int idx = blockIdx.x * NTHR + F.tid;
    if (idx < NB * 6 * D) { const int b = idx / (6 * D), j = idx % (6 * D); float s = F.b_mod[j];
#pragma unroll
        for (int sl = 0; sl < KSL; ++sl) s += part[((size_t)sl * 2 + b) * (6 * D) + j];
        modf[idx] = s; }
}
__device__ __forceinline__ void p1a_modulate(Frame& F) {
    const float* part = (const float*)(F.ws + WS_PART);
    LAS float* sm = (LAS float*)(F.lds + RING_OFF);
    bf16* hb = (bf16*)(F.ws + WS_HB);
    for (int r0 = F.vcu * 32; r0 < M; r0 += F.G * 32) {
        const int b = r0 / SEQ;
        __syncthreads();
        for (int i = F.tid; i < 2 * D; i += NTHR) { float s = F.b_mod[i];
#pragma unroll
            for (int sl = 0; sl < KSL; ++sl) s += part[((size_t)sl * 2 + b) * (6 * D) + i];
            sm[i] = s; }
        __syncthreads();
#pragma unroll 1
        for (int rr = 0; rr < 4; ++rr) {
            const int m = r0 + F.wave * 4 + rr; const GAS f32x4* xr = (const GAS f32x4*)(F.x + (size_t)m * D) + F.lane;
            const LAS f32x4* sh = (const LAS f32x4*)sm + F.lane; const LAS f32x4* sc = (const LAS f32x4*)(sm + D) + F.lane;
            GAS v2u* o = (GAS v2u*)(hb + (size_t)m * D) + F.lane;
#pragma unroll
            for (int j = 0; j < 8; ++j) { const f32x4 v = xr[64 * j], a = sc[64 * j], s = sh[64 * j]; const f32x4 h = v * (a + 1.0f) + s;
                v2u w; w.x = pk2(h.x, h.y); w.y = pk2(h.z, h.w); o[64 * j] = w; }
        }
    }
}

constexpr int KS_PITCH = 144, VT_PITCH = 528, LDS_KS = 0, LDS_VT = 256 * KS_PITCH;
__device__ __forceinline__ void p2_attn_conv(Frame& F) {
    const bf16* proj = (const bf16*)(F.ws + WS_PROJ); bf16* mix = (bf16*)(F.ws + WS_MIX);
    const int fr = F.lane & 15, fq = F.lane >> 4;
    for (int unit = blockIdx.x; unit < NB * (SEQ / 128) * NKVH; unit += F.G) {
        const int hkv = unit % NKVH, nb = (unit / NKVH) % (SEQ / 128), b = unit / (NKVH * (SEQ / 128));
        const int rowbase = b * SEQ + nb * 128 - 128;
        __syncthreads();
#pragma unroll
        for (int it = 0; it < 4; ++it) {
            const int idx = F.tid + NTHR * it, j = idx >> 3, c = idx & 7;
            v4u kv = {0u, 0u, 0u, 0u};
            if (nb > 0 || j >= 128) kv = *(const GAS v4u*)(proj + (size_t)(rowbase + j) * INW + COL_K + hkv * HD + c * 8);
            *(LAS v4u*)(F.lds + LDS_KS + j * KS_PITCH + c * 16) = kv;
        }
#pragma unroll
        for (int it = 0; it < 4; ++it) {
            const int idx = F.tid + NTHR * it, j = idx & 255, c = idx >> 8;
            v4u vv = {0u, 0u, 0u, 0u};
            if (nb > 0 || j >= 128) vv = *(const GAS v4u*)(proj + (size_t)(rowbase + j) * INW + COL_V + hkv * HD + c * 8);
            LAS unsigned short* vt = (LAS unsigned short*)(F.lds + LDS_VT + (c * 8) * VT_PITCH + j * 2);
            vt[0 * (VT_PITCH / 2)] = (unsigned short)(vv.x & 0xffffu); vt[1 * (VT_PITCH / 2)] = (unsigned short)(vv.x >> 16);
            vt[2 * (VT_PITCH / 2)] = (unsigned short)(vv.y & 0xffffu); vt[3 * (VT_PITCH / 2)] = (unsigned short)(vv.y >> 16);
            vt[4 * (VT_PITCH / 2)] = (unsigned short)(vv.z & 0xffffu); vt[5 * (VT_PITCH / 2)] = (unsigned short)(vv.z >> 16);
            vt[6 * (VT_PITCH / 2)] = (unsigned short)(vv.w & 0xffffu); vt[7 * (VT_PITCH / 2)] = (unsigned short)(vv.w >> 16);
        }
        __syncthreads();
        const int g = F.wave & 3, half = F.wave >> 2, h = hkv * 4 + g;
        const float slope2 = exp2f(-0.5f * (float)(h + 1)) * 1.4426950408889634f;
        const float sink2 = F.sinks[h] * 1.4426950408889634f;
        const float qk2 = 0.125f * 1.4426950408889634f;
#pragma unroll 1
        for (int mi = 0; mi < 4; ++mi) {
            const int i = half * 4 + mi, j0 = i >> 1;
            const size_t qrow = (size_t)(b * SEQ + nb * 128 + 16 * i + fr);
            const bf16x8 q0 = *(const GAS bf16x8*)(proj + qrow * INW + h * HD + 8 * fq), q1 = *(const GAS bf16x8*)(proj + qrow * INW + h * HD + 32 + 8 * fq);
            f32x4 s[10];
#pragma unroll
            for (int x = 0; x < 10; ++x) {
                const int tt = 2 * j0 + x;
                const bf16x8 k0 = *(const LAS bf16x8*)(F.lds + LDS_KS + (16 * tt + fr) * KS_PITCH + 16 * fq), k1 = *(const LAS bf16x8*)(F.lds + LDS_KS + (16 * tt + fr) * KS_PITCH + 64 + 16 * fq);
                f32x4 a = {0.f, 0.f, 0.f, 0.f};
                a = __builtin_amdgcn_mfma_f32_16x16x32_bf16(k0, q0, a, 0, 0, 0);
                a = __builtin_amdgcn_mfma_f32_16x16x32_bf16(k1, q1, a, 0, 0, 0);
                s[x] = a;
            }
            float mx = sink2;
#pragma unroll
            for (int x = 0; x < 10; ++x) {
#pragma unroll
                for (int r = 0; r < 4; ++r) {
                    const int kj = 16 * (2 * j0 + x) + 4 * fq + r, dist = 16 * i + fr + 128 - kj;
                    const bool valid = (dist >= 0) && (dist < 128) && (nb > 0 || kj >= 128);
                    const float v = valid ? (s[x][r] * qk2 - slope2 * (float)dist) : -INFINITY;
                    s[x][r] = v; mx = fmaxf(mx, v);
                }
            }
            mx = fmaxf(mx, __shfl_xor(mx, 16)); mx = fmaxf(mx, __shfl_xor(mx, 32));
            float l = 0.f;
#pragma unroll
            for (int x = 0; x < 10; ++x) {
#pragma unroll
                for (int r = 0; r < 4; ++r) { const float p = __builtin_amdgcn_exp2f(s[x][r] - mx); s[x][r] = p; l += p; }
            }
            l += __shfl_xor(l, 16); l += __shfl_xor(l, 32);
            const float inv = 1.0f / (l + __builtin_amdgcn_exp2f(sink2 - mx));
            f32x4 o[4];
#pragma unroll
            for (int dt = 0; dt < 4; ++dt) o[dt] = (f32x4){0.f, 0.f, 0.f, 0.f};
#pragma unroll
            for (int pp = 0; pp < 5; ++pp) {
                const int tt0 = 2 * (j0 + pp);
                v4u pw; pw.x = pk2(s[2 * pp][0] * inv, s[2 * pp][1] * inv); pw.y = pk2(s[2 * pp][2] * inv, s[2 * pp][3] * inv);
                pw.z = pk2(s[2 * pp + 1][0] * inv, s[2 * pp + 1][1] * inv); pw.w = pk2(s[2 * pp + 1][2] * inv, s[2 * pp + 1][3] * inv);
                const bf16x8 pf = __builtin_bit_cast(bf16x8, pw);
#pragma unroll
                for (int dt = 0; dt < 4; ++dt) {
                    const LAS unsigned char* vp = F.lds + LDS_VT + (16 * dt + fr) * VT_PITCH + 32 * tt0 + 8 * fq;
                    const v2u lo = *(const LAS v2u*)vp, hi = *(const LAS v2u*)(vp + 32);
                    v4u vw; vw.x = lo.x; vw.y = lo.y; vw.z = hi.x; vw.w = hi.y;
                    o[dt] = __builtin_amdgcn_mfma_f32_16x16x32_bf16(__builtin_bit_cast(bf16x8, vw), pf, o[dt], 0, 0, 0);
                }
            }
#pragma unroll
            for (int dt = 0; dt < 4; ++dt) { v2u w; w.x = pk2(o[dt][0], o[dt][1]); w.y = pk2(o[dt][2], o[dt][3]);
                *(GAS v2u*)(mix + qrow * D + h * HD + 16 * dt + 4 * fq) = w; }
        }
    }
    for (int item = F.vcu * NTHR + F.tid; item < (M / 8) * (CW / 8); item += F.G * NTHR) {
        const int cch = item % (CW / 8), rb = item / (CW / 8), r0 = rb * 8, t0 = r0 % SEQ, c0 = cch * 8;
        float w0[8], w1[8], w2[8], u1[8], u2[8];
        { const f32x4 a = *(const GAS f32x4*)(F.conv_w + c0), b2 = *(const GAS f32x4*)(F.conv_w + c0 + 4);
          w0[0] = a.x; w0[1] = a.y; w0[2] = a.z; w0[3] = a.w; w0[4] = b2.x; w0[5] = b2.y; w0[6] = b2.z; w0[7] = b2.w; }
        { const f32x4 a = *(const GAS f32x4*)(F.conv_w + CW + c0), b2 = *(const GAS f32x4*)(F.conv_w + CW + c0 + 4);
          w1[0] = a.x; w1[1] = a.y; w1[2] = a.z; w1[3] = a.w; w1[4] = b2.x; w1[5] = b2.y; w1[6] = b2.z; w1[7] = b2.w; }
        { const f32x4 a = *(const GAS f32x4*)(F.conv_w + 2 * CW + c0), b2 = *(const GAS f32x4*)(F.conv_w + 2 * CW + c0 + 4);
          w2[0] = a.x; w2[1] = a.y; w2[2] = a.z; w2[3] = a.w; w2[4] = b2.x; w2[5] = b2.y; w2[6] = b2.z; w2[7] = b2.w; }
        if (t0 == 0) {
#pragma unroll
            for (int q = 0; q < 8; ++q) { u1[q] = 0.f; u2[q] = 0.f; }
        } else {
            const v4u c1 = *(const GAS v4u*)(proj + (size_t)(r0 - 1) * INW + COL_CC + c0), h1 = *(const GAS v4u*)(proj + (size_t)(r0 - 1) * INW + COL_CH + c0);
            const v4u c2 = *(const GAS v4u*)(proj + (size_t)(r0 - 2) * INW + COL_CC + c0), h2 = *(const GAS v4u*)(proj + (size_t)(r0 - 2) * INW + COL_CH + c0);
            u1[0] = bflo(c1.x) * bflo(h1.x); u1[1] = bfhi(c1.x) * bfhi(h1.x); u1[2] = bflo(c1.y) * bflo(h1.y); u1[3] = bfhi(c1.y) * bfhi(h1.y);
            u1[4] = bflo(c1.z) * bflo(h1.z); u1[5] = bfhi(c1.z) * bfhi(h1.z); u1[6] = bflo(c1.w) * bflo(h1.w); u1[7] = bfhi(c1.w) * bfhi(h1.w);
            u2[0] = bflo(c2.x) * bflo(h2.x); u2[1] = bfhi(c2.x) * bfhi(h2.x); u2[2] = bflo(c2.y) * bflo(h2.y); u2[3] = bfhi(c2.y) * bfhi(h2.y);
            u2[4] = bflo(c2.z) * bflo(h2.z); u2[5] = bfhi(c2.z) * bfhi(h2.z); u2[6] = bflo(c2.w) * bflo(h2.w); u2[7] = bfhi(c2.w) * bfhi(h2.w);
        }
#pragma unroll
        for (int rr = 0; rr < 8; ++rr) {
            const size_t ro = (size_t)(r0 + rr) * INW;
            const v4u bv = *(const GAS v4u*)(proj + ro + COL_CB + c0), cv = *(const GAS v4u*)(proj + ro + COL_CC + c0), hv = *(const GAS v4u*)(proj + ro + COL_CH + c0);
            float u0[8], cb[8], y[8];
            u0[0] = bflo(cv.x) * bflo(hv.x); u0[1] = bfhi(cv.x) * bfhi(hv.x); u0[2] = bflo(cv.y) * bflo(hv.y); u0[3] = bfhi(cv.y) * bfhi(hv.y);
            u0[4] = bflo(cv.z) * bflo(hv.z); u0[5] = bfhi(cv.z) * bfhi(hv.z); u0[6] = bflo(cv.w) * bflo(hv.w); u0[7] = bfhi(cv.w) * bfhi(hv.w);
            cb[0] = bflo(bv.x); cb[1] = bfhi(bv.x); cb[2] = bflo(bv.y); cb[3] = bfhi(bv.y); cb[4] = bflo(bv.z); cb[5] = bfhi(bv.z); cb[6] = bflo(bv.w); cb[7] = bfhi(bv.w);
#pragma unroll
            for (int q = 0; q < 8; ++q) { y[q] = cb[q] * (w0[q] * u2[q] + w1[q] * u1[q] + w2[q] * u0[q]); u2[q] = u1[q]; u1[q] = u0[q]; }
            v4u ov; ov.x = pk2(y[0], y[1]); ov.y = pk2(y[2], y[3]); ov.z = pk2(y[4], y[5]); ov.w = pk2(y[6], y[7]);
            *(GAS v4u*)(mix + (size_t)(r0 + rr) * D + AW + c0) = ov;
        }
    }
}

constexpr int P4_STAT = 0, P4_GB = 1024, P4_PART = P4_GB + 2 * D * 4, P4_END = P4_PART + 8 * 32 * 64 * 4;
static_assert(P4_END <= RING_BYTES, "P4 LDS");
__device__ __forceinline__ void p4_ln_router(Frame& F) {
    const bf16* y1 = (const bf16*)(F.ws + WS_Y1); bf16* x1 = (bf16*)(F.ws + WS_X1); bf16* xg = (bf16*)(F.ws + WS_XG);
    const float* modf = (const float*)(F.ws + WS_MODF);
    const bf16* WrHi = (const bf16*)(F.ws + WS_WRT); const bf16* WrLo = WrHi + NE * D;
    int* rowtok = (int*)(F.ws + WS_ROWTOK); float* roww = (float*)(F.ws + WS_ROWW); int* tokslot = (int*)(F.ws + WS_TOKSLOT);
    LAS float* stat = (LAS float*)(F.lds + P4_STAT); LAS float* GB = (LAS float*)(F.lds + P4_GB); LAS float* lpart = (LAS float*)(F.lds + P4_PART);
    const int fr = F.lane & 15, fq = F.lane >> 4;
    for (int unit = blockIdx.x; unit < M / 32; unit += F.G) {
        const int row0 = unit * 32, b = row0 / SEQ;
        const float* sh2 = modf + (size_t)b * 6 * D + 3 * D; const float* sc2 = modf + (size_t)b * 6 * D + 4 * D;
        __syncthreads();
        if (F.tid < NE) ((LAS unsigned*)(F.lds + P4_STAT + 512))[F.tid] = 0u;
        for (int k = F.tid; k < D; k += NTHR) { const float a = 1.0f + sc2[k]; GB[k] = F.ln1_g[k] * a; GB[D + k] = F.ln1_b[k] * a + sh2[k]; }
#pragma unroll 1
        for (int rr = 0; rr < 4; ++rr) {
            const int r = F.wave * 4 + rr; const size_t m = (size_t)(row0 + r);
            const GAS v4u* yr = (const GAS v4u*)(y1 + m * D) + F.lane;
            f32x4 v[8]; float s = 0.f;
#pragma unroll
            for (int c = 0; c < 4; ++c) { const v4u w = yr[64 * c]; v[2 * c] = (f32x4){bflo(w.x), bfhi(w.x), bflo(w.y), bfhi(w.y)}; v[2 * c + 1] = (f32x4){bflo(w.z), bfhi(w.z), bflo(w.w), bfhi(w.w)}; }
#pragma unroll
            for (int j = 0; j < 8; ++j) s += (v[j].x + v[j].y) + (v[j].z + v[j].w);
            const float mean = wave_sum(s) * (1.f / D); float s2 = 0.f;
#pragma unroll
            for (int j = 0; j < 8; ++j) { v[j] = v[j] - mean; s2 += (v[j].x * v[j].x + v[j].y * v[j].y) + (v[j].z * v[j].z + v[j].w * v[j].w); }
            const float rstd = 1.f / sqrtf(wave_sum(s2) * (1.f / D) + LN_EPS);
            if (F.lane == 0) { stat[2 * r] = mean; stat[2 * r + 1] = rstd; }
            GAS v2u* xo = (GAS v2u*)(x1 + m * D); GAS v2u* ho = (GAS v2u*)(xg + m * D); GAS unsigned* ho8 = (GAS unsigned*)((unsigned char*)xg + m * D);
#pragma unroll
            for (int j = 0; j < 8; ++j) {
                const int q4 = 128 * (j >> 1) + 2 * F.lane + (j & 1);
                const f32x4 g = *((const GAS f32x4*)F.ln1_g + q4), bb = *((const GAS f32x4*)F.ln1_b + q4);
                const f32x4 a = *((const GAS f32x4*)sc2 + q4), sft = *((const GAS f32x4*)sh2 + q4);
                const f32x4 xv = v[j] * rstd * g + bb; { v2u xw; xw.x = pk2(xv.x, xv.y); xw.y = pk2(xv.z, xv.w); xo[q4] = xw; }
                const f32x4 hv = xv * (a + 1.0f) + sft;
                if (MOE_F8) { f32x4 t = hv * pg8::F8_SX;
#pragma unroll
                    for (int q = 0; q < 4; ++q) t[q] = __builtin_fminf(__builtin_fmaxf(t[q], -440.0f), 440.0f);
                    int pa = __builtin_amdgcn_cvt_pk_fp8_f32(t.x, t.y, 0, false); pa = __builtin_amdgcn_cvt_pk_fp8_f32(t.z, t.w, pa, true); ho8[q4] = (unsigned)pa; }
                else { v2u w; w.x = pk2(hv.x, hv.y); w.y = pk2(hv.z, hv.w); ho[q4] = w; }
            }
        }
        __syncthreads();
        {
            f32x4 acc[2][4];
#pragma unroll
            for (int mt = 0; mt < 2; ++mt)
#pragma unroll
                for (int nt = 0; nt < 4; ++nt) acc[mt][nt] = (f32x4){0.f, 0.f, 0.f, 0.f};
            const float mu0 = stat[2 * fr], rs0 = stat[2 * fr + 1], mu1 = stat[2 * (16 + fr)], rs1 = stat[2 * (16 + fr) + 1];
#pragma unroll 4
            for (int ks = F.wave * 8; ks < F.wave * 8 + 8; ++ks) {
                const int k0 = 32 * ks + 8 * fq;
                const f32x4 g0 = *(const LAS f32x4*)(GB + k0), g1 = *(const LAS f32x4*)(GB + k0 + 4), b0 = *(const LAS f32x4*)(GB + D + k0), b1 = *(const LAS f32x4*)(GB + D + k0 + 4);
                bf16x8 whi[4], wlo[4];
#pragma unroll
                for (int nt = 0; nt < 4; ++nt) { whi[nt] = *(const GAS bf16x8*)(WrHi + (size_t)(16 * nt + fr) * D + k0); wlo[nt] = *(const GAS bf16x8*)(WrLo + (size_t)(16 * nt + fr) * D + k0); }
#pragma unroll
                for (int mt = 0; mt < 2; ++mt) {
                    const float mu = mt ? mu1 : mu0, rs = mt ? rs1 : rs0;
                    const v4u yw = *(const GAS v4u*)(y1 + (size_t)(row0 + 16 * mt + fr) * D + k0);
                    const f32x4 ya = {bflo(yw.x), bfhi(yw.x), bflo(yw.y), bfhi(yw.y)}, yb = {bflo(yw.z), bfhi(yw.z), bflo(yw.w), bfhi(yw.w)};
                    const f32x4 ha = (ya - mu) * rs * g0 + b0, hb2 = (yb - mu) * rs * g1 + b1;
                    unsigned hh[8], ll[8];
                    { const float t[8] = {ha.x, ha.y, ha.z, ha.w, hb2.x, hb2.y, hb2.z, hb2.w};
#pragma unroll
                      for (int q = 0; q < 8; ++q) { hh[q] = f2bf(t[q]); ll[q] = f2bf(t[q] - bf2f(hh[q])); } }
                    v4u ah, al; ah.x = hh[0] | (hh[1] << 16); ah.y = hh[2] | (hh[3] << 16); ah.z = hh[4] | (hh[5] << 16); ah.w = hh[6] | (hh[7] << 16);
                    al.x = ll[0] | (ll[1] << 16); al.y = ll[2] | (ll[3] << 16); al.z = ll[4] | (ll[5] << 16); al.w = ll[6] | (ll[7] << 16);
                    const bf16x8 fh = __builtin_bit_cast(bf16x8, ah), fl = __builtin_bit_cast(bf16x8, al);
#pragma unroll
                    for (int nt = 0; nt < 4; ++nt) {
                        acc[mt][nt] = __builtin_amdgcn_mfma_f32_16x16x32_bf16(fh, whi[nt], acc[mt][nt], 0, 0, 0);
                        acc[mt][nt] = __builtin_amdgcn_mfma_f32_16x16x32_bf16(fl, whi[nt], acc[mt][nt], 0, 0, 0);
                        acc[mt][nt] = __builtin_amdgcn_mfma_f32_16x16x32_bf16(fh, wlo[nt], acc[mt][nt], 0, 0, 0);
                    }
                }
            }
#pragma unroll
            for (int mt = 0; mt < 2; ++mt)
#pragma unroll
                for (int nt = 0; nt < 4; ++nt)
#pragma unroll
                    for (int r = 0; r < 4; ++r) lpart[(F.wave * 32 + 16 * mt + 4 * fq + r) * 64 + 16 * nt + fr] = acc[mt][nt][r];
        }
        __syncthreads();
        {
            LAS unsigned* hist = (LAS unsigned*)(F.lds + P4_STAT + 512); LAS unsigned* hbase = hist + 64;
            const int e = F.lane; const float rb = F.router_bias[e];
            bool chosen[4]; float wgt[4]; int erks[4]; unsigned lrank[4];
#pragma unroll
            for (int rr = 0; rr < 4; ++rr) {
                const int r = F.wave * 4 + rr;
                float logit = 0.f;
#pragma unroll
                for (int w = 0; w < 8; ++w) logit += lpart[(w * 32 + r) * 64 + e];
                const float score = 1.0f / (1.0f + __expf(-logit));
                const float sel = score + rb;
                int rk = 0;
#pragma unroll
                for (int x = 1; x < 8; ++x) { const float o = __shfl_xor(sel, x); const int e2 = e ^ x; rk += (o > sel || (o == sel && e2 < e)) ? 1 : 0; }
                float gs = rk < 2 ? sel : 0.f;
                gs += __shfl_xor(gs, 1); gs += __shfl_xor(gs, 2); gs += __shfl_xor(gs, 4);
                int grk = 0; const int gi = e >> 3;
#pragma unroll
                for (int x = 1; x < 8; ++x) { const float o = __shfl_xor(gs, 8 * x); const int g2 = gi ^ x; grk += (o > gs || (o == gs && g2 < gi)) ? 1 : 0; }
                const bool gsel = grk < 4;
                const float mv = gsel ? sel : -INFINITY;
                int erk = 0;
#pragma unroll 9
                for (int x = 1; x < 64; ++x) { const float o = __shfl_xor(mv, x); const int e2 = e ^ x; erk += (o > mv || (o == mv && e2 < e)) ? 1 : 0; }
                chosen[rr] = gsel && erk < TOPK; erks[rr] = erk;
                const float wsum = wave_sum(chosen[rr] ? score : 0.f);
                wgt[rr] = score / wsum * RSCALE;
                lrank[rr] = chosen[rr] ? __hip_atomic_fetch_add(hist + e, 1u, __ATOMIC_RELAXED, __HIP_MEMORY_SCOPE_WORKGROUP) : 0u;
            }
            __syncthreads();
            if (F.tid < NE) { const unsigned n = hist[F.tid]; hbase[F.tid] = n ? __hip_atomic_fetch_add(F.ctl + CW_CNT + 64 * F.tid, n, RLX_AGENT) : 0u; }
            __syncthreads();
            const unsigned pb = hbase[e];
#pragma unroll
            for (int rr = 0; rr < 4; ++rr) if (chosen[rr]) { const int tok = row0 + F.wave * 4 + rr; const unsigned pos = pb + lrank[rr];
                rowtok[e * M + pos] = tok; roww[e * M + pos] = wgt[rr]; tokslot[tok * TOPK + erks[rr]] = e * M + (int)pos; }
        }
    }
}

__device__ __forceinline__ void build_tables(Frame& F) {
    LAS unsigned short* tslot = (LAS unsigned short*)(F.lds + TS_OFF); LAS int* poff = (LAS int*)(F.lds + POFF_OFF); LAS int* cnt = poff + 128; LAS int* nt_p = poff + 256;
    __syncthreads();
    if (F.tid < NE) cnt[F.tid] = (int)__hip_atomic_load(F.ctl + CW_CNT + 64 * F.tid, RLX_AGENT);
    __syncthreads();
    if (F.tid == 0) {
        int t = M / 256; poff[0] = 0;
        for (int i = 0; i < M / 256; ++i) tslot[i] = 0;
        for (int e = 0; e < NE; ++e) { poff[1 + e] = t * 256; int c = cnt[e]; c = c < 0 ? 0 : (c > M ? M : c); const int n = (c + 255) >> 8; for (int i = 0; i < n && t < MAXT; ++i) tslot[t++] = (unsigned short)(1 + e); }
        nt_p[0] = t;
    }
    __syncthreads();
}

__device__ __forceinline__ void p6_setup(Frame& F, int Geff, int c) {
    const LAS unsigned short* tslot = (const LAS unsigned short*)(F.lds + TS_OFF); const LAS int* poff = (const LAS int*)(F.lds + POFF_OFF); const LAS int* cnt = poff + 128; const int ntiles = poff[256];
    const int* rowtok = (const int*)(F.ws + WS_ROWTOK); const float* roww = (const float*)(F.ws + WS_ROWW); float* wrow = (float*)(F.ws + WS_WROW);
    v4u* vt = (v4u*)(F.ws + WS_VTAB) + (size_t)blockIdx.x * 8 * NTHR;
    int R0, C0, R1, C1; pg8::stage_rc(F.tid * 16, R0, C0); pg8::stage_rc(F.tid * 16 + 8192, R1, C1);
#pragma unroll 1
    for (int i = 0; i < 8; ++i) {
        const int L = i * Geff + c; if (L >= ntiles * 4) break;
        const int t = L >> 2, s = tslot[t], e = s - 1, pos0 = t * 256 - poff[s], ce = s ? cnt[e] : 0;
        int rr[4] = {R0, R1, 128 + R0, 128 + R1}; const int cc[4] = {C0, C1, C0, C1}; unsigned off[4];
#pragma unroll
        for (int q = 0; q < 4; ++q) { int tok = t * 256 + rr[q]; if (s) { const int pos = pos0 + rr[q]; tok = pos < ce ? rowtok[e * M + pos] : 0; } off[q] = (unsigned)(tok * (MOE_F8 ? D / 2 : D) + cc[q]) * 2u; }
        v4u o; o.x = off[0]; o.y = off[1]; o.z = off[2]; o.w = off[3]; vt[i * NTHR + F.tid] = o;
        if (F.tid < 256) { float w = 1.0f; if (s) { const int pos = pos0 + F.tid; w = pos < ce ? roww[e * M + pos] : 0.f; } wrow[t * 256 + F.tid] = w; }
    }
    VM_WAIT(); __syncthreads();
}

__device__ __forceinline__ void p7_combine(Frame& F) {
    build_tables(F);
    const LAS int* poff = (const LAS int*)(F.lds + POFF_OFF);
    const unsigned char* Y = (const unsigned char*)(F.ws + WS_XG); const bf16* x1 = (const bf16*)(F.ws + WS_X1); const float* modf = (const float*)(F.ws + WS_MODF);
    const int* tokslot = (const int*)(F.ws + WS_TOKSLOT);
    const int gw = F.vcu * NWAVES + F.wave, NGW = F.G * NWAVES;
    typedef float f32x2 __attribute__((ext_vector_type(2)));
    for (int m = gw; m < M; m += NGW) {
        const int b = m / SEQ; const float* g2 = modf + (size_t)b * 6 * D + 5 * D;
        int ln = F.lane; asm volatile("" : "+v"(ln));
        int rows[9]; rows[0] = m;
#pragma unroll
        for (int k = 0; k < TOPK; ++k) { const int sl = __builtin_amdgcn_readfirstlane(tokslot[m * TOPK + k]), e = sl / M, pos = sl % M; rows[1 + k] = poff[1 + e] + pos; }
        f32x4 v[2][4];
#pragma unroll
        for (int j = 0; j < 2; ++j)
#pragma unroll
            for (int q = 0; q < 4; ++q) v[j][q] = (f32x4){0.f, 0.f, 0.f, 0.f};
        v4u w[9][2];
#pragma unroll
        for (int k = 0; k < 9; ++k) { const GAS v4u* yr = (const GAS v4u*)(Y + (size_t)rows[k] * D); w[k][0] = yr[ln]; w[k][1] = yr[64 + ln]; }
        f32x4 xv[2][4];
        { const GAS v4u* xr0 = (const GAS v4u*)(x1 + (size_t)m * D);
#pragma unroll
          for (int j = 0; j < 2; ++j)
#pragma unroll
              for (int h = 0; h < 2; ++h) { const v4u w = xr0[2 * ln + 128 * j + h];
                  xv[j][2 * h] = (f32x4){bflo(w.x), bfhi(w.x), bflo(w.y), bfhi(w.y)}; xv[j][2 * h + 1] = (f32x4){bflo(w.z), bfhi(w.z), bflo(w.w), bfhi(w.w)}; } }
#pragma unroll
        for (int k = 0; k < 9; ++k)
#pragma unroll
            for (int j = 0; j < 2; ++j) {
                const unsigned ww[4] = {w[k][j].x, w[k][j].y, w[k][j].z, w[k][j].w};
#pragma unroll
                for (int q = 0; q < 4; ++q) { const f32x2 lo = (Y_BF8 == 2) ? __builtin_amdgcn_cvt_pk_f32_fp8((int)ww[q], false) : __builtin_amdgcn_cvt_pk_f32_bf8((int)ww[q], false), hi = (Y_BF8 == 2) ? __builtin_amdgcn_cvt_pk_f32_fp8((int)ww[q], true) : __builtin_amdgcn_cvt_pk_f32_bf8((int)ww[q], true);
                    v[j][q].x += lo.x; v[j][q].y += lo.y; v[j][q].z += hi.x; v[j][q].w += hi.y; }
            }
        const GAS f32x4* gr = (const GAS f32x4*)g2; const int l4 = 4 * ln; float s = 0.f;
#pragma unroll
        for (int j = 0; j < 2; ++j)
#pragma unroll
            for (int q = 0; q < 4; ++q) { v[j][q] = xv[j][q] * ALPHA + (gr[l4 + 256 * j + q] + 1.0f) * (v[j][q] * ((Y_BF8 == 2) ? (1.0f / 64.0f) : 1.0f)); s += (v[j][q].x + v[j][q].y) + (v[j][q].z + v[j][q].w); }
        const float mean = wave_sum(s) * (1.f / D); float s2 = 0.f;
#pragma unroll
        for (int j = 0; j < 2; ++j)
#pragma unroll
            for (int q = 0; q < 4; ++q) { v[j][q] = v[j][q] - mean; s2 += (v[j][q].x * v[j][q].x + v[j][q].y * v[j][q].y) + (v[j][q].z * v[j][q].z + v[j][q].w * v[j][q].w); }
        const float rstd = 1.f / sqrtf(wave_sum(s2) * (1.f / D) + LN_EPS);
        GAS f32x4* o = (GAS f32x4*)(F.out + (size_t)m * D); const GAS f32x4* lg = (const GAS f32x4*)F.ln2_g; const GAS f32x4* lb = (const GAS f32x4*)F.ln2_b;
#pragma unroll
        for (int j = 0; j < 2; ++j)
#pragma unroll
            for (int q = 0; q < 4; ++q) o[l4 + 256 * j + q] = v[j][q] * rstd * lg[l4 + 256 * j + q] + lb[l4 + 256 * j + q];
    }
}

constexpr int NPHASE = 9;
struct Args { const float* in[20]; float* out; unsigned char* ws; int ph_lo, ph_hi; };
__global__ void __launch_bounds__(NWAVES * 64, 2) mk_fwd(Args args) {
    extern __shared__ __attribute__((aligned(16))) unsigned char lds[];
    Frame F;
    F.lds = (LAS unsigned char*)lds;
    F.MISC = (volatile LAS unsigned*)(F.lds + MISC_OFF);
    F.tid = threadIdx.x; F.lane = F.tid & 63; F.wave = __builtin_amdgcn_readfirstlane(F.tid >> 6);
    F.G = gridDim.x; { const int bx = blockIdx.x; F.vcu = (F.G % 8 == 0) ? (bx % 8) * (F.G / 8) + bx / 8 : bx; }
    F.ws = args.ws; F.ctl = (gu32*)(args.ws + WS_CTL);
    F.x = args.in[0]; F.c = args.in[1]; F.w_mod = args.in[2]; F.b_mod = args.in[3]; F.w_in = args.in[4]; F.conv_w = args.in[5]; F.sinks = args.in[6]; F.w_out = args.in[7];
    F.ln1_g = args.in[8]; F.ln1_b = args.in[9]; F.w_router = args.in[10]; F.router_bias = args.in[11]; F.w_gate = args.in[12]; F.w_up = args.in[13]; F.w_down = args.in[14];
    F.ws_gate = args.in[15]; F.ws_up = args.in[16]; F.ws_down = args.in[17]; F.ln2_g = args.in[18]; F.ln2_b = args.in[19]; F.out = args.out;
    for (int u = F.tid; u < (LDS_BYTES - LDSCTL_OFF) / 4; u += NWAVES * 64) ((LAS unsigned*)(F.lds + LDSCTL_OFF))[u] = 0u;
    __syncthreads();
    XcdBarrier bar; bar.bar = (unsigned*)(F.ctl + CW_BAR); bar.x = 0; bar.st = nullptr;
    if (!MK_PER_PHASE) bar = xcd_barrier_post((unsigned*)(F.ctl + CW_BAR), F.MISC + 8);
#define GRID_BAR() do { if (!MK_PER_PHASE) xcd_barrier(bar); } while (0)
    unsigned long long tA = 0;
#define ST_BEGIN(k) do { if (PROBE_STAMP == (k)) tA = __builtin_amdgcn_s_memrealtime(); } while (0)
#define ST_END(k) do { if (PROBE_STAMP == (k)) { const unsigned long long t1 = __builtin_amdgcn_s_memrealtime(), dd = t1 - tA; while (__builtin_amdgcn_s_memrealtime() - t1 < dd) __builtin_amdgcn_s_sleep(8); } } while (0)
    const int lo = args.ph_lo, hi = args.ph_hi;
#define IN(k) (lo <= (k) && (k) < hi && ((F.lane = pg8::lane_id_v()), (F.tid = F.wave * 64 + F.lane), true))
#define BOTH(k) (IN(k) && IN((k) + 1))
    if (IN(0)) { ST_BEGIN(0); p0_gemv(F, 0, 16); if (BOTH(0)) GRID_BAR(); ST_END(0); }
    if (IN(1)) { ST_BEGIN(1); p1a_modulate(F); p0_gemv(F, 16, 48); p0_static_conv(F); if (BOTH(1)) GRID_BAR(); ST_END(1); }
    if (IN(2)) {
        ST_BEGIN(2);
        __syncthreads();
        const bool split = (F.G == 256); const int q = (int)blockIdx.x >> 3, x = (int)blockIdx.x & 7, Geff = split ? 192 : F.G;
        if (!split || q < 24) {
            pg8::Gemm g{(const pg8::bf16_t*)(F.ws + WS_HB), (const pg8::bf16_t*)(F.ws + WS_WINT), M, INW, D, F.ws}; pg8::StaticOrder S; S.init(M, INW, Geff, split ? q * 8 + x : (int)blockIdx.x);
            pg8::EpiBf16<0> E{(pg8::bf16_t*)(F.ws + WS_PROJ), INW, nullptr, 0, 0, 1.f};
            pg8::gemm_phase<pg8::EpiBf16<0>, pg8::StaticOrder, PG8_ALIGN, PG8_SP2>(F.lds + RING_OFF, g, S, E, F.wave);
            phase_fin(F, CW_FIN + 64 * 2);
        } else { drain(F, 0, CW_FIN + 64 * 2, (unsigned)Geff); drain(F, 1, CW_FIN + 64 * 2, (unsigned)Geff); }
        if (BOTH(2)) GRID_BAR();
        ST_END(2);
    }
    if (IN(3)) { ST_BEGIN(3); modf_reduce(F); p2_attn_conv(F); if (BOTH(3)) GRID_BAR(); ST_END(3); }
    if (IN(4)) {
        ST_BEGIN(4);
        _Pragma("unroll") for (int rep = (REP_PHASE == 4 ? 0 : 1); rep < 2; ++rep) {
        __syncthreads();
        pg8::Gemm g{(const pg8::bf16_t*)(F.ws + WS_MIX), (const pg8::bf16_t*)(F.ws + WS_WOUTT), M, D, D, F.ws}; pg8::StaticOrder S; S.init(M, D, F.G, (int)blockIdx.x);
        pg8::EpiResF32 E{F.x, (pg8::bf16_t*)(F.ws + WS_Y1), (const float*)(F.ws + WS_MODF) + 2 * D, D, SEQ, 6 * D, ALPHA};
        pg8::gemm_phase<pg8::EpiResF32, pg8::StaticOrder, PG8_ALIGN, PG8_SP2>(F.lds + RING_OFF, g, S, E, F.wave);
        if (rep == 0) GRID_BAR(); }
        if (BOTH(4)) GRID_BAR();
        ST_END(4);
    }
    if (IN(5)) { ST_BEGIN(5); p4_ln_router(F); __syncthreads(); ST_BEGIN(10); drain(F, 0, -1, 0u); ST_END(10); if (BOTH(5)) GRID_BAR(); ST_END(5); }
    if (IN(6)) {
        ST_BEGIN(6); ST_BEGIN(12);
        build_tables(F);
        const int ntiles = ((const LAS int*)(F.lds + POFF_OFF))[256];
        const int units = ntiles * 4, Rn = (units + F.G - 1) / F.G, slack = F.G - (units + Rn - 1) / Rn, R = (F.G == 256 && slack < P6_MIN_CONV) ? Rn + 1 : Rn, Geff = (F.G % 8 == 0) ? (units + R - 1) / R : F.G;
        const int x = (int)blockIdx.x & 7, q = (int)blockIdx.x >> 3;
        int c = (int)blockIdx.x;
        if (F.G % 8 == 0) { int px = 0; for (int xx = 0; xx < x; ++xx) px += (Geff - xx + 7) >> 3; c = px + q; }
        if ((int)blockIdx.x < Geff) {
            p6_setup(F, Geff, c);
            int Kgu = MOE_F8 ? D / 2 : D; asm volatile("" : "+s"(Kgu));
            pg8::Gemm g{(const pg8::bf16_t*)(F.ws + WS_XG), (const pg8::bf16_t*)(F.ws + WS_WGUT), M, NSLOT * 1024, Kgu, F.ws};
            pg8::GroupedOrder<true> S{(const PG8_LAS unsigned short*)(F.lds + TS_OFF), ntiles, 4, Geff, c, (const unsigned*)(F.ws + WS_VTAB) + (size_t)blockIdx.x * 8 * NTHR * 4};
            pg8::EpiSwiGLU E{(pg8::bf16_t*)(F.ws + WS_H), (const float*)(F.ws + WS_WROW), DE, 4};
            pg8::gemm_phase<pg8::EpiSwiGLU, pg8::GroupedOrder<true>, PG8_ALIGN, PG8_SP2>(F.lds + RING_OFF, g, S, E, F.wave);
            phase_fin(F, CW_FIN + 64 * 6);
        } else drain(F, 1, CW_FIN + 64 * 6, (unsigned)Geff);
        __syncthreads();
        ST_END(12); ST_BEGIN(11);
        drain(F, 1, -1, 0u);
        ST_END(11);
        if (BOTH(6)) GRID_BAR();
        ST_END(6);
    }
    if (IN(7)) {
        ST_BEGIN(7);
        _Pragma("unroll") for (int rep = (REP_PHASE == 7 ? 0 : 1); rep < 2; ++rep) {
        build_tables(F);
        const int ntiles = ((const LAS int*)(F.lds + POFF_OFF))[256];
        int Kdn = MOE_F8 ? DE / 2 : DE; asm volatile("" : "+s"(Kdn));
        pg8::Gemm g{(const pg8::bf16_t*)(F.ws + WS_H), (const pg8::bf16_t*)(F.ws + WS_WDT), MAXR, NSLOT * D, Kdn, F.ws};
        pg8::GroupedOrder<false> S{(const PG8_LAS unsigned short*)(F.lds + TS_OFF), ntiles, 8, F.G, F.vcu, nullptr, (PROBE_PIN && rep == 0) ? 1 : 0};
        pg8::EpiDown E{(pg8::bf16_t*)(F.ws + WS_XG), D, 8, (PROBE_NOSTORE && rep == 0) ? 1 : 0};
        if (DOWN_STAGGER) {
            const unsigned long long t0 = __builtin_amdgcn_s_memrealtime(), dl = (unsigned long long)(((unsigned)F.vcu >> 3) & 7u) * DOWN_STAGGER;
            while (__builtin_amdgcn_s_memrealtime() - t0 < dl) __builtin_amdgcn_s_sleep(4);
        }
        pg8::gemm_phase<pg8::EpiDown, pg8::GroupedOrder<false>, PG8_ALIGN, PG8_SP2>(F.lds + RING_OFF, g, S, E, F.wave);
        if (rep == 0) GRID_BAR(); }
        if (BOTH(7)) GRID_BAR();
        ST_END(7);
    }
    if (IN(8)) { ST_BEGIN(8); p7_combine(F); VM_WAIT(); ST_END(8); }
#undef IN
#undef BOTH
}

extern "C" void kernel_launch(void* const* d_in, const int* in_sizes, int n_in, void* d_out, int out_size, void* d_ws, size_t ws_size, hipStream_t stream) {
    static int grid = 0;
    if (grid == 0) {
        if (n_in != 20 || in_sizes[0] != M * D || out_size != M * D || ws_size < WS_END) { fprintf(stderr, "kernel_launch: unexpected shapes (n_in %d, in0 %d, out %d, ws %zu)\n", n_in, n_in > 0 ? in_sizes[0] : -1, out_size, ws_size); grid = -1; return; }
        int dev = 0, cus = 0, per_cu = 0;
        if (hipGetDevice(&dev) != hipSuccess || hipDeviceGetAttribute(&cus, hipDeviceAttributeMultiprocessorCount, dev) != hipSuccess) { grid = -1; return; }
        if (hipFuncSetAttribute((const void*)mk_fwd, hipFuncAttributeMaxDynamicSharedMemorySize, LDS_BYTES) != hipSuccess) { fprintf(stderr, "kernel_launch: hipFuncSetAttribute failed\n"); grid = -1; return; }
        if (hipOccupancyMaxActiveBlocksPerMultiprocessor(&per_cu, (const void*)mk_fwd, NWAVES * 64, LDS_BYTES) != hipSuccess || per_cu < 1) fprintf(stderr, "kernel_launch: occupancy query reports %d\n", per_cu);
        (void)hipGetLastError();
        grid = cus;
    }
    if (grid < 0) return;
    if (hipMemsetAsync((char*)d_ws + WS_CTL, 0, CTL_ZERO_BYTES, stream) != hipSuccess) return;
    Args a{};
    for (int i = 0; i < 20; ++i) a.in[i] = (const float*)d_in[i];
    a.out = (float*)d_out; a.ws = (unsigned char*)d_ws;
#if MK_PER_PHASE
    for (int p = 0; p < NPHASE; ++p) { a.ph_lo = p; a.ph_hi = p + 1; hipLaunchKernelGGL(mk_fwd, dim3(grid), dim3(NWAVES * 64), LDS_BYTES, stream, a); }
#else
    a.ph_lo = 0; a.ph_hi = NPHASE; hipLaunchKernelGGL(mk_fwd, dim3(grid), dim3(NWAVES * 64), LDS_BYTES, stream, a);
#endif
}
```

```cpp
#include <hip/hip_runtime.h>
#include <cstdio>
#include <cstdint>
#include <cmath>
#ifndef MOE_F8
#define MOE_F8 1
#endif
#ifndef Y_BF8
#define Y_BF8 2
#endif
namespace pg8 {
constexpr float F8_SX = 8.0f, F8_SWG = 64.0f, F8_SH = 16.0f, F8_SWD = 32.0f;
#define PG8_LAS __attribute__((address_space(3)))
typedef unsigned short bf16_t;
typedef short bf16x8 __attribute__((ext_vector_type(8)));
typedef float f32x4 __attribute__((ext_vector_type(4)));
typedef unsigned u32x4 __attribute__((ext_vector_type(4)));
constexpr int BM = 256, BK = 64, HALF = 128, HTB = HALF * BK * 2  , STAGE_BYTES = 8 * HTB, NXCD = 8, WGM = 8;
constexpr int VT_SLOT = STAGE_BYTES + 4096;

__host__ __device__ __forceinline__ int lds_byte(int r, int c) { const int st = (r >> 4) * 2 + (c >> 5), rr = r & 15, cc = c & 31, ob = rr * 64 + cc * 2; return st * 1024 + (ob ^ (((ob >> 9) & 1) << 5)); }
__host__ __device__ __forceinline__ void stage_rc(int b, int& R, int& C) { const int st = b / 1024, sb = b % 1024, swz = sb ^ (((sb >> 9) & 1) << 5); R = (st >> 1) * 16 + swz / 64; C = (st & 1) * 32 + (swz % 64) / 2; }
__host__ __device__ __forceinline__ int perm32(int rho) { const int n = rho >> 4, i = rho & 15; return 8 * (i >> 2) + 4 * n + (i & 3); }

__device__ __forceinline__ int lane_id_v() { int l; asm volatile("v_mbcnt_lo_u32_b32 %0, -1, 0\n\tv_mbcnt_hi_u32_b32 %0, -1, %0" : "=v"(l)); return l; }
struct Unit { int pm, pn; };
struct Gemm { const bf16_t* A; const bf16_t* Bt; int M, N, K; const void* base; };

struct StaticOrder {
    static constexpr bool GATHER = false;
    int nM, nN, nwg, G, c;
    __host__ __device__ void init(int M, int N, int G_, int c_) { nM = M / BM; nN = N / BM; nwg = nM * nN; G = G_; c = c_; }
    __host__ __device__ bool next(int i, Unit& u) const {
        const long L = (long)i * G + c; if (L >= nwg) return false;
        int wgid = (int)L; { const int q = nwg / NXCD, r = nwg % NXCD, xcd = wgid % NXCD, off = wgid / NXCD; wgid = (xcd < r ? xcd * (q + 1) : r * (q + 1) + (xcd - r) * q) + off; }
        const int nig = WGM * nN, gid = wgid / nig, fm = gid * WGM, gsz = (nM - fm) < WGM ? (nM - fm) : WGM;
        u.pm = fm + ((wgid % nig) % gsz); u.pn = (wgid % nig) / gsz; return true;
    }
    __device__ __forceinline__ void a_ready(const Unit&) const {}
    __device__ __forceinline__ void done(const Unit&) const {}
};

__device__ __forceinline__ unsigned cvt_pk_bf16(float lo, float hi) { unsigned r; asm volatile("v_cvt_pk_bf16_f32 %0, %1, %2" : "=v"(r) : "v"(lo), "v"(hi)); return r; }
typedef float f32x2 __attribute__((ext_vector_type(2)));
__device__ __forceinline__ f32x2 gelu_pk(f32x2 v) {
    const f32x2 av = __builtin_elementwise_abs(v), d = av * 0.2316418882f + 1.0f;
    f32x2 t; t.x = __builtin_amdgcn_rcpf(d.x); t.y = __builtin_amdgcn_rcpf(d.y);
    f32x2 q = t * 0.5307027145f + (-0.7265760135f); q = q * t + 0.7107068705f; q = q * t + (-0.142248368f); q = q * t + 0.127414796f; q = q * t;
    const f32x2 s = (v * v) * (-0.72134752044f);
    f32x2 e; e.x = __builtin_amdgcn_exp2f(s.x); e.y = __builtin_amdgcn_exp2f(s.y);
    const f32x2 m = v * (q * e), r = v - m;
    f32x2 o; o.x = v.x < 0.f ? m.x : r.x; o.y = v.y < 0.f ? m.y : r.y; return o;
}

template <int ACT  > struct EpiBf16 {
    static constexpr bool PERM = true, AFTER_DRAIN = false, F8 = false; static_assert(ACT == 0 || ACT == 1, "EpiBf16: ACT is 0 (none) or 1 (gelu_pk)");
    bf16_t* O; int ldc; const float* bias; int split_cols; size_t split_stride; float scale0;
    __device__ __forceinline__ void operator()(const f32x4 (&acc)[2][2][4][2], const Unit& u, int wr, int wc, int fr, int fq) const {
        const int row0 = u.pm * BM + wr * 64 + fr; int colt = u.pn * BM; bf16_t* base = O;
        float sc = 1.f; if (split_cols) { const int t = colt / split_cols; base += (size_t)t * split_stride; colt -= t * split_cols; if (t == 0) sc = scale0; }
        const int col0 = colt + wc * 32 + 8 * fq, bcol0 = u.pn * BM + wc * 32 + 8 * fq;
        f32x4 bv[2][2];
#pragma unroll
        for (int bj = 0; bj < 2; ++bj)
#pragma unroll
            for (int n = 0; n < 2; ++n) bv[bj][n] = bias ? *(const f32x4*)(bias + bcol0 + bj * HALF + 4 * n) : (f32x4){0.f, 0.f, 0.f, 0.f};
#pragma unroll
        for (int ai = 0; ai < 2; ++ai)
#pragma unroll
            for (int m = 0; m < 4; ++m) { bf16_t* rowp = base + (size_t)(row0 + ai * HALF + m * 16) * ldc + col0;
#pragma unroll
                for (int bj = 0; bj < 2; ++bj) { f32x4 v0 = acc[ai][bj][m][0] + bv[bj][0], v1 = acc[ai][bj][m][1] + bv[bj][1];
                    if (ACT == 1) { f32x2 a = gelu_pk((f32x2){v0[0], v0[1]}), b = gelu_pk((f32x2){v0[2], v0[3]}), c = gelu_pk((f32x2){v1[0], v1[1]}), d = gelu_pk((f32x2){v1[2], v1[3]});
                        v0 = (f32x4){a.x, a.y, b.x, b.y}; v1 = (f32x4){c.x, c.y, d.x, d.y}; }
                    v0 = v0 * sc; v1 = v1 * sc; u32x4 w; w.x = cvt_pk_bf16(v0[0], v0[1]); w.y = cvt_pk_bf16(v0[2], v0[3]); w.z = cvt_pk_bf16(v1[0], v1[1]); w.w = cvt_pk_bf16(v1[2], v1[3]);
                    *(u32x4*)(rowp + bj * HALF) = w; } }
    }
};

__device__ __forceinline__ float silu_f(float g) { return g * __builtin_amdgcn_rcpf(1.0f + __builtin_amdgcn_exp2f(-1.4426950408889634f * g)); }
struct EpiResF32 {
    static constexpr bool PERM = true, AFTER_DRAIN = false, F8 = false;
    const float* x; bf16_t* y; const float* gate; int ldc; int rows_per_batch; int gate_stride; float alpha;
    __device__ __forceinline__ void operator()(const f32x4 (&acc)[2][2][4][2], const Unit& u, int wr, int wc, int fr, int fq) const {
        const int row0 = u.pm * BM + wr * 64 + fr, col0 = u.pn * BM + wc * 32 + 8 * fq;
        const float* gp = gate + (size_t)((u.pm * BM) / rows_per_batch) * gate_stride + col0;
        f32x4 gv[2][2];
#pragma unroll
        for (int bj = 0; bj < 2; ++bj)
#pragma unroll
            for (int n = 0; n < 2; ++n) gv[bj][n] = *(const f32x4*)(gp + bj * HALF + n * 4) + 1.0f;
#pragma unroll
        for (int ai = 0; ai < 2; ++ai)
#pragma unroll
            for (int m = 0; m < 4; ++m) { const size_t off = (size_t)(row0 + ai * HALF + m * 16) * ldc + col0;
#pragma unroll
                for (int bj = 0; bj < 2; ++bj) { const f32x4 x0 = *(const f32x4*)(x + off + bj * HALF), x1v = *(const f32x4*)(x + off + bj * HALF + 4);
                    const f32x4 v0 = x0 * alpha + gv[bj][0] * acc[ai][bj][m][0], v1 = x1v * alpha + gv[bj][1] * acc[ai][bj][m][1];
                    u32x4 w; w.x = cvt_pk_bf16(v0[0], v0[1]); w.y = cvt_pk_bf16(v0[2], v0[3]); w.z = cvt_pk_bf16(v1[0], v1[1]); w.w = cvt_pk_bf16(v1[2], v1[3]);
                    *(u32x4*)(y + off + bj * HALF) = w; } }
    }
};
struct EpiSwiGLU {
    static constexpr bool PERM = true, AFTER_DRAIN = false, F8 = (MOE_F8 != 0);
    bf16_t* H; const float* wrow; int ldh; int npn;
    __device__ __forceinline__ void operator()(const f32x4 (&acc)[2][2][4][2], const Unit& u, int wr, int wc, int fr, int fq) const {
        const int row0 = u.pm * BM + wr * 64 + fr, col0 = (u.pn % npn) * HALF + wc * 32 + 8 * fq;
        constexpr float inv = F8 ? 1.0f / (F8_SX * F8_SWG) : 1.0f;
#pragma unroll
        for (int ai = 0; ai < 2; ++ai)
#pragma unroll
            for (int m = 0; m < 4; ++m) { const int r = row0 + ai * HALF + m * 16; const float w8 = wrow[r] * inv * (F8 ? F8_SH : 1.0f);
                const f32x4 g0 = acc[ai][0][m][0] * inv, g1 = acc[ai][0][m][1] * inv, u0 = acc[ai][1][m][0] * w8, u1 = acc[ai][1][m][1] * w8;
                float h[8];
#pragma unroll
                for (int q = 0; q < 4; ++q) { h[q] = silu_f(g0[q]) * u0[q]; h[4 + q] = silu_f(g1[q]) * u1[q]; }
                if (F8) {
                    typedef unsigned u32x2 __attribute__((ext_vector_type(2)));
#pragma unroll
                    for (int q = 0; q < 8; ++q) h[q] = __builtin_fminf(__builtin_fmaxf(h[q], -440.0f), 440.0f);
                    int a = __builtin_amdgcn_cvt_pk_fp8_f32(h[0], h[1], 0, false); a = __builtin_amdgcn_cvt_pk_fp8_f32(h[2], h[3], a, true);
                    int b = __builtin_amdgcn_cvt_pk_fp8_f32(h[4], h[5], 0, false); b = __builtin_amdgcn_cvt_pk_fp8_f32(h[6], h[7], b, true);
                    u32x2 w; w.x = (unsigned)a; w.y = (unsigned)b; *(u32x2*)((unsigned char*)H + (size_t)r * ldh + col0) = w;
                } else {
                    u32x4 w; w.x = cvt_pk_bf16(h[0], h[1]); w.y = cvt_pk_bf16(h[2], h[3]); w.z = cvt_pk_bf16(h[4], h[5]); w.w = cvt_pk_bf16(h[6], h[7]);
                    *(u32x4*)(H + (size_t)r * ldh + col0) = w; } }
    }
};
struct EpiDown {
    static constexpr int PERM = Y_BF8 ? 2 : 1; static constexpr bool AFTER_DRAIN = false, F8 = (MOE_F8 != 0);
    bf16_t* Y; int ldc; int npn; int nostore;
    __device__ __forceinline__ void operator()(const f32x4 (&acc)[2][2][4][2], const Unit& u, int wr, int wc, int fr, int fq) const {
        const int row0 = u.pm * BM + wr * 64 + fr;
        if (Y_BF8) {
            const int col0 = (u.pn % npn) * BM + wc * 64 + 16 * fq;
#pragma unroll
            for (int ai = 0; ai < 2; ++ai)
#pragma unroll
                for (int m = 0; m < 4; ++m) { const int r = row0 + ai * HALF + m * 16; u32x4 w;
#pragma unroll
                    for (int bj = 0; bj < 2; ++bj)
#pragma unroll
                        for (int n = 0; n < 2; ++n) { const f32x4 v = acc[ai][bj][m][n] * (F8 ? 1.0f / (F8_SH * F8_SWD) : 1.0f); int a;
                            if (Y_BF8 == 2) { f32x4 sv = v * 64.0f;
#pragma unroll
                                for (int q = 0; q < 4; ++q) sv[q] = __builtin_fminf(__builtin_fmaxf(sv[q], -440.0f), 440.0f);
                                a = __builtin_amdgcn_cvt_pk_fp8_f32(sv[0], sv[1], 0, false); a = __builtin_amdgcn_cvt_pk_fp8_f32(sv[2], sv[3], a, true);
                            } else { a = __builtin_amdgcn_cvt_pk_bf8_f32(v[0], v[1], 0, false); a = __builtin_amdgcn_cvt_pk_bf8_f32(v[2], v[3], a, true); }
                            w[2 * bj + n] = (unsigned)a; }
                    if (!nostore || w.x == 0x12345678u) *(u32x4*)((unsigned char*)Y + (size_t)r * ldc + col0) = w; }
        } else {
            const int col0 = (u.pn % npn) * BM + wc * 32 + 8 * fq;
#pragma unroll
            for (int ai = 0; ai < 2; ++ai)
#pragma unroll
                for (int m = 0; m < 4; ++m) { const int r = row0 + ai * HALF + m * 16;
#pragma unroll
                    for (int bj = 0; bj < 2; ++bj) { const f32x4 v0 = acc[ai][bj][m][0] * (F8 ? 1.0f / (F8_SH * F8_SWD) : 1.0f), v1 = acc[ai][bj][m][1] * (F8 ? 1.0f / (F8_SH * F8_SWD) : 1.0f);
                        u32x4 w; w.x = cvt_pk_bf16(v0[0], v0[1]); w.y = cvt_pk_bf16(v0[2], v0[3]); w.z = cvt_pk_bf16(v1[0], v1[1]); w.w = cvt_pk_bf16(v1[2], v1[3]);
                        if (!nostore || w.x == 0x12345678u) *(u32x4*)(Y + (size_t)r * ldc + col0 + bj * HALF) = w; } }
        }
    }
};
template <bool GATHER_> struct GroupedOrder {
    static constexpr bool GATHER = GATHER_;
    const PG8_LAS unsigned short* tslot; int ntiles, npn, G, c; const unsigned* vtab; int pin = 0;
    __device__ __forceinline__ bool next(int i, Unit& u) const {
        const int L = i * G + c; if (L >= ntiles * npn) return false;
        const int t = L / npn, p = L - t * npn; u.pm = t; u.pn = (int)tslot[t] * npn + p; if (pin) { u.pm = c & 3; u.pn = c & 7; } return true;
    }
    __device__ __forceinline__ void a_ready(const Unit&) const {}
    __device__ __forceinline__ void done(const Unit&) const {}
};


template <class Epi, class Sched, bool ALIGN_EPI = false, bool SP2 = false>
__device__ __forceinline__ void gemm_phase(PG8_LAS unsigned char* lds, const Gemm g, const Sched& S, const Epi& E, const int wid) {
    const int lane = lane_id_v(), tid = wid * 64 + lane, wr = wid >> 2, wc = wid & 3, fr = lane & 15, fq = lane >> 4;
    const int K = g.K, nt = K / BK;
    unsigned voffA[2], voffA1[2], voffB[2];
#pragma unroll
    for (int i = 0; i < 2; ++i) { int R, C; stage_rc(tid * 16 + i * 8192, R, C); const int rho = R & 31;
        const int Rb = ((int)Epi::PERM == 2) ? (64 * (R >> 5) + 16 * ((rho & 15) >> 2) + 4 * (rho >> 4) + (rho & 3)) : (Epi::PERM ? ((R & ~31) + perm32(rho)) : R);
        voffA[i] = (unsigned)(R * K + C) * 2u; voffA1[i] = voffA[i] + (unsigned)(HALF * K * 2); voffB[i] = (unsigned)(Rb * K + C) * 2u; }
    const size_t kstep = (size_t)(BK * 2);
    const size_t hstep = (size_t)HALF * K * 2;
    const size_t tstep = 2 * hstep;
    const size_t bh1 = ((int)Epi::PERM == 2) ? (size_t)8 * K * 2 : hstep;
    const unsigned ldsw = (unsigned)wid * 1024u;
    const int aoff = lds_byte(wr * 64 + fr, fq * 8), boff = lds_byte(wc * 32 + fr, fq * 8);
#define PG8_SA(b, h) (((b) * 2 + (h)) * HTB)
#define PG8_SB(b, h) ((4 + (b) * 2 + (h)) * HTB)
    const __amdgpu_buffer_rsrc_t rs_ = __builtin_amdgcn_make_buffer_rsrc((void*)g.base, (short)0, 0x7ffffff0, 0x00020000);
#define PG8_STAGE(bufoff, gbase, voff) do { _Pragma("unroll") for (int _i = 0; _i < 2; ++_i) \
        __builtin_amdgcn_raw_ptr_buffer_load_lds(rs_, (PG8_LAS unsigned*)(lds + (bufoff) + ldsw + _i * 8192), 16, (int)(voff)[_i], (int)((const char*)(gbase) - (const char*)g.base), 0, 0); } while (0)
#define PG8_STAGE_A1(bufoff, gbase) do { if constexpr (Sched::GATHER) PG8_STAGE(bufoff, gbase, voffA1); else PG8_STAGE(bufoff, (gbase) + hstep, voffA); } while (0)
#define PG8_LDA(dst, b, h) do { if constexpr (Epi::F8) { _Pragma("unroll") for (int m = 0; m < 4; ++m) { const i32x4_ l0_ = *(const PG8_LAS i32x4_*)(lds + PG8_SA(b, h) + aoff + m * 2048), l1_ = *(const PG8_LAS i32x4_*)(lds + PG8_SA(b, h) + aoff + m * 2048 + 1024); dst##8[m] = __builtin_shufflevector(l0_, l1_, 0, 1, 2, 3, 4, 5, 6, 7); } } \
        else { _Pragma("unroll") for (int m = 0; m < 4; ++m) _Pragma("unroll") for (int k = 0; k < 2; ++k) dst[m][k] = *(const PG8_LAS bf16x8*)(lds + PG8_SA(b, h) + aoff + m * 2048 + k * 1024); } } while (0)
#define PG8_LDB(dst, b, h) do { if constexpr (Epi::F8) { _Pragma("unroll") for (int n = 0; n < 2; ++n) { const i32x4_ l0_ = *(const PG8_LAS i32x4_*)(lds + PG8_SB(b, h) + boff + n * 2048), l1_ = *(const PG8_LAS i32x4_*)(lds + PG8_SB(b, h) + boff + n * 2048 + 1024); dst##8[n] = __builtin_shufflevector(l0_, l1_, 0, 1, 2, 3, 4, 5, 6, 7); } } \
        else { _Pragma("unroll") for (int n = 0; n < 2; ++n) _Pragma("unroll") for (int k = 0; k < 2; ++k) dst[n][k] = *(const PG8_LAS bf16x8*)(lds + PG8_SB(b, h) + boff + n * 2048 + k * 1024); } } while (0)
#define PG8_MMA(ai, bj, At, Bt) do { __builtin_amdgcn_s_setprio(1); \
        if constexpr (Epi::F8) { _Pragma("unroll") for (int m = 0; m < 4; ++m) _Pragma("unroll") for (int n = 0; n < 2; ++n) \
                acc[ai][bj][m][n] = __builtin_amdgcn_mfma_scale_f32_16x16x128_f8f6f4(Bt##8[n], At##8[m], acc[ai][bj][m][n], 0, 0, 0, 0, 0, 0); \
        } else { _Pragma("unroll") for (int m = 0; m < 4; ++m) _Pragma("unroll") for (int n = 0; n < 2; ++n) _Pragma("unroll") for (int k = 0; k < 2; ++k) \
        acc[ai][bj][m][n] = __builtin_amdgcn_mfma_f32_16x16x32_bf16(Bt[n][k], At[m][k], acc[ai][bj][m][n], 0, 0, 0); } __builtin_amdgcn_s_setprio(0); } while (0)
#define PG8_WAIT_V(n) asm volatile("s_waitcnt vmcnt(" #n ")" ::: "memory")
#define PG8_WAIT_L(n) asm volatile("s_waitcnt lgkmcnt(" #n ")" ::: "memory")
#define PG8_BAR __builtin_amdgcn_s_barrier()
#define PG8_SCHED __builtin_amdgcn_sched_barrier(0)
    Unit cur, nxt; int ui = 0;
    if (!S.next(0, cur)) return;
    f32x4 acc[2][2][4][2];
#pragma unroll
    for (int a = 0; a < 2; ++a)
#pragma unroll
        for (int b = 0; b < 2; ++b)
#pragma unroll
            for (int m = 0; m < 4; ++m)
#pragma unroll
                for (int n = 0; n < 2; ++n) { acc[a][b][m][n] = (f32x4){0.f, 0.f, 0.f, 0.f}; if constexpr (Epi::F8) asm volatile("" : "+v"(acc[a][b][m][n])); }
    typedef int i32x4_ __attribute__((ext_vector_type(4))); typedef int i32x8_ __attribute__((ext_vector_type(8)));
    bf16x8 At[4][2], B0[2][2], B1[2][2]; i32x8_ At8[4], B08[2], B18[2];
    const char* cA = Sched::GATHER ? (const char*)g.A : (const char*)g.A + (size_t)cur.pm * tstep; const char* cB = (const char*)g.Bt + (size_t)cur.pn * tstep;
    S.a_ready(cur);
    if constexpr (Sched::GATHER) {
        static_assert(SP2, "gather: SP2 loop only");
        __builtin_amdgcn_global_load_lds((const unsigned*)(S.vtab + ((size_t)0 * 512 + tid) * 4), (PG8_LAS unsigned*)(lds + VT_SLOT + wid * 1024), 16, 0, 0);
        PG8_WAIT_V(0);
        const u32x4 e4 = *(const PG8_LAS u32x4*)(lds + VT_SLOT + tid * 16); voffA[0] = e4.x; voffA[1] = e4.y; voffA1[0] = e4.z; voffA1[1] = e4.w;
    }
    if constexpr (SP2) {
        PG8_STAGE(PG8_SB(0, 0), cB, voffB); PG8_STAGE(PG8_SB(0, 1), cB + bh1, voffB); PG8_STAGE(PG8_SA(0, 0), cA, voffA); PG8_STAGE_A1(PG8_SA(0, 1), cA);
        if (wr == 1) PG8_BAR;
        PG8_WAIT_V(2); PG8_BAR;
        PG8_STAGE(PG8_SB(1, 0), cB + kstep, voffB); PG8_STAGE(PG8_SA(1, 0), cA + kstep, voffA); PG8_STAGE(PG8_SB(1, 1), cB + bh1 + kstep, voffB);
        PG8_WAIT_V(6); PG8_BAR;
    } else {
        PG8_STAGE(PG8_SB(0, 0), cB, voffB); PG8_STAGE(PG8_SA(0, 0), cA, voffA); PG8_STAGE(PG8_SB(0, 1), cB + hstep, voffB); PG8_STAGE(PG8_SA(0, 1), cA + hstep, voffA);
        if (wr == 1) PG8_BAR;
        PG8_WAIT_V(4); PG8_BAR;
        PG8_STAGE(PG8_SB(1, 0), cB + kstep, voffB); PG8_STAGE(PG8_SA(1, 0), cA + kstep, voffA); PG8_STAGE(PG8_SB(1, 1), cB + hstep + kstep, voffB);
        PG8_WAIT_V(6); PG8_BAR;
    }
    for (;;) {
        const bool has_next = S.next(ui + 1, nxt);
        const char* nA = (has_next && !Sched::GATHER) ? (const char*)g.A + (size_t)nxt.pm * tstep : cA; const char* nB = has_next ? (const char*)g.Bt + (size_t)nxt.pn * tstep : cB;
        for (int t = 0; t < nt; t += 2) {
            const bool last = (t == nt - 2);
            const char* a1 = cA + (size_t)(t + 1) * kstep;
            const char* a2 = last ? nA : cA + (size_t)(t + 2) * kstep; const char* b2 = last ? nB : cB + (size_t)(t + 2) * kstep;
            const char* a3 = a2 + kstep; const char* b3 = b2 + kstep;
            if (last && has_next) S.a_ready(nxt);
            if constexpr (SP2) {
            if constexpr (Sched::GATHER) { if (t == 0 && has_next)
                __builtin_amdgcn_global_load_lds((const unsigned*)(S.vtab + ((size_t)(ui + 1) * 512 + tid) * 4), (PG8_LAS unsigned*)(lds + VT_SLOT + wid * 1024), 16, 0, 0); }
            PG8_LDB(B0, 0, 0); PG8_LDB(B1, 0, 1); PG8_SCHED; PG8_LDA(At, 0, 0); PG8_STAGE_A1(PG8_SA(1, 1), a1);
            PG8_WAIT_V(8); PG8_WAIT_L(0); PG8_BAR; PG8_MMA(0, 0, At, B0); PG8_MMA(0, 1, At, B1); PG8_BAR; PG8_SCHED;
            if constexpr (Sched::GATHER) { if (last && has_next) {
                const u32x4 e4 = *(const PG8_LAS u32x4*)(lds + VT_SLOT + tid * 16); voffA[0] = e4.x; voffA[1] = e4.y; voffA1[0] = e4.z; voffA1[1] = e4.w; } }
            PG8_LDA(At, 0, 1); PG8_STAGE(PG8_SB(0, 0), b2, voffB); PG8_STAGE(PG8_SB(0, 1), b2 + bh1, voffB); PG8_STAGE(PG8_SA(0, 0), a2, voffA);
            PG8_WAIT_V(8); PG8_WAIT_L(0); PG8_BAR; PG8_MMA(1, 0, At, B0); PG8_MMA(1, 1, At, B1); PG8_BAR; PG8_SCHED;
            PG8_LDB(B0, 1, 0); PG8_LDB(B1, 1, 1); PG8_SCHED; PG8_LDA(At, 1, 0); PG8_STAGE_A1(PG8_SA(0, 1), a2);
            PG8_WAIT_V(8); PG8_WAIT_L(0); PG8_BAR; PG8_MMA(0, 0, At, B0); PG8_MMA(0, 1, At, B1); PG8_BAR; PG8_SCHED;
            PG8_LDA(At, 1, 1); PG8_STAGE(PG8_SB(1, 0), b3, voffB); PG8_STAGE(PG8_SB(1, 1), b3 + bh1, voffB); PG8_STAGE(PG8_SA(1, 0), a3, voffA);
            PG8_WAIT_V(8); PG8_WAIT_L(0); PG8_BAR; PG8_MMA(1, 0, At, B0); PG8_MMA(1, 1, At, B1); PG8_BAR; PG8_SCHED;
            } else {
            PG8_LDB(B0, 0, 0); PG8_SCHED; PG8_LDA(At, 0, 0); PG8_STAGE(PG8_SA(1, 1), a1 + hstep, voffA);
            PG8_WAIT_L(8); PG8_BAR; PG8_WAIT_L(0); PG8_MMA(0, 0, At, B0); PG8_BAR; PG8_SCHED;
            PG8_LDB(B1, 0, 1); PG8_STAGE(PG8_SB(0, 0), b2, voffB);
            PG8_BAR; PG8_WAIT_L(0); PG8_MMA(0, 1, At, B1); PG8_BAR;
            PG8_LDA(At, 0, 1); PG8_STAGE(PG8_SA(0, 0), a2, voffA);
            PG8_BAR; PG8_WAIT_L(0); PG8_MMA(1, 0, At, B0); PG8_BAR; PG8_SCHED;
            PG8_STAGE(PG8_SB(0, 1), b2 + hstep, voffB);
            PG8_WAIT_V(6); PG8_BAR; PG8_MMA(1, 1, At, B1); PG8_BAR;
            PG8_LDB(B0, 1, 0); PG8_SCHED; PG8_LDA(At, 1, 0); PG8_STAGE(PG8_SA(0, 1), a2 + hstep, voffA);
            PG8_WAIT_L(8); PG8_BAR; PG8_WAIT_L(0); PG8_MMA(0, 0, At, B0); PG8_BAR; PG8_SCHED;
            PG8_LDB(B1, 1, 1); PG8_STAGE(PG8_SB(1, 0), b3, voffB);
            PG8_BAR; PG8_WAIT_L(0); PG8_MMA(0, 1, At, B1); PG8_BAR;
            PG8_LDA(At, 1, 1); PG8_STAGE(PG8_SA(1, 0), a3, voffA);
            PG8_BAR; PG8_WAIT_L(0); PG8_MMA(1, 0, At, B0); PG8_BAR; PG8_SCHED;
            PG8_STAGE(PG8_SB(1, 1), b3 + hstep, voffB);
            PG8_WAIT_V(6); PG8_BAR; PG8_MMA(1, 1, At, B1); PG8_BAR;
            }
        }
        if constexpr (ALIGN_EPI) { if (wr == 0) PG8_BAR; }
        if constexpr (!Epi::AFTER_DRAIN) { E(acc, cur, wr, wc, fr, fq); S.done(cur); }
        if (!has_next) break;
#pragma unroll
        for (int a = 0; a < 2; ++a)
#pragma unroll
            for (int b = 0; b < 2; ++b)
#pragma unroll
                for (int m = 0; m < 4; ++m)
#pragma unroll
                    for (int n = 0; n < 2; ++n) acc[a][b][m][n] = (f32x4){0.f, 0.f, 0.f, 0.f};
        cur = nxt; cA = nA; cB = nB; ++ui;
        if constexpr (ALIGN_EPI) { if (wr == 1) PG8_BAR; }
    }
    PG8_WAIT_V(0);
    if constexpr (!ALIGN_EPI) { if (wr == 0) PG8_BAR; }
    PG8_BAR;
    if constexpr (Epi::AFTER_DRAIN) { E.fused(acc, cur, wr, wc, fr, fq, lds, wid, lane); S.done(cur); }
#undef PG8_SA
#undef PG8_SB
#undef PG8_STAGE
#undef PG8_LDA
#undef PG8_LDB
#undef PG8_MMA
#undef PG8_WAIT_V
#undef PG8_WAIT_L
#undef PG8_BAR
#undef PG8_SCHED
}
}

#ifndef PG8_SP2
#define PG8_SP2 true
#endif
#ifndef PG8_ALIGN
#define PG8_ALIGN true
#endif
#ifndef DOWN_STAGGER
#define DOWN_STAGGER 0
#endif
#ifndef CONV_NT
#define CONV_NT 1
#endif
#ifndef P5_MAIN_Q
#define P5_MAIN_Q 16
#endif
#ifndef P6_MIN_CONV
#define P6_MIN_CONV 0
#endif
#ifndef PROBE_STAMP
#define PROBE_STAMP -1
#endif
#ifndef PROBE_PIN
#define PROBE_PIN 0
#endif
#ifndef PROBE_NOSTORE
#define PROBE_NOSTORE 0
#endif
#ifndef REP_PHASE
#define REP_PHASE -1
#endif
#ifndef MK_PER_PHASE
#define MK_PER_PHASE 0
#endif

constexpr int NB = 2, SEQ = 4096, D = 2048, M = NB * SEQ;
constexpr int AW = 1024, NQH = 16, NKVH = 4, HD = 64, KVW = 256, CW = 1024, INW = 4608;
constexpr int COL_K = 1024, COL_V = 1280, COL_CB = 1536, COL_CC = 2560, COL_CH = 3584;
constexpr int NE = 64, TOPK = 8, DE = 512, NSLOT = NE + 1;
constexpr int MAXT = 32 + 256 + 64, MAXR = MAXT * 256;
constexpr float ALPHA = 1.189207115002721f;
constexpr float LN_EPS = 1e-5f, RSCALE = 2.5f;
constexpr int NWAVES = 8, NTHR = 512;
constexpr int KSL = 8;

constexpr size_t MiB = 1u << 20;
constexpr size_t WS_CTL = 0, CTL_ZERO_BYTES = 1 * MiB;
constexpr size_t WS_PART = 1 * MiB;
constexpr size_t WS_MODF = 2 * MiB;
constexpr size_t WS_WRT = 3 * MiB;
constexpr size_t WS_ROWTOK = 4 * MiB;
constexpr size_t WS_ROWW = 6 * MiB;
constexpr size_t WS_TOKSLOT = 8 * MiB;
constexpr size_t WS_WROW = 9 * MiB;
constexpr size_t WS_WINT = 10 * MiB;
constexpr size_t WS_WOUTT = 28 * MiB;
constexpr size_t WS_WGUT = 36 * MiB;
constexpr size_t WS_WDT = 296 * MiB;
constexpr size_t WS_X1 = 426 * MiB;
constexpr size_t WS_H = 490 * MiB;
constexpr size_t WS_XG = 578 * MiB;
constexpr size_t WS_HB = 610 * MiB;
constexpr size_t WS_PROJ = 642 * MiB;
constexpr size_t WS_MIX = 714 * MiB;
constexpr size_t WS_Y1 = 746 * MiB;
constexpr size_t WS_VTAB = 930 * MiB;
constexpr size_t WS_END = 946 * MiB;
static_assert(WS_XG + (size_t)MAXR * D * 2 <= WS_VTAB && WS_H + (size_t)MAXR * DE * 2 <= WS_XG && WS_Y1 + (size_t)M * D * 4 <= WS_VTAB, "ws map");
static_assert(WS_WGUT + (size_t)NSLOT * 1024 * D * 2 <= WS_WDT && WS_WDT + (size_t)NSLOT * D * DE * 2 <= WS_X1 && WS_X1 + (size_t)M * D * 4 <= WS_H, "ws map 2");
constexpr int CW_TMO = 0;
constexpr int CW_BAR = 4096;
constexpr int CW_Q = 8192;
constexpr int CW_FIN = 8448;
constexpr int CW_CNT = 16384;

constexpr int RING_OFF = 0, RING_BYTES = 131072;
constexpr int LDSCTL_OFF = RING_BYTES, MISC_OFF = LDSCTL_OFF + 320;
constexpr int TS_OFF = LDSCTL_OFF + 512;
constexpr int POFF_OFF = LDSCTL_OFF + 1280;
constexpr int LDS_BYTES = 147456;

#define GAS __attribute__((address_space(1)))
#define LAS __attribute__((address_space(3)))
typedef unsigned short bf16;
typedef unsigned v4u __attribute__((ext_vector_type(4)));
typedef unsigned v2u __attribute__((ext_vector_type(2)));
typedef float f32x4 __attribute__((ext_vector_type(4)));
typedef short bf16x8 __attribute__((ext_vector_type(8)));
typedef GAS unsigned gu32;
#define RLX_AGENT __ATOMIC_RELAXED, __HIP_MEMORY_SCOPE_AGENT
#define LDS_WAIT() asm volatile("s_waitcnt lgkmcnt(0)" ::: "memory")
#define VM_WAIT() asm volatile("s_waitcnt vmcnt(0)" ::: "memory")
__device__ __forceinline__ unsigned f2bf(float f) { unsigned u = __builtin_bit_cast(unsigned, f); return (u + 0x7fffu + ((u >> 16) & 1u)) >> 16; }
__device__ __forceinline__ unsigned pk2(float lo, float hi) { return f2bf(lo) | (f2bf(hi) << 16); }
__device__ __forceinline__ float bf2f(unsigned h) { return __builtin_bit_cast(float, h << 16); }
__device__ __forceinline__ float bflo(unsigned w) { return __builtin_bit_cast(float, w << 16); }
__device__ __forceinline__ float bfhi(unsigned w) { return __builtin_bit_cast(float, w & 0xffff0000u); }

#define XB_TMO      128
#define XB_XCNT(j)  (256  + 64 * (j))
#define XB_XSUB(j)  (1280 + 64 * (j))
#define XB_XGEN(j)  (2304 + 64 * (j))
#define XB_TOP      3328
#define XB_TOPGEN   3392
#define XCD_BAR_WORDS 3456
#define XB_SPIN_CAP (1u << 18)
__device__ __forceinline__ unsigned xb_ld(unsigned* p)              { return __hip_atomic_load(p, __ATOMIC_RELAXED, __HIP_MEMORY_SCOPE_AGENT); }
__device__ __forceinline__ unsigned xb_add(unsigned* p, unsigned v) { return __hip_atomic_fetch_add(p, v, __ATOMIC_RELAXED, __HIP_MEMORY_SCOPE_AGENT); }
__device__ __forceinline__ unsigned xb_xcc_id() { return (unsigned)__builtin_amdgcn_s_getreg((3 << 11) | 20) & 0xFu; }
#define XB_SPIN(cond, bar) do { unsigned _sp = 0; while (cond) { __builtin_amdgcn_s_sleep(1); \
    if ((++_sp & 255u) == 0u) { if (xb_ld(&(bar)[XB_TMO])) break; if (_sp > XB_SPIN_CAP) { atomicAdd(&(bar)[XB_TMO], 1u); break; } } } } while (0)
struct XcdBarrier { unsigned* bar; unsigned x; volatile LAS unsigned* st; };
__device__ __forceinline__ XcdBarrier xcd_barrier_post(unsigned* bar, volatile LAS unsigned* st) {
    XcdBarrier b; b.bar = bar; b.x = xb_xcc_id(); b.st = st;
    if (threadIdx.x == 0) (void)xb_add(&bar[XB_XCNT(b.x)], 1u);
    return b;
}
__device__ __forceinline__ void xcd_barrier_complete(unsigned* bar, unsigned x, unsigned& nloc, unsigned& nx) {
    const unsigned G = gridDim.x * gridDim.y * gridDim.z;
    unsigned sum, cnt, mine, sp = 0u;
    for (;;) {
        sum = 0u; cnt = 0u; mine = 0u;
#pragma unroll
        for (unsigned j = 0; j < 16; ++j) { const unsigned c = xb_ld(&bar[XB_XCNT(j)]); sum += c; cnt += (c > 0u) ? 1u : 0u; mine = (j == x) ? c : mine; }
        if (sum == G) break;
        __builtin_amdgcn_s_sleep(1);
        if ((++sp & 255u) == 0u) { if (xb_ld(&bar[XB_TMO])) break; if (sp > XB_SPIN_CAP) { atomicAdd(&bar[XB_TMO], 1u); break; } }
    }
    nloc = mine > 0u ? mine : 1u; nx = cnt > 0u ? cnt : 1u;
}
__device__ __forceinline__ void xcd_barrier(const XcdBarrier& b) {
    asm volatile("s_waitcnt vmcnt(0)" ::: "memory");
    __syncthreads();
    if (threadIdx.x == 0) {
        unsigned* bar = b.bar;
        __builtin_amdgcn_s_waitcnt(0);
        unsigned nloc = b.st[0], nx = b.st[1];
        if (nloc == 0u) { xcd_barrier_complete(bar, b.x, nloc, nx); b.st[0] = nloc; b.st[1] = nx; }
        const unsigned old = xb_add(&bar[XB_XSUB(b.x)], 1u);
        const unsigned gen = old / nloc;
        if (old + 1u == (gen + 1u) * nloc) {
            __builtin_amdgcn_fence(__ATOMIC_RELEASE, "agent");
            asm volatile("s_waitcnt vmcnt(0)" ::: "memory");
            const unsigned og = xb_add(&bar[XB_TOP], 1u);
            const unsigned tg = og / nx;
            if (og + 1u == (tg + 1u) * nx) xb_add(&bar[XB_TOPGEN], 1u);
            else XB_SPIN(xb_ld(&bar[XB_TOPGEN]) == tg, bar);
            __builtin_amdgcn_fence(__ATOMIC_ACQUIRE, "agent");
            xb_add(&bar[XB_XGEN(b.x)], 1u);
            asm volatile("s_waitcnt vmcnt(0)" ::: "memory");
        } else {
            XB_SPIN(xb_ld(&bar[XB_XGEN(b.x)]) == gen, bar);
            __builtin_amdgcn_fence(__ATOMIC_ACQUIRE, "agent");
            asm volatile("s_waitcnt vmcnt(0)" ::: "memory");
        }
    }
    __syncthreads();
}

struct Frame {
    LAS unsigned char* lds;
    volatile LAS unsigned* MISC;
    gu32* ctl;
    int tid, lane, wave;
    int vcu, G;
    unsigned char* ws;
    const float *x, *c, *w_mod, *b_mod, *w_in, *conv_w, *sinks, *w_out, *ln1_g, *ln1_b, *w_router, *router_bias, *w_gate, *w_up, *w_down, *ws_gate, *ws_up, *ws_down, *ln2_g, *ln2_b;
    float* out;
};
__device__ __forceinline__ float wave_sum(float v) {
#pragma unroll
    for (int o = 1; o < 64; o <<= 1) v += __shfl_xor(v, o);
    return v;
}

__device__ __forceinline__ void p0_transpose_item(const float* src, int ldw, bf16* dst, int ldt, LAS float* scr, int lane) {
    { const float* sp = src + (size_t)(lane >> 5) * ldw + (lane & 31); LAS float* dp = scr + (lane >> 5) * 33 + (lane & 31);
#pragma unroll 1
      for (int h = 0; h < 2; ++h) { float tv[16];
#pragma unroll
        for (int i = 0; i < 16; ++i) tv[i] = sp[(size_t)(2 * i) * ldw];
#pragma unroll
        for (int i = 0; i < 16; ++i) dp[(2 * i) * 33] = tv[i];
        sp += (size_t)32 * ldw; dp += 32 * 33; } }
    LDS_WAIT(); asm volatile("" ::: "memory");
    const int c = lane & 7;
#pragma unroll
    for (int j = 0; j < 4; ++j) { const int n = (lane >> 3) + 8 * j; const LAS float* s = scr + (8 * c) * 33 + n;
        v4u o; o.x = pk2(s[0 * 33], s[1 * 33]); o.y = pk2(s[2 * 33], s[3 * 33]); o.z = pk2(s[4 * 33], s[5 * 33]); o.w = pk2(s[6 * 33], s[7 * 33]);
        *(GAS v4u*)(dst + (size_t)n * ldt + 8 * c) = o; }
    LDS_WAIT(); asm volatile("" ::: "memory");
}
constexpr int SCRP = 136;
__device__ __forceinline__ void conv64(const float* src, int ldw, bf16* dst, int ldt, LAS unsigned char* scr, int lane) {
    const int kr = lane >> 4, nq = lane & 15;
    const float* sp = src + (size_t)kr * ldw + 4 * nq;
    f32x4 tv[16];
#pragma unroll
    for (int i = 0; i < 16; ++i) tv[i] = CONV_NT ? __builtin_nontemporal_load((const GAS f32x4*)(sp + (size_t)(4 * i) * ldw)) : *(const GAS f32x4*)(sp + (size_t)(4 * i) * ldw);
#pragma unroll
    for (int i = 0; i < 16; ++i) { v2u w; w.x = pk2(tv[i].x, tv[i].y); w.y = pk2(tv[i].z, tv[i].w); *(LAS v2u*)(scr + (4 * i + kr) * SCRP + 8 * nq) = w; }
    LDS_WAIT(); asm volatile("" ::: "memory");
    const int c = lane & 7;
#pragma unroll
    for (int j = 0; j < 8; ++j) { const int n = (lane >> 3) + 8 * j; const LAS unsigned short* p = (const LAS unsigned short*)(scr + (8 * c) * SCRP + 2 * n);
        v4u o; o.x = (unsigned)p[0] | ((unsigned)p[SCRP / 2] << 16); o.y = (unsigned)p[2 * (SCRP / 2)] | ((unsigned)p[3 * (SCRP / 2)] << 16);
        o.z = (unsigned)p[4 * (SCRP / 2)] | ((unsigned)p[5 * (SCRP / 2)] << 16); o.w = (unsigned)p[6 * (SCRP / 2)] | ((unsigned)p[7 * (SCRP / 2)] << 16);
        if (CONV_NT) __builtin_nontemporal_store(o, (GAS v4u*)(dst + (size_t)n * ldt + 8 * c)); else *(GAS v4u*)(dst + (size_t)n * ldt + 8 * c) = o; }
    LDS_WAIT(); asm volatile("" ::: "memory");
}
constexpr int SCRP8 = 68;
__device__ __forceinline__ void conv64_f8(const float* src, int ldw, unsigned char* dst, int ldt, LAS unsigned char* scr, int lane, float scale) {
    const int kr = lane >> 4, nq = lane & 15;
    const float* sp = src + (size_t)kr * ldw + 4 * nq;
    f32x4 tv[16];
#pragma unroll
    for (int i = 0; i < 16; ++i) tv[i] = CONV_NT ? __builtin_nontemporal_load((const GAS f32x4*)(sp + (size_t)(4 * i) * ldw)) : *(const GAS f32x4*)(sp + (size_t)(4 * i) * ldw);
#pragma unroll
    for (int i = 0; i < 16; ++i) { const f32x4 t = tv[i] * scale; int a = __builtin_amdgcn_cvt_pk_fp8_f32(t.x, t.y, 0, false); a = __builtin_amdgcn_cvt_pk_fp8_f32(t.z, t.w, a, true);
        *(LAS unsigned*)(scr + (4 * i + kr) * SCRP8 + 4 * nq) = (unsigned)a; }
    LDS_WAIT(); asm volatile("" ::: "memory");
    const int c = lane & 3;
#pragma unroll
    for (int j = 0; j < 4; ++j) { const int n = (lane >> 2) + 16 * j; const LAS unsigned char* p = scr + (16 * c) * SCRP8 + n;
        unsigned o[4];
#pragma unroll
        for (int q = 0; q < 4; ++q) o[q] = (unsigned)p[(4 * q) * SCRP8] | ((unsigned)p[(4 * q + 1) * SCRP8] << 8) | ((unsigned)p[(4 * q + 2) * SCRP8] << 16) | ((unsigned)p[(4 * q + 3) * SCRP8] << 24);
        v4u ov; ov.x = o[0]; ov.y = o[1]; ov.z = o[2]; ov.w = o[3];
        if (CONV_NT) __builtin_nontemporal_store(ov, (GAS v4u*)(dst + (size_t)n * ldt + 16 * c)); else *(GAS v4u*)(dst + (size_t)n * ldt + 16 * c) = ov; }
    LDS_WAIT(); asm volatile("" ::: "memory");
}
__device__ __forceinline__ void p0_transpose_item_hilo(const float* src, int ldw, bf16* dhi, bf16* dlo, int ldt, LAS float* scr, int lane) {
    { const float* sp = src + (size_t)(lane >> 5) * ldw + (lane & 31); LAS float* dp = scr + (lane >> 5) * 33 + (lane & 31);
#pragma unroll 1
      for (int h = 0; h < 2; ++h) { float tv[16];
#pragma unroll
        for (int i = 0; i < 16; ++i) tv[i] = sp[(size_t)(2 * i) * ldw];
#pragma unroll
        for (int i = 0; i < 16; ++i) dp[(2 * i) * 33] = tv[i];
        sp += (size_t)32 * ldw; dp += 32 * 33; } }
    LDS_WAIT(); asm volatile("" ::: "memory");
    const int c = lane & 7;
#pragma unroll
    for (int j = 0; j < 4; ++j) { const int n = (lane >> 3) + 8 * j; const LAS float* s = scr + (8 * c) * 33 + n;
        float v[8]; unsigned h[8], l[8];
#pragma unroll
        for (int q = 0; q < 8; ++q) { v[q] = s[q * 33]; h[q] = f2bf(v[q]); l[q] = f2bf(v[q] - bf2f(h[q])); }
        v4u o; o.x = h[0] | (h[1] << 16); o.y = h[2] | (h[3] << 16); o.z = h[4] | (h[5] << 16); o.w = h[6] | (h[7] << 16);
        *(GAS v4u*)(dhi + (size_t)n * ldt + 8 * c) = o;
        o.x = l[0] | (l[1] << 16); o.y = l[2] | (l[3] << 16); o.z = l[4] | (l[5] << 16); o.w = l[6] | (l[7] << 16);
        *(GAS v4u*)(dlo + (size_t)n * ldt + 8 * c) = o; }
    LDS_WAIT(); asm volatile("" ::: "memory");
}
constexpr int I_G = (D / 64) * (DE / 64), I_D = (DE / 64) * (D / 64);
constexpr int QB_ITEMS = NE * 2 * I_G, QC_ITEMS = NE * I_D, CONV_CH = 8;
__device__ __forceinline__ void conv_item_gu(Frame& F, int s, int q, LAS float* scr) {
    const int up = q / I_G, q2 = q % I_G, nblk = DE / 64, kb = q2 / nblk, nb = q2 % nblk, n0 = 64 * nb;
    const float* W = up ? (s == 0 ? F.ws_up : F.w_up + (size_t)(s - 1) * D * DE) : (s == 0 ? F.ws_gate : F.w_gate + (size_t)(s - 1) * D * DE);
    const int drow = s * 1024 + (n0 >> 7) * 256 + up * 128 + (n0 & 127);
    if (MOE_F8) conv64_f8(W + (size_t)(64 * kb) * DE + n0, DE, (unsigned char*)(F.ws + WS_WGUT) + (size_t)drow * D + 64 * kb, D, (LAS unsigned char*)scr, F.lane, pg8::F8_SWG);
    else conv64(W + (size_t)(64 * kb) * DE + n0, DE, (bf16*)(F.ws + WS_WGUT) + (size_t)drow * D + 64 * kb, D, (LAS unsigned char*)scr, F.lane);
}
__device__ __forceinline__ void conv_item_dn(Frame& F, int s, int q, LAS float* scr) {
    const int nblk = D / 64, kb = q / nblk, nb = q % nblk;
    const float* W = (s == 0 ? F.ws_down : F.w_down + (size_t)(s - 1) * DE * D);
    if (MOE_F8) conv64_f8(W + (size_t)(64 * kb) * D + 64 * nb, D, (unsigned char*)(F.ws + WS_WDT) + (size_t)(s * D + 64 * nb) * DE + 64 * kb, DE, (LAS unsigned char*)scr, F.lane, pg8::F8_SWD);
    else conv64(W + (size_t)(64 * kb) * D + 64 * nb, D, (bf16*)(F.ws + WS_WDT) + (size_t)(s * D + 64 * nb) * DE + 64 * kb, DE, (LAS unsigned char*)scr, F.lane);
}
__device__ __forceinline__ void drain(Frame& F, int which, int fin_idx, unsigned target) {
    LAS float* scr = (LAS float*)(F.lds + RING_OFF + 32768 + F.wave * 12288);
    const unsigned total = which ? (unsigned)QC_ITEMS : (unsigned)QB_ITEMS;
    for (;;) {
        if (F.tid == 0) {
            unsigned base = 0xffffffffu; bool go = true;
            if (fin_idx >= 0) go = __hip_atomic_load(F.ctl + fin_idx, RLX_AGENT) < target;
            if (go) base = __hip_atomic_fetch_add(F.ctl + CW_Q + 64 * which, (unsigned)CONV_CH, RLX_AGENT);
            F.MISC[16] = base;
        }
        __syncthreads();
        const unsigned base = F.MISC[16];
        __syncthreads();
        if (base >= total) break;
        for (int j = F.wave; j < CONV_CH; j += NWAVES) { const unsigned r = base + j; if (r < total) { if (which) conv_item_dn(F, 1 + (int)(r / I_D), (int)(r % I_D), scr); else conv_item_gu(F, 1 + (int)(r / (2 * I_G)), (int)(r % (2 * I_G)), scr); } }
    }
}
__device__ __forceinline__ void phase_fin(Frame& F, int fin_idx) { __syncthreads(); if (F.tid == 0) __hip_atomic_fetch_add(F.ctl + fin_idx, 1u, RLX_AGENT); }

__device__ __forceinline__ void p0_gemv(Frame& F, int c0, int c1) {
    {
        __syncthreads();
        LAS float* cs = (LAS float*)(F.lds + RING_OFF);
        LAS float* red = (LAS float*)(F.lds + RING_OFF + 16384);
        for (int i = F.tid; i < NB * D; i += NTHR) { const float v = F.c[i]; cs[i] = v / (1.0f + __expf(-v)); }
        __syncthreads();
        float* part = (float*)(F.ws + WS_PART);
        const int nch = c1 - c0;
        for (int it = blockIdx.x; it < nch * KSL; it += F.G) {
            const int chunk = c0 + it % nch, sl = it / nch, k0 = sl * (D / KSL) + F.wave * 32;
            const float* wp = F.w_mod + (size_t)k0 * (6 * D) + chunk * 256 + F.lane * 4;
            f32x4 a0 = {0.f, 0.f, 0.f, 0.f}, a1 = {0.f, 0.f, 0.f, 0.f};
#pragma unroll 8
            for (int k = 0; k < 32; ++k) { const f32x4 w = *(const GAS f32x4*)(wp + (size_t)k * (6 * D)); const float c0 = cs[k0 + k], c1 = cs[D + k0 + k]; a0 += w * c0; a1 += w * c1; }
            *(LAS f32x4*)(red + (F.wave * 2 + 0) * 256 + F.lane * 4) = a0;
            *(LAS f32x4*)(red + (F.wave * 2 + 1) * 256 + F.lane * 4) = a1;
            __syncthreads();
            { const int b = F.tid >> 8, col = F.tid & 255; float s = 0.f;
#pragma unroll
              for (int w = 0; w < 8; ++w) s += red[(w * 2 + b) * 256 + col];
              part[((size_t)sl * 2 + b) * (6 * D) + chunk * 256 + col] = s; }
            __syncthreads();
        }
    }
}
__device__ __forceinline__ void p0_static_conv(Frame& F) {
    __syncthreads();
    LAS float* scr = (LAS float*)(F.lds + RING_OFF + 32768 + F.wave * 12288);
    const int gw = F.vcu * NWAVES + F.wave, NGW = F.G * NWAVES;
    constexpr int I_IN = (D / 64) * (INW / 64), I_OUT = (D / 64) * (D / 64), I_R = (D / 64) * (NE / 32);
    constexpr int NITEMS = I_IN + I_OUT + (2 * I_G + I_D) + I_R;
    bf16* WinT = (bf16*)(F.ws + WS_WINT); bf16* WoutT = (bf16*)(F.ws + WS_WOUTT);
    bf16* WrHi = (bf16*)(F.ws + WS_WRT); bf16* WrLo = WrHi + NE * D;
    for (int it = gw; it < NITEMS; it += NGW) {
        int r = it;
        if (r < I_IN) { const int nblk = INW / 64, kb = r / nblk, nb = r % nblk; conv64(F.w_in + (size_t)(64 * kb) * INW + 64 * nb, INW, WinT + (size_t)(64 * nb) * D + 64 * kb, D, (LAS unsigned char*)scr, F.lane); continue; } r -= I_IN;
        if (r < I_OUT) { const int nblk = D / 64, kb = r / nblk, nb = r % nblk; conv64(F.w_out + (size_t)(64 * kb) * D + 64 * nb, D, WoutT + (size_t)(64 * nb) * D + 64 * kb, D, (LAS unsigned char*)scr, F.lane); continue; } r -= I_OUT;
        if (r < 2 * I_G) { conv_item_gu(F, 0, r, scr); continue; } r -= 2 * I_G;
        if (r < I_D) { conv_item_dn(F, 0, r, scr); continue; } r -= I_D;
        { const int nblk = NE / 32, kb = r / nblk, nb = r % nblk;
          p0_transpose_item_hilo(F.w_router + (size_t)(64 * kb) * NE + 32 * nb, NE, WrHi + (size_t)(32 * nb) * D + 64 * kb, WrLo + (size_t)(32 * nb) * D + 64 * kb, D, scr, F.lane); }
    }
}

__device__ __forceinline__ void modf_reduce(Frame& F) {
    const float* part = (const float*)(F.ws + WS_PART); float* modf = (float*)(F.ws + WS_MODF);
    const int idx = blockIdx.x * NTHR + F.tid;
    if (idx < NB * 6 * D) { const int b = idx / (6 * D), j = idx % (6 * D); float s = F.b_mod[j];
#pragma unroll
        for (int sl = 0; sl < KSL; ++sl) s += part[((size_t)sl * 2 + b) * (6 * D) + j];
        modf[idx] = s; }
}
__device__ __forceinline__ void p1a_modulate(Frame& F) {
    const float* part = (const float*)(F.ws + WS_PART);
    LAS float* sm = (LAS float*)(F.lds + RING_OFF);
    bf16* hb = (bf16*)(F.ws + WS_HB);
    for (int r0 = F.vcu * 32; r0 < M; r0 += F.G * 32) {
        const int b = r0 / SEQ;
        __syncthreads();
        for (int i = F.tid; i < 2 * D; i += NTHR) { float s = F.b_mod[i];
#pragma unroll
            for (int sl = 0; sl < KSL; ++sl) s += part[((size_t)sl * 2 + b) * (6 * D) + i];
            sm[i] = s; }
        __syncthreads();
#pragma unroll 1
        for (int rr = 0; rr < 4; ++rr) {
            const int m = r0 + F.wave * 4 + rr; const GAS f32x4* xr = (const GAS f32x4*)(F.x + (size_t)m * D) + F.lane;
            const LAS f32x4* sh = (const LAS f32x4*)sm + F.lane; const LAS f32x4* sc = (const LAS f32x4*)(sm + D) + F.lane;
            GAS v2u* o = (GAS v2u*)(hb + (size_t)m * D) + F.lane;
#pragma unroll
            for (int j = 0; j < 8; ++j) { const f32x4 v = xr[64 * j], a = sc[64 * j], s = sh[64 * j]; const f32x4 h = v * (a + 1.0f) + s;
                v2u w; w.x = pk2(h.x, h.y); w.y = pk2(h.z, h.w); o[64 * j] = w; }
        }
    }
}

constexpr int KS_PITCH = 144, VT_PITCH = 528, LDS_KS = 0, LDS_VT = 256 * KS_PITCH;
__device__ __forceinline__ void p2_attn_conv(Frame& F) {
    const bf16* proj = (const bf16*)(F.ws + WS_PROJ); bf16* mix = (bf16*)(F.ws + WS_MIX);
    const int fr = F.lane & 15, fq = F.lane >> 4;
    for (int unit = blockIdx.x; unit < NB * (SEQ / 128) * NKVH; unit += F.G) {
        const int hkv = unit % NKVH, nb = (unit / NKVH) % (SEQ / 128), b = unit / (NKVH * (SEQ / 128));
        const int rowbase = b * SEQ + nb * 128 - 128;
        __syncthreads();
#pragma unroll
        for (int it = 0; it < 4; ++it) {
            const int idx = F.tid + NTHR * it, j = idx >> 3, c = idx & 7;
            v4u kv = {0u, 0u, 0u, 0u};
            if (nb > 0 || j >= 128) kv = *(const GAS v4u*)(proj + (size_t)(rowbase + j) * INW + COL_K + hkv * HD + c * 8);
            *(LAS v4u*)(F.lds + LDS_KS + j * KS_PITCH + c * 16) = kv;
        }
#pragma unroll
        for (int it = 0; it < 4; ++it) {
            const int idx = F.tid + NTHR * it, j = idx & 255, c = idx >> 8;
            v4u vv = {0u, 0u, 0u, 0u};
            if (nb > 0 || j >= 128) vv = *(const GAS v4u*)(proj + (size_t)(rowbase + j) * INW + COL_V + hkv * HD + c * 8);
            LAS unsigned short* vt = (LAS unsigned short*)(F.lds + LDS_VT + (c * 8) * VT_PITCH + j * 2);
            vt[0 * (VT_PITCH / 2)] = (unsigned short)(vv.x & 0xffffu); vt[1 * (VT_PITCH / 2)] = (unsigned short)(vv.x >> 16);
            vt[2 * (VT_PITCH / 2)] = (unsigned short)(vv.y & 0xffffu); vt[3 * (VT_PITCH / 2)] = (unsigned short)(vv.y >> 16);
            vt[4 * (VT_PITCH / 2)] = (unsigned short)(vv.z & 0xffffu); vt[5 * (VT_PITCH / 2)] = (unsigned short)(vv.z >> 16);
            vt[6 * (VT_PITCH / 2)] = (unsigned short)(vv.w & 0xffffu); vt[7 * (VT_PITCH / 2)] = (unsigned short)(vv.w >> 16);
        }
        __syncthreads();
        const int g = F.wave & 3, half = F.wave >> 2, h = hkv * 4 + g;
        const float slope2 = exp2f(-0.5f * (float)(h + 1)) * 1.4426950408889634f;
        const float sink2 = F.sinks[h] * 1.4426950408889634f;
        const float qk2 = 0.125f * 1.4426950408889634f;
#pragma unroll 1
        for (int mi = 0; mi < 4; ++mi) {
            const int i = half * 4 + mi, j0 = i >> 1;
            const size_t qrow = (size_t)(b * SEQ + nb * 128 + 16 * i + fr);
            const bf16x8 q0 = *(const GAS bf16x8*)(proj + qrow * INW + h * HD + 8 * fq), q1 = *(const GAS bf16x8*)(proj + qrow * INW + h * HD + 32 + 8 * fq);
            f32x4 s[10];
#pragma unroll
            for (int x = 0; x < 10; ++x) {
                const int tt = 2 * j0 + x;
                const bf16x8 k0 = *(const LAS bf16x8*)(F.lds + LDS_KS + (16 * tt + fr) * KS_PITCH + 16 * fq), k1 = *(const LAS bf16x8*)(F.lds + LDS_KS + (16 * tt + fr) * KS_PITCH + 64 + 16 * fq);
                f32x4 a = {0.f, 0.f, 0.f, 0.f};
                a = __builtin_amdgcn_mfma_f32_16x16x32_bf16(k0, q0, a, 0, 0, 0);
                a = __builtin_amdgcn_mfma_f32_16x16x32_bf16(k1, q1, a, 0, 0, 0);
                s[x] = a;
            }
            float mx = sink2;
#pragma unroll
            for (int x = 0; x < 10; ++x) {
#pragma unroll
                for (int r = 0; r < 4; ++r) {
                    const int kj = 16 * (2 * j0 + x) + 4 * fq + r, dist = 16 * i + fr + 128 - kj;
                    const bool valid = (dist >= 0) && (dist < 128) && (nb > 0 || kj >= 128);
                    const float v = valid ? (s[x][r] * qk2 - slope2 * (float)dist) : -INFINITY;
                    s[x][r] = v; mx = fmaxf(mx, v);
                }
            }
            mx = fmaxf(mx, __shfl_xor(mx, 16)); mx = fmaxf(mx, __shfl_xor(mx, 32));
            float l = 0.f;
#pragma unroll
            for (int x = 0; x < 10; ++x) {
#pragma unroll
                for (int r = 0; r < 4; ++r) { const float p = __builtin_amdgcn_exp2f(s[x][r] - mx); s[x][r] = p; l += p; }
            }
            l += __shfl_xor(l, 16); l += __shfl_xor(l, 32);
            const float inv = 1.0f / (l + __builtin_amdgcn_exp2f(sink2 - mx));
            f32x4 o[4];
#pragma unroll
            for (int dt = 0; dt < 4; ++dt) o[dt] = (f32x4){0.f, 0.f, 0.f, 0.f};
#pragma unroll
            for (int pp = 0; pp < 5; ++pp) {
                const int tt0 = 2 * (j0 + pp);
                v4u pw; pw.x = pk2(s[2 * pp][0] * inv, s[2 * pp][1] * inv); pw.y = pk2(s[2 * pp][2] * inv, s[2 * pp][3] * inv);
                pw.z = pk2(s[2 * pp + 1][0] * inv, s[2 * pp + 1][1] * inv); pw.w = pk2(s[2 * pp + 1][2] * inv, s[2 * pp + 1][3] * inv);
                const bf16x8 pf = __builtin_bit_cast(bf16x8, pw);
#pragma unroll
                for (int dt = 0; dt < 4; ++dt) {
                    const LAS unsigned char* vp = F.lds + LDS_VT + (16 * dt + fr) * VT_PITCH + 32 * tt0 + 8 * fq;
                    const v2u lo = *(const LAS v2u*)vp, hi = *(const LAS v2u*)(vp + 32);
                    v4u vw; vw.x = lo.x; vw.y = lo.y; vw.z = hi.x; vw.w = hi.y;
                    o[dt] = __builtin_amdgcn_mfma_f32_16x16x32_bf16(__builtin_bit_cast(bf16x8, vw), pf, o[dt], 0, 0, 0);
                }
            }
#pragma unroll
            for (int dt = 0; dt < 4; ++dt) { v2u w; w.x = pk2(o[dt][0], o[dt][1]); w.y = pk2(o[dt][2], o[dt][3]);
                *(GAS v2u*)(mix + qrow * D + h * HD + 16 * dt + 4 * fq) = w; }
        }
    }
    for (int item = F.vcu * NTHR + F.tid; item < (M / 8) * (CW / 8); item += F.G * NTHR) {
        const int cch = item % (CW / 8), rb = item / (CW / 8), r0 = rb * 8, t0 = r0 % SEQ, c0 = cch * 8;
        float w0[8], w1[8], w2[8], u1[8], u2[8];
        { const f32x4 a = *(const GAS f32x4*)(F.conv_w + c0), b2 = *(const GAS f32x4*)(F.conv_w + c0 + 4);
          w0[0] = a.x; w0[1] = a.y; w0[2] = a.z; w0[3] = a.w; w0[4] = b2.x; w0[5] = b2.y; w0[6] = b2.z; w0[7] = b2.w; }
        { const f32x4 a = *(const GAS f32x4*)(F.conv_w + CW + c0), b2 = *(const GAS f32x4*)(F.conv_w + CW + c0 + 4);
          w1[0] = a.x; w1[1] = a.y; w1[2] = a.z; w1[3] = a.w; w1[4] = b2.x; w1[5] = b2.y; w1[6] = b2.z; w1[7] = b2.w; }
        { const f32x4 a = *(const GAS f32x4*)(F.conv_w + 2 * CW + c0), b2 = *(const GAS f32x4*)(F.conv_w + 2 * CW + c0 + 4);
          w2[0] = a.x; w2[1] = a.y; w2[2] = a.z; w2[3] = a.w; w2[4] = b2.x; w2[5] = b2.y; w2[6] = b2.z; w2[7] = b2.w; }
        if (t0 == 0) {
#pragma unroll
            for (int q = 0; q < 8; ++q) { u1[q] = 0.f; u2[q] = 0.f; }
        } else {
            const v4u c1 = *(const GAS v4u*)(proj + (size_t)(r0 - 1) * INW + COL_CC + c0), h1 = *(const GAS v4u*)(proj + (size_t)(r0 - 1) * INW + COL_CH + c0);
            const v4u c2 = *(const GAS v4u*)(proj + (size_t)(r0 - 2) * INW + COL_CC + c0), h2 = *(const GAS v4u*)(proj + (size_t)(r0 - 2) * INW + COL_CH + c0);
            u1[0] = bflo(c1.x) * bflo(h1.x); u1[1] = bfhi(c1.x) * bfhi(h1.x); u1[2] = bflo(c1.y) * bflo(h1.y); u1[3] = bfhi(c1.y) * bfhi(h1.y);
            u1[4] = bflo(c1.z) * bflo(h1.z); u1[5] = bfhi(c1.z) * bfhi(h1.z); u1[6] = bflo(c1.w) * bflo(h1.w); u1[7] = bfhi(c1.w) * bfhi(h1.w);
            u2[0] = bflo(c2.x) * bflo(h2.x); u2[1] = bfhi(c2.x) * bfhi(h2.x); u2[2] = bflo(c2.y) * bflo(h2.y); u2[3] = bfhi(c2.y) * bfhi(h2.y);
            u2[4] = bflo(c2.z) * bflo(h2.z); u2[5] = bfhi(c2.z) * bfhi(h2.z); u2[6] = bflo(c2.w) * bflo(h2.w); u2[7] = bfhi(c2.w) * bfhi(h2.w);
        }
#pragma unroll
        for (int rr = 0; rr < 8; ++rr) {
            const size_t ro = (size_t)(r0 + rr) * INW;
            const v4u bv = *(const GAS v4u*)(proj + ro + COL_CB + c0), cv = *(const GAS v4u*)(proj + ro + COL_CC + c0), hv = *(const GAS v4u*)(proj + ro + COL_CH + c0);
            float u0[8], cb[8], y[8];
            u0[0] = bflo(cv.x) * bflo(hv.x); u0[1] = bfhi(cv.x) * bfhi(hv.x); u0[2] = bflo(cv.y) * bflo(hv.y); u0[3] = bfhi(cv.y) * bfhi(hv.y);
            u0[4] = bflo(cv.z) * bflo(hv.z); u0[5] = bfhi(cv.z) * bfhi(hv.z); u0[6] = bflo(cv.w) * bflo(hv.w); u0[7] = bfhi(cv.w) * bfhi(hv.w);
            cb[0] = bflo(bv.x); cb[1] = bfhi(bv.x); cb[2] = bflo(bv.y); cb[3] = bfhi(bv.y); cb[4] = bflo(bv.z); cb[5] = bfhi(bv.z); cb[6] = bflo(bv.w); cb[7] = bfhi(bv.w);
#pragma unroll
            for (int q = 0; q < 8; ++q) { y[q] = cb[q] * (w0[q] * u2[q] + w1[q] * u1[q] + w2[q] * u0[q]); u2[q] = u1[q]; u1[q] = u0[q]; }
            v4u ov; ov.x = pk2(y[0], y[1]); ov.y = pk2(y[2], y[3]); ov.z = pk2(y[4], y[5]); ov.w = pk2(y[6], y[7]);
            *(GAS v4u*)(mix + (size_t)(r0 + rr) * D + AW + c0) = ov;
        }
    }
}

constexpr int P4_STAT = 0, P4_GB = 1024, P4_PART = P4_GB + 2 * D * 4, P4_END = P4_PART + 8 * 32 * 64 * 4;
static_assert(P4_END <= RING_BYTES, "P4 LDS");
__device__ __forceinline__ void p4_ln_router(Frame& F, int u_first, int u_stride) {
    const bf16* y1 = (const bf16*)(F.ws + WS_Y1); bf16* x1 = (bf16*)(F.ws + WS_X1); bf16* xg = (bf16*)(F.ws + WS_XG);
    const float* modf = (const float*)(F.ws + WS_MODF);
    const bf16* WrHi = (const bf16*)(F.ws + WS_WRT); const bf16* WrLo = WrHi + NE * D;
    int* rowtok = (int*)(F.ws + WS_ROWTOK); float* roww = (float*)(F.ws + WS_ROWW); int* tokslot = (int*)(F.ws + WS_TOKSLOT);
    LAS float* stat = (LAS float*)(F.lds + P4_STAT); LAS float* GB = (LAS float*)(F.lds + P4_GB); LAS float* lpart = (LAS float*)(F.lds + P4_PART);
    const int fr = F.lane & 15, fq = F.lane >> 4;
    for (int unit = u_first; unit < M / 32; unit += u_stride) {
        const int row0 = unit * 32, b = row0 / SEQ;
        const float* sh2 = modf + (size_t)b * 6 * D + 3 * D; const float* sc2 = modf + (size_t)b * 6 * D + 4 * D;
        __syncthreads();
        if (F.tid < NE) ((LAS unsigned*)(F.lds + P4_STAT + 512))[F.tid] = 0u;
        for (int k = F.tid; k < D; k += NTHR) { const float a = 1.0f + sc2[k]; GB[k] = F.ln1_g[k] * a; GB[D + k] = F.ln1_b[k] * a + sh2[k]; }
#pragma unroll 1
        for (int rr = 0; rr < 4; ++rr) {
            const int r = F.wave * 4 + rr; const size_t m = (size_t)(row0 + r);
            const GAS v4u* yr = (const GAS v4u*)(y1 + m * D) + F.lane;
            f32x4 v[8]; float s = 0.f;
#pragma unroll
            for (int c = 0; c < 4; ++c) { const v4u w = yr[64 * c]; v[2 * c] = (f32x4){bflo(w.x), bfhi(w.x), bflo(w.y), bfhi(w.y)}; v[2 * c + 1] = (f32x4){bflo(w.z), bfhi(w.z), bflo(w.w), bfhi(w.w)}; }
#pragma unroll
            for (int j = 0; j < 8; ++j) s += (v[j].x + v[j].y) + (v[j].z + v[j].w);
            const float mean = wave_sum(s) * (1.f / D); float s2 = 0.f;
#pragma unroll
            for (int j = 0; j < 8; ++j) { v[j] = v[j] - mean; s2 += (v[j].x * v[j].x + v[j].y * v[j].y) + (v[j].z * v[j].z + v[j].w * v[j].w); }
            const float rstd = 1.f / sqrtf(wave_sum(s2) * (1.f / D) + LN_EPS);
            if (F.lane == 0) { stat[2 * r] = mean; stat[2 * r + 1] = rstd; }
            GAS v2u* xo = (GAS v2u*)(x1 + m * D); GAS v2u* ho = (GAS v2u*)(xg + m * D); GAS unsigned* ho8 = (GAS unsigned*)((unsigned char*)xg + m * D);
#pragma unroll
            for (int j = 0; j < 8; ++j) {
                const int q4 = 128 * (j >> 1) + 2 * F.lane + (j & 1);
                const f32x4 g = *((const GAS f32x4*)F.ln1_g + q4), bb = *((const GAS f32x4*)F.ln1_b + q4);
                const f32x4 a = *((const GAS f32x4*)sc2 + q4), sft = *((const GAS f32x4*)sh2 + q4);
                const f32x4 xv = v[j] * rstd * g + bb; { v2u xw; xw.x = pk2(xv.x, xv.y); xw.y = pk2(xv.z, xv.w); xo[q4] = xw; }
                const f32x4 hv = xv * (a + 1.0f) + sft;
                if (MOE_F8) { f32x4 t = hv * pg8::F8_SX;
#pragma unroll
                    for (int q = 0; q < 4; ++q) t[q] = __builtin_fminf(__builtin_fmaxf(t[q], -440.0f), 440.0f);
                    int pa = __builtin_amdgcn_cvt_pk_fp8_f32(t.x, t.y, 0, false); pa = __builtin_amdgcn_cvt_pk_fp8_f32(t.z, t.w, pa, true); ho8[q4] = (unsigned)pa; }
                else { v2u w; w.x = pk2(hv.x, hv.y); w.y = pk2(hv.z, hv.w); ho[q4] = w; }
            }
        }
        __syncthreads();
        {
            f32x4 acc[2][4];
#pragma unroll
            for (int mt = 0; mt < 2; ++mt)
#pragma unroll
                for (int nt = 0; nt < 4; ++nt) acc[mt][nt] = (f32x4){0.f, 0.f, 0.f, 0.f};
            const float mu0 = stat[2 * fr], rs0 = stat[2 * fr + 1], mu1 = stat[2 * (16 + fr)], rs1 = stat[2 * (16 + fr) + 1];
#pragma unroll 4
            for (int ks = F.wave * 8; ks < F.wave * 8 + 8; ++ks) {
                const int k0 = 32 * ks + 8 * fq;
                const f32x4 g0 = *(const LAS f32x4*)(GB + k0), g1 = *(const LAS f32x4*)(GB + k0 + 4), b0 = *(const LAS f32x4*)(GB + D + k0), b1 = *(const LAS f32x4*)(GB + D + k0 + 4);
                bf16x8 whi[4], wlo[4];
#pragma unroll
                for (int nt = 0; nt < 4; ++nt) { whi[nt] = *(const GAS bf16x8*)(WrHi + (size_t)(16 * nt + fr) * D + k0); wlo[nt] = *(const GAS bf16x8*)(WrLo + (size_t)(16 * nt + fr) * D + k0); }
#pragma unroll
                for (int mt = 0; mt < 2; ++mt) {
                    const float mu = mt ? mu1 : mu0, rs = mt ? rs1 : rs0;
                    const v4u yw = *(const GAS v4u*)(y1 + (size_t)(row0 + 16 * mt + fr) * D + k0);
                    const f32x4 ya = {bflo(yw.x), bfhi(yw.x), bflo(yw.y), bfhi(yw.y)}, yb = {bflo(yw.z), bfhi(yw.z), bflo(yw.w), bfhi(yw.w)};
                    const f32x4 ha = (ya - mu) * rs * g0 + b0, hb2 = (yb - mu) * rs * g1 + b1;
                    unsigned hh[8], ll[8];
                    { const float t[8] = {ha.x, ha.y, ha.z, ha.w, hb2.x, hb2.y, hb2.z, hb2.w};
#pragma unroll
                      for (int q = 0; q < 8; ++q) { hh[q] = f2bf(t[q]); ll[q] = f2bf(t[q] - bf2f(hh[q])); } }
                    v4u ah, al; ah.x = hh[0] | (hh[1] << 16); ah.y = hh[2] | (hh[3] << 16); ah.z = hh[4] | (hh[5] << 16); ah.w = hh[6] | (hh[7] << 16);
                    al.x = ll[0] | (ll[1] << 16); al.y = ll[2] | (ll[3] << 16); al.z = ll[4] | (ll[5] << 16); al.w = ll[6] | (ll[7] << 16);
                    const bf16x8 fh = __builtin_bit_cast(bf16x8, ah), fl = __builtin_bit_cast(bf16x8, al);
#pragma unroll
                    for (int nt = 0; nt < 4; ++nt) {
                        acc[mt][nt] = __builtin_amdgcn_mfma_f32_16x16x32_bf16(fh, whi[nt], acc[mt][nt], 0, 0, 0);
                        acc[mt][nt] = __builtin_amdgcn_mfma_f32_16x16x32_bf16(fl, whi[nt], acc[mt][nt], 0, 0, 0);
                        acc[mt][nt] = __builtin_amdgcn_mfma_f32_16x16x32_bf16(fh, wlo[nt], acc[mt][nt], 0, 0, 0);
                    }
                }
            }
#pragma unroll
            for (int mt = 0; mt < 2; ++mt)
#pragma unroll
                for (int nt = 0; nt < 4; ++nt)
#pragma unroll
                    for (int r = 0; r < 4; ++r) lpart[(F.wave * 32 + 16 * mt + 4 * fq + r) * 64 + 16 * nt + fr] = acc[mt][nt][r];
        }
        __syncthreads();
        {
            LAS unsigned* hist = (LAS unsigned*)(F.lds + P4_STAT + 512); LAS unsigned* hbase = hist + 64;
            const int e = F.lane; const float rb = F.router_bias[e];
            bool chosen[4]; float wgt[4]; int erks[4]; unsigned lrank[4];
#pragma unroll
            for (int rr = 0; rr < 4; ++rr) {
                const int r = F.wave * 4 + rr;
                float logit = 0.f;
#pragma unroll
                for (int w = 0; w < 8; ++w) logit += lpart[(w * 32 + r) * 64 + e];
                const float score = 1.0f / (1.0f + __expf(-logit));
                const float sel = score + rb;
                int rk = 0;
#pragma unroll
                for (int x = 1; x < 8; ++x) { const float o = __shfl_xor(sel, x); const int e2 = e ^ x; rk += (o > sel || (o == sel && e2 < e)) ? 1 : 0; }
                float gs = rk < 2 ? sel : 0.f;
                gs += __shfl_xor(gs, 1); gs += __shfl_xor(gs, 2); gs += __shfl_xor(gs, 4);
                int grk = 0; const int gi = e >> 3;
#pragma unroll
                for (int x = 1; x < 8; ++x) { const float o = __shfl_xor(gs, 8 * x); const int g2 = gi ^ x; grk += (o > gs || (o == gs && g2 < gi)) ? 1 : 0; }
                const bool gsel = grk < 4;
                const float mv = gsel ? sel : -INFINITY;
                int erk = 0;
#pragma unroll 9
                for (int x = 1; x < 64; ++x) { const float o = __shfl_xor(mv, x); const int e2 = e ^ x; erk += (o > mv || (o == mv && e2 < e)) ? 1 : 0; }
                chosen[rr] = gsel && erk < TOPK; erks[rr] = erk;
                const float wsum = wave_sum(chosen[rr] ? score : 0.f);
                wgt[rr] = score / wsum * RSCALE;
                lrank[rr] = chosen[rr] ? __hip_atomic_fetch_add(hist + e, 1u, __ATOMIC_RELAXED, __HIP_MEMORY_SCOPE_WORKGROUP) : 0u;
            }
            __syncthreads();
            if (F.tid < NE) { const unsigned n = hist[F.tid]; hbase[F.tid] = n ? __hip_atomic_fetch_add(F.ctl + CW_CNT + 64 * F.tid, n, RLX_AGENT) : 0u; }
            __syncthreads();
            const unsigned pb = hbase[e];
#pragma unroll
            for (int rr = 0; rr < 4; ++rr) if (chosen[rr]) { const int tok = row0 + F.wave * 4 + rr; const unsigned pos = pb + lrank[rr];
                rowtok[e * M + pos] = tok; roww[e * M + pos] = wgt[rr]; tokslot[tok * TOPK + erks[rr]] = e * M + (int)pos; }
        }
    }
}

__device__ __forceinline__ void build_tables(Frame& F) {
    LAS unsigned short* tslot = (LAS unsigned short*)(F.lds + TS_OFF); LAS int* poff = (LAS int*)(F.lds + POFF_OFF); LAS int* cnt = poff + 128; LAS int* nt_p = poff + 256;
    __syncthreads();
    if (F.tid < NE) cnt[F.tid] = (int)__hip_atomic_load(F.ctl + CW_CNT + 64 * F.tid, RLX_AGENT);
    __syncthreads();
    if (F.tid == 0) {
        int t = M / 256; poff[0] = 0;
        for (int i = 0; i < M / 256; ++i) tslot[i] = 0;
        for (int e = 0; e < NE; ++e) { poff[1 + e] = t * 256; int c = cnt[e]; c = c < 0 ? 0 : (c > M ? M : c); const int n = (c + 255) >> 8; for (int i = 0; i < n && t < MAXT; ++i) tslot[t++] = (unsigned short)(1 + e); }
        nt_p[0] = t;
    }
    __syncthreads();
}

__device__ __forceinline__ void p6_setup(Frame& F, int Geff, int c) {
    const LAS unsigned short* tslot = (const LAS unsigned short*)(F.lds + TS_OFF); const LAS int* poff = (const LAS int*)(F.lds + POFF_OFF); const LAS int* cnt = poff + 128; const int ntiles = poff[256];
    const int* rowtok = (const int*)(F.ws + WS_ROWTOK); const float* roww = (const float*)(F.ws + WS_ROWW); float* wrow = (float*)(F.ws + WS_WROW);
    v4u* vt = (v4u*)(F.ws + WS_VTAB) + (size_t)blockIdx.x * 8 * NTHR;
    int R0, C0, R1, C1; pg8::stage_rc(F.tid * 16, R0, C0); pg8::stage_rc(F.tid * 16 + 8192, R1, C1);
#pragma unroll 1
    for (int i = 0; i < 8; ++i) {
        const int L = i * Geff + c; if (L >= ntiles * 4) break;
        const int t = L >> 2, s = tslot[t], e = s - 1, pos0 = t * 256 - poff[s], ce = s ? cnt[e] : 0;
        int rr[4] = {R0, R1, 128 + R0, 128 + R1}; const int cc[4] = {C0, C1, C0, C1}; unsigned off[4];
#pragma unroll
        for (int q = 0; q < 4; ++q) { int tok = t * 256 + rr[q]; if (s) { const int pos = pos0 + rr[q]; tok = pos < ce ? rowtok[e * M + pos] : 0; } off[q] = (unsigned)(tok * (MOE_F8 ? D / 2 : D) + cc[q]) * 2u; }
        v4u o; o.x = off[0]; o.y = off[1]; o.z = off[2]; o.w = off[3]; vt[i * NTHR + F.tid] = o;
        if (F.tid < 256) { float w = 1.0f; if (s) { const int pos = pos0 + F.tid; w = pos < ce ? roww[e * M + pos] : 0.f; } wrow[t * 256 + F.tid] = w; }
    }
    VM_WAIT(); __syncthreads();
}

__device__ __forceinline__ void p7_combine(Frame& F) {
    build_tables(F);
    const LAS int* poff = (const LAS int*)(F.lds + POFF_OFF);
    const unsigned char* Y = (const unsigned char*)(F.ws + WS_XG); const bf16* x1 = (const bf16*)(F.ws + WS_X1); const float* modf = (const float*)(F.ws + WS_MODF);
    const int* tokslot = (const int*)(F.ws + WS_TOKSLOT);
    const int gw = F.vcu * NWAVES + F.wave, NGW = F.G * NWAVES;
    typedef float f32x2 __attribute__((ext_vector_type(2)));
    for (int m = gw; m < M; m += NGW) {
        const int b = m / SEQ; const float* g2 = modf + (size_t)b * 6 * D + 5 * D;
        int ln = F.lane; asm volatile("" : "+v"(ln));
        int rows[9]; rows[0] = m;
#pragma unroll
        for (int k = 0; k < TOPK; ++k) { const int sl = __builtin_amdgcn_readfirstlane(tokslot[m * TOPK + k]), e = sl / M, pos = sl % M; rows[1 + k] = poff[1 + e] + pos; }
        f32x4 v[2][4];
#pragma unroll
        for (int j = 0; j < 2; ++j)
#pragma unroll
            for (int q = 0; q < 4; ++q) v[j][q] = (f32x4){0.f, 0.f, 0.f, 0.f};
        v4u w[9][2];
#pragma unroll
        for (int k = 0; k < 9; ++k) { const GAS v4u* yr = (const GAS v4u*)(Y + (size_t)rows[k] * D); w[k][0] = yr[ln]; w[k][1] = yr[64 + ln]; }
        f32x4 xv[2][4];
        { const GAS v4u* xr0 = (const GAS v4u*)(x1 + (size_t)m * D);
#pragma unroll
          for (int j = 0; j < 2; ++j)
#pragma unroll
              for (int h = 0; h < 2; ++h) { const v4u w = xr0[2 * ln + 128 * j + h];
                  xv[j][2 * h] = (f32x4){bflo(w.x), bfhi(w.x), bflo(w.y), bfhi(w.y)}; xv[j][2 * h + 1] = (f32x4){bflo(w.z), bfhi(w.z), bflo(w.w), bfhi(w.w)}; } }
#pragma unroll
        for (int k = 0; k < 9; ++k)
#pragma unroll
            for (int j = 0; j < 2; ++j) {
                const unsigned ww[4] = {w[k][j].x, w[k][j].y, w[k][j].z, w[k][j].w};
#pragma unroll
                for (int q = 0; q < 4; ++q) { const f32x2 lo = (Y_BF8 == 2) ? __builtin_amdgcn_cvt_pk_f32_fp8((int)ww[q], false) : __builtin_amdgcn_cvt_pk_f32_bf8((int)ww[q], false), hi = (Y_BF8 == 2) ? __builtin_amdgcn_cvt_pk_f32_fp8((int)ww[q], true) : __builtin_amdgcn_cvt_pk_f32_bf8((int)ww[q], true);
                    v[j][q].x += lo.x; v[j][q].y += lo.y; v[j][q].z += hi.x; v[j][q].w += hi.y; }
            }
        const GAS f32x4* gr = (const GAS f32x4*)g2; const int l4 = 4 * ln; float s = 0.f;
#pragma unroll
        for (int j = 0; j < 2; ++j)
#pragma unroll
            for (int q = 0; q < 4; ++q) { v[j][q] = xv[j][q] * ALPHA + (gr[l4 + 256 * j + q] + 1.0f) * (v[j][q] * ((Y_BF8 == 2) ? (1.0f / 64.0f) : 1.0f)); s += (v[j][q].x + v[j][q].y) + (v[j][q].z + v[j][q].w); }
        const float mean = wave_sum(s) * (1.f / D); float s2 = 0.f;
#pragma unroll
        for (int j = 0; j < 2; ++j)
#pragma unroll
            for (int q = 0; q < 4; ++q) { v[j][q] = v[j][q] - mean; s2 += (v[j][q].x * v[j][q].x + v[j][q].y * v[j][q].y) + (v[j][q].z * v[j][q].z + v[j][q].w * v[j][q].w); }
        const float rstd = 1.f / sqrtf(wave_sum(s2) * (1.f / D) + LN_EPS);
        GAS f32x4* o = (GAS f32x4*)(F.out + (size_t)m * D); const GAS f32x4* lg = (const GAS f32x4*)F.ln2_g; const GAS f32x4* lb = (const GAS f32x4*)F.ln2_b;
#pragma unroll
        for (int j = 0; j < 2; ++j)
#pragma unroll
            for (int q = 0; q < 4; ++q) o[l4 + 256 * j + q] = v[j][q] * rstd * lg[l4 + 256 * j + q] + lb[l4 + 256 * j + q];
    }
}

constexpr int NPHASE = 9;
struct Args { const float* in[20]; float* out; unsigned char* ws; int ph_lo, ph_hi; };
__global__ void __launch_bounds__(NWAVES * 64, 2) mk_fwd(Args args) {
    extern __shared__ __attribute__((aligned(16))) unsigned char lds[];
    Frame F;
    F.lds = (LAS unsigned char*)lds;
    F.MISC = (volatile LAS unsigned*)(F.lds + MISC_OFF);
    F.tid = threadIdx.x; F.lane = F.tid & 63; F.wave = __builtin_amdgcn_readfirstlane(F.tid >> 6);
    F.G = gridDim.x; { const int bx = blockIdx.x; F.vcu = (F.G % 8 == 0) ? (bx % 8) * (F.G / 8) + bx / 8 : bx; }
    F.ws = args.ws; F.ctl = (gu32*)(args.ws + WS_CTL);
    F.x = args.in[0]; F.c = args.in[1]; F.w_mod = args.in[2]; F.b_mod = args.in[3]; F.w_in = args.in[4]; F.conv_w = args.in[5]; F.sinks = args.in[6]; F.w_out = args.in[7];
    F.ln1_g = args.in[8]; F.ln1_b = args.in[9]; F.w_router = args.in[10]; F.router_bias = args.in[11]; F.w_gate = args.in[12]; F.w_up = args.in[13]; F.w_down = args.in[14];
    F.ws_gate = args.in[15]; F.ws_up = args.in[16]; F.ws_down = args.in[17]; F.ln2_g = args.in[18]; F.ln2_b = args.in[19]; F.out = args.out;
    for (int u = F.tid; u < (LDS_BYTES - LDSCTL_OFF) / 4; u += NWAVES * 64) ((LAS unsigned*)(F.lds + LDSCTL_OFF))[u] = 0u;
    __syncthreads();
    XcdBarrier bar; bar.bar = (unsigned*)(F.ctl + CW_BAR); bar.x = 0; bar.st = nullptr;
    if (!MK_PER_PHASE) bar = xcd_barrier_post((unsigned*)(F.ctl + CW_BAR), F.MISC + 8);
#define GRID_BAR() do { if (!MK_PER_PHASE) xcd_barrier(bar); } while (0)
    unsigned long long tA = 0;
#define ST_BEGIN(k) do { if (PROBE_STAMP == (k)) tA = __builtin_amdgcn_s_memrealtime(); } while (0)
#define ST_END(k) do { if (PROBE_STAMP == (k)) { const unsigned long long t1 = __builtin_amdgcn_s_memrealtime(), dd = t1 - tA; while (__builtin_amdgcn_s_memrealtime() - t1 < dd) __builtin_amdgcn_s_sleep(8); } } while (0)
    const int lo = args.ph_lo, hi = args.ph_hi;
#define IN(k) (lo <= (k) && (k) < hi && ((F.lane = pg8::lane_id_v()), (F.tid = F.wave * 64 + F.lane), true))
#define BOTH(k) (IN(k) && IN((k) + 1))
    if (IN(0)) { ST_BEGIN(0); p0_gemv(F, 0, 16); if (BOTH(0)) GRID_BAR(); ST_END(0); }
    if (IN(1)) { ST_BEGIN(1); p1a_modulate(F); p0_gemv(F, 16, 48); p0_static_conv(F); if (BOTH(1)) GRID_BAR(); ST_END(1); }
    if (IN(2)) {
        ST_BEGIN(2);
        __syncthreads();
        const bool split = (F.G == 256); const int q = (int)blockIdx.x >> 3, x = (int)blockIdx.x & 7, Geff = split ? 192 : F.G;
        if (!split || q < 24) {
            pg8::Gemm g{(const pg8::bf16_t*)(F.ws + WS_HB), (const pg8::bf16_t*)(F.ws + WS_WINT), M, INW, D, F.ws}; pg8::StaticOrder S; S.init(M, INW, Geff, split ? q * 8 + x : (int)blockIdx.x);
            pg8::EpiBf16<0> E{(pg8::bf16_t*)(F.ws + WS_PROJ), INW, nullptr, 0, 0, 1.f};
            pg8::gemm_phase<pg8::EpiBf16<0>, pg8::StaticOrder, PG8_ALIGN, PG8_SP2>(F.lds + RING_OFF, g, S, E, F.wave);
            phase_fin(F, CW_FIN + 64 * 2);
        } else { drain(F, 0, CW_FIN + 64 * 2, (unsigned)Geff); drain(F, 1, CW_FIN + 64 * 2, (unsigned)Geff); }
        if (BOTH(2)) GRID_BAR();
        ST_END(2);
    }
    if (IN(3)) { ST_BEGIN(3); modf_reduce(F); p2_attn_conv(F); if (BOTH(3)) GRID_BAR(); ST_END(3); }
    if (IN(4)) {
        ST_BEGIN(4);
        _Pragma("unroll") for (int rep = (REP_PHASE == 4 ? 0 : 1); rep < 2; ++rep) {
        __syncthreads();
        pg8::Gemm g{(const pg8::bf16_t*)(F.ws + WS_MIX), (const pg8::bf16_t*)(F.ws + WS_WOUTT), M, D, D, F.ws}; pg8::StaticOrder S; S.init(M, D, F.G, (int)blockIdx.x);
        pg8::EpiResF32 E{F.x, (pg8::bf16_t*)(F.ws + WS_Y1), (const float*)(F.ws + WS_MODF) + 2 * D, D, SEQ, 6 * D, ALPHA};
        pg8::gemm_phase<pg8::EpiResF32, pg8::StaticOrder, PG8_ALIGN, PG8_SP2>(F.lds + RING_OFF, g, S, E, F.wave);
        if (rep == 0) GRID_BAR(); }
        if (BOTH(4)) GRID_BAR();
        ST_END(4);
    }
    if (IN(5)) { ST_BEGIN(5);
        const bool split5 = (F.G == 256) && (P5_MAIN_Q < 32); const int q5 = (int)blockIdx.x >> 3, x5 = (int)blockIdx.x & 7, nmain = split5 ? 8 * P5_MAIN_Q : F.G;
        if (!split5 || q5 < P5_MAIN_Q) { p4_ln_router(F, split5 ? q5 * 8 + x5 : (int)blockIdx.x, nmain); phase_fin(F, CW_FIN + 64 * 5); }
        else { drain(F, 0, CW_FIN + 64 * 5, (unsigned)nmain); drain(F, 1, CW_FIN + 64 * 5, (unsigned)nmain); }
        __syncthreads(); ST_BEGIN(10); drain(F, 0, -1, 0u); ST_END(10); if (BOTH(5)) GRID_BAR(); ST_END(5); }
    if (IN(6)) {
        ST_BEGIN(6); ST_BEGIN(12);
        build_tables(F);
        const int ntiles = ((const LAS int*)(F.lds + POFF_OFF))[256];
        const int units = ntiles * 4, Rn = (units + F.G - 1) / F.G, slack = F.G - (units + Rn - 1) / Rn, R = (F.G == 256 && slack < P6_MIN_CONV) ? Rn + 1 : Rn, Geff = (F.G % 8 == 0) ? (units + R - 1) / R : F.G;
        const int x = (int)blockIdx.x & 7, q = (int)blockIdx.x >> 3;
        int c = (int)blockIdx.x;
        if (F.G % 8 == 0) { int px = 0; for (int xx = 0; xx < x; ++xx) px += (Geff - xx + 7) >> 3; c = px + q; }
        if ((int)blockIdx.x < Geff) {
            p6_setup(F, Geff, c);
            int Kgu = MOE_F8 ? D / 2 : D; asm volatile("" : "+s"(Kgu));
            pg8::Gemm g{(const pg8::bf16_t*)(F.ws + WS_XG), (const pg8::bf16_t*)(F.ws + WS_WGUT), M, NSLOT * 1024, Kgu, F.ws};
            pg8::GroupedOrder<true> S{(const PG8_LAS unsigned short*)(F.lds + TS_OFF), ntiles, 4, Geff, c, (const unsigned*)(F.ws + WS_VTAB) + (size_t)blockIdx.x * 8 * NTHR * 4};
            pg8::EpiSwiGLU E{(pg8::bf16_t*)(F.ws + WS_H), (const float*)(F.ws + WS_WROW), DE, 4};
            pg8::gemm_phase<pg8::EpiSwiGLU, pg8::GroupedOrder<true>, PG8_ALIGN, PG8_SP2>(F.lds + RING_OFF, g, S, E, F.wave);
            phase_fin(F, CW_FIN + 64 * 6);
        } else drain(F, 1, CW_FIN + 64 * 6, (unsigned)Geff);
        __syncthreads();
        ST_END(12); ST_BEGIN(11);
        drain(F, 1, -1, 0u);
        ST_END(11);
        if (BOTH(6)) GRID_BAR();
        ST_END(6);
    }
    if (IN(7)) {
        ST_BEGIN(7);
        _Pragma("unroll") for (int rep = (REP_PHASE == 7 ? 0 : 1); rep < 2; ++rep) {
        build_tables(F);
        const int ntiles = ((const LAS int*)(F.lds + POFF_OFF))[256];
        int Kdn = MOE_F8 ? DE / 2 : DE; asm volatile("" : "+s"(Kdn));
        pg8::Gemm g{(const pg8::bf16_t*)(F.ws + WS_H), (const pg8::bf16_t*)(F.ws + WS_WDT), MAXR, NSLOT * D, Kdn, F.ws};
        pg8::GroupedOrder<false> S{(const PG8_LAS unsigned short*)(F.lds + TS_OFF), ntiles, 8, F.G, F.vcu, nullptr, (PROBE_PIN && rep == 0) ? 1 : 0};
        pg8::EpiDown E{(pg8::bf16_t*)(F.ws + WS_XG), D, 8, (PROBE_NOSTORE && rep == 0) ? 1 : 0};
        if (DOWN_STAGGER) {
            const unsigned long long t0 = __builtin_amdgcn_s_memrealtime(), dl = (unsigned long long)(((unsigned)F.vcu >> 3) & 7u) * DOWN_STAGGER;
            while (__builtin_amdgcn_s_memrealtime() - t0 < dl) __builtin_amdgcn_s_sleep(4);
        }
        pg8::gemm_phase<pg8::EpiDown, pg8::GroupedOrder<false>, PG8_ALIGN, PG8_SP2>(F.lds + RING_OFF, g, S, E, F.wave);
        if (rep == 0) GRID_BAR(); }
        if (BOTH(7)) GRID_BAR();
        ST_END(7);
    }
    if (IN(8)) { ST_BEGIN(8); p7_combine(F); VM_WAIT(); ST_END(8); }
#undef IN
#undef BOTH
}

extern "C" void kernel_launch(void* const* d_in, const int* in_sizes, int n_in, void* d_out, int out_size, void* d_ws, size_t ws_size, hipStream_t stream) {
    static int grid = 0;
    if (grid == 0) {
        if (n_in != 20 || in_sizes[0] != M * D || out_size != M * D || ws_size < WS_END) { fprintf(stderr, "kernel_launch: unexpected shapes (n_in %d, in0 %d, out %d, ws %zu)\n", n_in, n_in > 0 ? in_sizes[0] : -1, out_size, ws_size); grid = -1; return; }
        int dev = 0, cus = 0, per_cu = 0;
        if (hipGetDevice(&dev) != hipSuccess || hipDeviceGetAttribute(&cus, hipDeviceAttributeMultiprocessorCount, dev) != hipSuccess) { grid = -1; return; }
        if (hipFuncSetAttribute((const void*)mk_fwd, hipFuncAttributeMaxDynamicSharedMemorySize, LDS_BYTES) != hipSuccess) { fprintf(stderr, "kernel_launch: hipFuncSetAttribute failed\n"); grid = -1; return; }
        if (hipOccupancyMaxActiveBlocksPerMultiprocessor(&per_cu, (const void*)mk_fwd, NWAVES * 64, LDS_BYTES) != hipSuccess || per_cu < 1) fprintf(stderr, "kernel_launch: occupancy query reports %d\n", per_cu);
        (void)hipGetLastError();
        grid = cus;
    }
    if (grid < 0) return;
    if (hipMemsetAsync((char*)d_ws + WS_CTL, 0, CTL_ZERO_BYTES, stream) != hipSuccess) return;
    Args a{};
    for (int i = 0; i < 20; ++i) a.in[i] = (const float*)d_in[i];
    a.out = (float*)d_out; a.ws = (unsigned char*)d_ws;
#if MK_PER_PHASE
    for (int p = 0; p < NPHASE; ++p) { a.ph_lo = p; a.ph_hi = p + 1; hipLaunchKernelGGL(mk_fwd, dim3(grid), dim3(NWAVES * 64), LDS_BYTES, stream, a); }
#else
    a.ph_lo = 0; a.ph_hi = NPHASE; hipLaunchKernelGGL(mk_fwd, dim3(grid), dim3(NWAVES * 64), LDS_BYTES, stream, a);
#endif
}
```

```cpp
#include <hip/hip_runtime.h>
#include <cstdio>
#include <cstdint>
#include <cmath>
#ifndef MOE_F8
#define MOE_F8 1
#endif
#ifndef Y_BF8
#define Y_BF8 2
#endif
namespace pg8 {
constexpr float F8_SX = 8.0f, F8_SWG = 64.0f, F8_SH = 8.0f, F8_SWD = 8.0f;
#define PG8_LAS __attribute__((address_space(3)))
typedef unsigned short bf16_t;
typedef short bf16x8 __attribute__((ext_vector_type(8)));
typedef float f32x4 __attribute__((ext_vector_type(4)));
typedef unsigned u32x4 __attribute__((ext_vector_type(4)));
constexpr int BM = 256, BK = 64, HALF = 128, HTB = HALF * BK * 2  , STAGE_BYTES = 8 * HTB, NXCD = 8, WGM = 8;
constexpr int VT_SLOT = STAGE_BYTES + 4096;
constexpr int WR_SLOT = STAGE_BYTES + 12288;

__host__ __device__ __forceinline__ int lds_byte(int r, int c) { const int st = (r >> 4) * 2 + (c >> 5), rr = r & 15, cc = c & 31, ob = rr * 64 + cc * 2; return st * 1024 + (ob ^ (((ob >> 9) & 1) << 5)); }
__host__ __device__ __forceinline__ void stage_rc(int b, int& R, int& C) { const int st = b / 1024, sb = b % 1024, swz = sb ^ (((sb >> 9) & 1) << 5); R = (st >> 1) * 16 + swz / 64; C = (st & 1) * 32 + (swz % 64) / 2; }
__host__ __device__ __forceinline__ int perm32(int rho) { const int n = rho >> 4, i = rho & 15; return 8 * (i >> 2) + 4 * n + (i & 3); }

__device__ __forceinline__ int lane_id_v() { int l; asm volatile("v_mbcnt_lo_u32_b32 %0, -1, 0\n\tv_mbcnt_hi_u32_b32 %0, -1, %0" : "=v"(l)); return l; }
typedef int rsrc4_t __attribute__((ext_vector_type(4)));
__device__ __forceinline__ rsrc4_t make_rsrc4(const void* base) { const unsigned long long b = (unsigned long long)base; rsrc4_t r; r.x = (int)(unsigned)b; r.y = (int)((unsigned)(b >> 32) & 0xffffu); r.z = 0x7ffffff0; r.w = 0x00020000; return r; }
__device__ __forceinline__ void bufdma16_asm(rsrc4_t rs, unsigned voff, unsigned soff, unsigned lds_dst) { unsigned keep;
    asm volatile("s_nop 4\n\ts_mov_b32 %0, m0\n\ts_mov_b32 m0, %4\n\ts_nop 0\n\tbuffer_load_dwordx4 %1, %2, %3 offen lds\n\ts_mov_b32 m0, %0" : "=&s"(keep) : "v"(voff), "s"(rs), "s"(soff), "s"(lds_dst) : "memory"); }
struct Unit { int pm, pn; };
struct Gemm { const bf16_t* A; const bf16_t* Bt; int M, N, K; const void* base; };

struct StaticOrder {
    static constexpr bool GATHER = false;
    int nM, nN, nwg, G, c;
    __host__ __device__ void init(int M, int N, int G_, int c_) { nM = M / BM; nN = N / BM; nwg = nM * nN; G = G_; c = c_; }
    __host__ __device__ bool next(int i, Unit& u) const {
        const long L = (long)i * G + c; if (L >= nwg) return false;
        int wgid = (int)L; { const int q = nwg / NXCD, r = nwg % NXCD, xcd = wgid % NXCD, off = wgid / NXCD; wgid = (xcd < r ? xcd * (q + 1) : r * (q + 1) + (xcd - r) * q) + off; }
        const int nig = WGM * nN, gid = wgid / nig, fm = gid * WGM, gsz = (nM - fm) < WGM ? (nM - fm) : WGM;
        u.pm = fm + ((wgid % nig) % gsz); u.pn = (wgid % nig) / gsz; return true;
    }
    __device__ __forceinline__ void a_ready(const Unit&) const {}
    __device__ __forceinline__ void done(const Unit&) const {}
};

__device__ __forceinline__ unsigned cvt_pk_bf16(float lo, float hi) { unsigned r; asm volatile("v_cvt_pk_bf16_f32 %0, %1, %2" : "=v"(r) : "v"(lo), "v"(hi)); return r; }
typedef float f32x2 __attribute__((ext_vector_type(2)));
__device__ __forceinline__ f32x2 gelu_pk(f32x2 v) {
    const f32x2 av = __builtin_elementwise_abs(v), d = av * 0.2316418882f + 1.0f;
    f32x2 t; t.x = __builtin_amdgcn_rcpf(d.x); t.y = __builtin_amdgcn_rcpf(d.y);
    f32x2 q = t * 0.5307027145f + (-0.7265760135f); q = q * t + 0.7107068705f; q = q * t + (-0.142248368f); q = q * t + 0.127414796f; q = q * t;
    const f32x2 s = (v * v) * (-0.72134752044f);
    f32x2 e; e.x = __builtin_amdgcn_exp2f(s.x); e.y = __builtin_amdgcn_exp2f(s.y);
    const f32x2 m = v * (q * e), r = v - m;
    f32x2 o; o.x = v.x < 0.f ? m.x : r.x; o.y = v.y < 0.f ? m.y : r.y; return o;
}

template <int ACT  > struct EpiBf16 {
    static constexpr bool PERM = true, AFTER_DRAIN = false, F8 = false; static_assert(ACT == 0 || ACT == 1, "EpiBf16: ACT is 0 (none) or 1 (gelu_pk)");
    bf16_t* O; int ldc; const float* bias; int split_cols; size_t split_stride; float scale0;
    __device__ __forceinline__ void operator()(const f32x4 (&acc)[2][2][4][2], const Unit& u, int wr, int wc, int fr, int fq) const {
        const int row0 = u.pm * BM + wr * 64 + fr; int colt = u.pn * BM; bf16_t* base = O;
        float sc = 1.f; if (split_cols) { const int t = colt / split_cols; base += (size_t)t * split_stride; colt -= t * split_cols; if (t == 0) sc = scale0; }
        const int col0 = colt + wc * 32 + 8 * fq, bcol0 = u.pn * BM + wc * 32 + 8 * fq;
        f32x4 bv[2][2];
#pragma unroll
        for (int bj = 0; bj < 2; ++bj)
#pragma unroll
            for (int n = 0; n < 2; ++n) bv[bj][n] = bias ? *(const f32x4*)(bias + bcol0 + bj * HALF + 4 * n) : (f32x4){0.f, 0.f, 0.f, 0.f};
#pragma unroll
        for (int ai = 0; ai < 2; ++ai)
#pragma unroll
            for (int m = 0; m < 4; ++m) { bf16_t* rowp = base + (size_t)(row0 + ai * HALF + m * 16) * ldc + col0;
#pragma unroll
                for (int bj = 0; bj < 2; ++bj) { f32x4 v0 = acc[ai][bj][m][0] + bv[bj][0], v1 = acc[ai][bj][m][1] + bv[bj][1];
                    if (ACT == 1) { f32x2 a = gelu_pk((f32x2){v0[0], v0[1]}), b = gelu_pk((f32x2){v0[2], v0[3]}), c = gelu_pk((f32x2){v1[0], v1[1]}), d = gelu_pk((f32x2){v1[2], v1[3]});
                        v0 = (f32x4){a.x, a.y, b.x, b.y}; v1 = (f32x4){c.x, c.y, d.x, d.y}; }
                    v0 = v0 * sc; v1 = v1 * sc; u32x4 w; w.x = cvt_pk_bf16(v0[0], v0[1]); w.y = cvt_pk_bf16(v0[2], v0[3]); w.z = cvt_pk_bf16(v1[0], v1[1]); w.w = cvt_pk_bf16(v1[2], v1[3]);
                    *(u32x4*)(rowp + bj * HALF) = w; } }
    }
};

__device__ __forceinline__ float silu_f(float g) { return g * __builtin_amdgcn_rcpf(1.0f + __builtin_amdgcn_exp2f(-1.4426950408889634f * g)); }
struct EpiResF32 {
    static constexpr bool PERM = true, AFTER_DRAIN = false, F8 = false;
    const float* x; bf16_t* y; const float* gate; int ldc; int rows_per_batch; int gate_stride; float alpha;
    __device__ __forceinline__ void operator()(const f32x4 (&acc)[2][2][4][2], const Unit& u, int wr, int wc, int fr, int fq) const {
        const int row0 = u.pm * BM + wr * 64 + fr, col0 = u.pn * BM + wc * 32 + 8 * fq;
        const float* gp = gate + (size_t)((u.pm * BM) / rows_per_batch) * gate_stride + col0;
        f32x4 gv[2][2];
#pragma unroll
        for (int bj = 0; bj < 2; ++bj)
#pragma unroll
            for (int n = 0; n < 2; ++n) gv[bj][n] = *(const f32x4*)(gp + bj * HALF + n * 4) + 1.0f;
#pragma unroll
        for (int ai = 0; ai < 2; ++ai)
#pragma unroll
            for (int m = 0; m < 4; ++m) { const size_t off = (size_t)(row0 + ai * HALF + m * 16) * ldc + col0;
#pragma unroll
                for (int bj = 0; bj < 2; ++bj) { const f32x4 x0 = *(const f32x4*)(x + off + bj * HALF), x1v = *(const f32x4*)(x + off + bj * HALF + 4);
                    const f32x4 v0 = x0 * alpha + gv[bj][0] * acc[ai][bj][m][0], v1 = x1v * alpha + gv[bj][1] * acc[ai][bj][m][1];
                    u32x4 w; w.x = cvt_pk_bf16(v0[0], v0[1]); w.y = cvt_pk_bf16(v0[2], v0[3]); w.z = cvt_pk_bf16(v1[0], v1[1]); w.w = cvt_pk_bf16(v1[2], v1[3]);
                    *(u32x4*)(y + off + bj * HALF) = w; } }
    }
};
struct EpiSwiGLU {
    static constexpr bool PERM = true, AFTER_DRAIN = false, F8 = (MOE_F8 != 0);
    bf16_t* H; const PG8_LAS float* wl; int ldh; int npn;
    __device__ __forceinline__ void operator()(const f32x4 (&acc)[2][2][4][2], const Unit& u, int wr, int wc, int fr, int fq) const {
        const int row0 = u.pm * BM + wr * 64 + fr, col0 = (u.pn % npn) * HALF + wc * 32 + 8 * fq;
        constexpr float inv = F8 ? 1.0f / (F8_SX * F8_SWG) : 1.0f;
#pragma unroll
        for (int ai = 0; ai < 2; ++ai)
#pragma unroll
            for (int m = 0; m < 4; ++m) { const int r = row0 + ai * HALF + m * 16; const float w8 = wl[(wr * 4 + wc) * 256 + wr * 64 + fr + ai * HALF + m * 16] * inv * (F8 ? F8_SH : 1.0f);
                const f32x4 g0 = acc[ai][0][m][0] * inv, g1 = acc[ai][0][m][1] * inv, u0 = acc[ai][1][m][0] * w8, u1 = acc[ai][1][m][1] * w8;
                float h[8];
#pragma unroll
                for (int q = 0; q < 4; ++q) { h[q] = silu_f(g0[q]) * u0[q]; h[4 + q] = silu_f(g1[q]) * u1[q]; }
                if (F8) {
                    typedef unsigned u32x2 __attribute__((ext_vector_type(2)));
                    if (F8_SH > 8.0f) {
#pragma unroll
                        for (int q = 0; q < 8; ++q) h[q] = __builtin_fminf(__builtin_fmaxf(h[q], -440.0f), 440.0f); }
                    int a = __builtin_amdgcn_cvt_pk_fp8_f32(h[0], h[1], 0, false); a = __builtin_amdgcn_cvt_pk_fp8_f32(h[2], h[3], a, true);
                    int b = __builtin_amdgcn_cvt_pk_fp8_f32(h[4], h[5], 0, false); b = __builtin_amdgcn_cvt_pk_fp8_f32(h[6], h[7], b, true);
                    u32x2 w; w.x = (unsigned)a; w.y = (unsigned)b; *(u32x2*)((unsigned char*)H + (size_t)r * ldh + col0) = w;
                } else {
                    u32x4 w; w.x = cvt_pk_bf16(h[0], h[1]); w.y = cvt_pk_bf16(h[2], h[3]); w.z = cvt_pk_bf16(h[4], h[5]); w.w = cvt_pk_bf16(h[6], h[7]);
                    *(u32x4*)(H + (size_t)r * ldh + col0) = w; } }
    }
};
struct EpiDown {
    static constexpr int PERM = Y_BF8 ? 2 : 1; static constexpr bool AFTER_DRAIN = false, F8 = (MOE_F8 != 0);
    bf16_t* Y; int ldc; int npn; int nostore;
    __device__ __forceinline__ void operator()(const f32x4 (&acc)[2][2][4][2], const Unit& u, int wr, int wc, int fr, int fq) const {
        const int row0 = u.pm * BM + wr * 64 + fr;
        if (Y_BF8) {
            const int col0 = (u.pn % npn) * BM + wc * 64 + 16 * fq;
#pragma unroll
            for (int ai = 0; ai < 2; ++ai)
#pragma unroll
                for (int m = 0; m < 4; ++m) { const int r = row0 + ai * HALF + m * 16; u32x4 w;
#pragma unroll
                    for (int bj = 0; bj < 2; ++bj)
#pragma unroll
                        for (int n = 0; n < 2; ++n) { const f32x4 v = acc[ai][bj][m][n] * (F8 ? 1.0f / (F8_SH * F8_SWD) : 1.0f); int a;
                            if (Y_BF8 == 2) { constexpr float ys = F8 ? 64.0f / (F8_SH * F8_SWD) : 64.0f; f32x4 sv = acc[ai][bj][m][n]; if (ys != 1.0f) sv = sv * ys;
#pragma unroll
                                for (int q = 0; q < 4; ++q) sv[q] = __builtin_amdgcn_fmed3f(sv[q], -440.0f, 440.0f);
                                a = __builtin_amdgcn_cvt_pk_fp8_f32(sv[0], sv[1], 0, false); a = __builtin_amdgcn_cvt_pk_fp8_f32(sv[2], sv[3], a, true);
                            } else { a = __builtin_amdgcn_cvt_pk_bf8_f32(v[0], v[1], 0, false); a = __builtin_amdgcn_cvt_pk_bf8_f32(v[2], v[3], a, true); }
                            w[2 * bj + n] = (unsigned)a; }
                    if (!nostore || w.x == 0x12345678u) *(u32x4*)((unsigned char*)Y + (size_t)r * ldc + col0) = w; }
        } else {
            const int col0 = (u.pn % npn) * BM + wc * 32 + 8 * fq;
#pragma unroll
            for (int ai = 0; ai < 2; ++ai)
#pragma unroll
                for (int m = 0; m < 4; ++m) { const int r = row0 + ai * HALF + m * 16;
#pragma unroll
                    for (int bj = 0; bj < 2; ++bj) { const f32x4 v0 = acc[ai][bj][m][0] * (F8 ? 1.0f / (F8_SH * F8_SWD) : 1.0f), v1 = acc[ai][bj][m][1] * (F8 ? 1.0f / (F8_SH * F8_SWD) : 1.0f);
                        u32x4 w; w.x = cvt_pk_bf16(v0[0], v0[1]); w.y = cvt_pk_bf16(v0[2], v0[3]); w.z = cvt_pk_bf16(v1[0], v1[1]); w.w = cvt_pk_bf16(v1[2], v1[3]);
                        if (!nostore || w.x == 0x12345678u) *(u32x4*)(Y + (size_t)r * ldc + col0 + bj * HALF) = w; } }
        }
    }
};
template <bool GATHER_> struct GroupedOrder {
    static constexpr bool GATHER = GATHER_;
    const PG8_LAS unsigned short* tslot; int ntiles, npn, G, c; const unsigned* vtab; int pin = 0; const float* wrow_g = nullptr;
    __device__ __forceinline__ bool next(int i, Unit& u) const {
        const int L = i * G + c; if (L >= ntiles * npn) return false;
        const int t = L / npn, p = L - t * npn; u.pm = t; u.pn = (int)tslot[t] * npn + p; if (pin) { u.pm = c & 3; u.pn = c & 7; } return true;
    }
    __device__ __forceinline__ void a_ready(const Unit&) const {}
    __device__ __forceinline__ void done(const Unit&) const {}
};


template <class Epi, class Sched, bool ALIGN_EPI = false, bool SP2 = false>
__device__ __forceinline__ void gemm_phase(PG8_LAS unsigned char* lds, const Gemm g, const Sched& S, const Epi& E, const int wid) {
    const int lane = lane_id_v(), tid = wid * 64 + lane, wr = wid >> 2, wc = wid & 3, fr = lane & 15, fq = lane >> 4;
    const int K = g.K, nt = K / BK;
    unsigned voffA[2], voffA1[2], voffB[2];
#pragma unroll
    for (int i = 0; i < 2; ++i) { int R, C; stage_rc(tid * 16 + i * 8192, R, C); const int rho = R & 31;
        const int Rb = ((int)Epi::PERM == 2) ? (64 * (R >> 5) + 16 * ((rho & 15) >> 2) + 4 * (rho >> 4) + (rho & 3)) : (Epi::PERM ? ((R & ~31) + perm32(rho)) : R);
        voffA[i] = (unsigned)(R * K + C) * 2u; voffA1[i] = voffA[i] + (unsigned)(HALF * K * 2); voffB[i] = (unsigned)(Rb * K + C) * 2u; }
    const size_t kstep = (size_t)(BK * 2);
    const size_t hstep = (size_t)HALF * K * 2;
    const size_t tstep = 2 * hstep;
    const size_t bh1 = ((int)Epi::PERM == 2) ? (size_t)8 * K * 2 : hstep;
    const unsigned ldsw = (unsigned)wid * 1024u;
    const int aoff = lds_byte(wr * 64 + fr, fq * 8), boff = lds_byte(wc * 32 + fr, fq * 8);
#define PG8_SA(b, h) (((b) * 2 + (h)) * HTB)
#define PG8_SB(b, h) ((4 + (b) * 2 + (h)) * HTB)
    const __amdgpu_buffer_rsrc_t rs_ = __builtin_amdgcn_make_buffer_rsrc((void*)g.base, (short)0, 0x7ffffff0, 0x00020000);
#define PG8_STAGE(bufoff, gbase, voff) do { _Pragma("unroll") for (int _i = 0; _i < 2; ++_i) \
        __builtin_amdgcn_raw_ptr_buffer_load_lds(rs_, (PG8_LAS unsigned*)(lds + (bufoff) + ldsw + _i * 8192), 16, (int)(voff)[_i], (int)((const char*)(gbase) - (const char*)g.base), 0, 0); } while (0)
#define PG8_STAGE_A1(bufoff, gbase) do { if constexpr (Sched::GATHER) PG8_STAGE(bufoff, gbase, voffA1); else PG8_STAGE(bufoff, (gbase) + hstep, voffA); } while (0)
#define PG8_LDA(dst, b, h) do { if constexpr (Epi::F8) { _Pragma("unroll") for (int m = 0; m < 4; ++m) { const i32x4_ l0_ = *(const PG8_LAS i32x4_*)(lds + PG8_SA(b, h) + aoff + m * 2048), l1_ = *(const PG8_LAS i32x4_*)(lds + PG8_SA(b, h) + aoff + m * 2048 + 1024); dst##8[m] = __builtin_shufflevector(l0_, l1_, 0, 1, 2, 3, 4, 5, 6, 7); } } \
        else { _Pragma("unroll") for (int m = 0; m < 4; ++m) _Pragma("unroll") for (int k = 0; k < 2; ++k) dst[m][k] = *(const PG8_LAS bf16x8*)(lds + PG8_SA(b, h) + aoff + m * 2048 + k * 1024); } } while (0)
#define PG8_LDB(dst, b, h) do { if constexpr (Epi::F8) { _Pragma("unroll") for (int n = 0; n < 2; ++n) { const i32x4_ l0_ = *(const PG8_LAS i32x4_*)(lds + PG8_SB(b, h) + boff + n * 2048), l1_ = *(const PG8_LAS i32x4_*)(lds + PG8_SB(b, h) + boff + n * 2048 + 1024); dst##8[n] = __builtin_shufflevector(l0_, l1_, 0, 1, 2, 3, 4, 5, 6, 7); } } \
        else { _Pragma("unroll") for (int n = 0; n < 2; ++n) _Pragma("unroll") for (int k = 0; k < 2; ++k) dst[n][k] = *(const PG8_LAS bf16x8*)(lds + PG8_SB(b, h) + boff + n * 2048 + k * 1024); } } while (0)
#define PG8_MMA(ai, bj, At, Bt) do { __builtin_amdgcn_s_setprio(1); \
        if constexpr (Epi::F8) { _Pragma("unroll") for (int m = 0; m < 4; ++m) _Pragma("unroll") for (int n = 0; n < 2; ++n) \
                acc[ai][bj][m][n] = __builtin_amdgcn_mfma_scale_f32_16x16x128_f8f6f4(Bt##8[n], At##8[m], acc[ai][bj][m][n], 0, 0, 0, 0, 0, 0); \
        } else { _Pragma("unroll") for (int m = 0; m < 4; ++m) _Pragma("unroll") for (int n = 0; n < 2; ++n) _Pragma("unroll") for (int k = 0; k < 2; ++k) \
        acc[ai][bj][m][n] = __builtin_amdgcn_mfma_f32_16x16x32_bf16(Bt[n][k], At[m][k], acc[ai][bj][m][n], 0, 0, 0); } __builtin_amdgcn_s_setprio(0); } while (0)
#define PG8_MMA_Z(ai, bj, At, Bt) do { __builtin_amdgcn_s_setprio(1); const f32x4 z_ = {0.f, 0.f, 0.f, 0.f}; \
        if constexpr (Epi::F8) { _Pragma("unroll") for (int m = 0; m < 4; ++m) _Pragma("unroll") for (int n = 0; n < 2; ++n) \
                acc[ai][bj][m][n] = __builtin_amdgcn_mfma_scale_f32_16x16x128_f8f6f4(Bt##8[n], At##8[m], z_, 0, 0, 0, 0, 0, 0); \
        } else { _Pragma("unroll") for (int m = 0; m < 4; ++m) _Pragma("unroll") for (int n = 0; n < 2; ++n) { \
        acc[ai][bj][m][n] = __builtin_amdgcn_mfma_f32_16x16x32_bf16(Bt[n][0], At[m][0], z_, 0, 0, 0); acc[ai][bj][m][n] = __builtin_amdgcn_mfma_f32_16x16x32_bf16(Bt[n][1], At[m][1], acc[ai][bj][m][n], 0, 0, 0); } } __builtin_amdgcn_s_setprio(0); } while (0)
#define PG8_WAIT_V(n) asm volatile("s_waitcnt vmcnt(" #n ")" ::: "memory")
#define PG8_WAIT_L(n) asm volatile("s_waitcnt lgkmcnt(" #n ")" ::: "memory")
#define PG8_BAR __builtin_amdgcn_s_barrier()
#define PG8_SCHED __builtin_amdgcn_sched_barrier(0)
    Unit cur, nxt; int ui = 0;
    if (!S.next(0, cur)) return;
    f32x4 acc[2][2][4][2];
#pragma unroll
    for (int a = 0; a < 2; ++a)
#pragma unroll
        for (int b = 0; b < 2; ++b)
#pragma unroll
            for (int m = 0; m < 4; ++m)
#pragma unroll
                for (int n = 0; n < 2; ++n) { acc[a][b][m][n] = (f32x4){0.f, 0.f, 0.f, 0.f}; if constexpr (Epi::F8 && !SP2) asm volatile("" : "+v"(acc[a][b][m][n])); }
    typedef int i32x4_ __attribute__((ext_vector_type(4))); typedef int i32x8_ __attribute__((ext_vector_type(8)));
    bf16x8 At[4][2], B0[2][2], B1[2][2]; i32x8_ At8[4], B08[2], B18[2];
    const char* cA = Sched::GATHER ? (const char*)g.A : (const char*)g.A + (size_t)cur.pm * tstep; const char* cB = (const char*)g.Bt + (size_t)cur.pn * tstep;
    S.a_ready(cur);
    if constexpr (Sched::GATHER) {
        static_assert(SP2, "gather: SP2 loop only");
        __builtin_amdgcn_global_load_lds((const unsigned*)(S.vtab + ((size_t)0 * 512 + tid) * 4), (PG8_LAS unsigned*)(lds + VT_SLOT + wid * 1024), 16, 0, 0);
        PG8_WAIT_V(0);
        const u32x4 e4 = *(const PG8_LAS u32x4*)(lds + VT_SLOT + tid * 16); voffA[0] = e4.x; voffA[1] = e4.y; voffA1[0] = e4.z; voffA1[1] = e4.w;
    }
    if constexpr (SP2) {
        PG8_STAGE(PG8_SB(0, 0), cB, voffB); PG8_STAGE(PG8_SB(0, 1), cB + bh1, voffB); PG8_STAGE(PG8_SA(0, 0), cA, voffA); PG8_STAGE_A1(PG8_SA(0, 1), cA);
        if (wr == 1) PG8_BAR;
        PG8_WAIT_V(2); PG8_BAR;
        PG8_STAGE(PG8_SB(1, 0), cB + kstep, voffB); PG8_STAGE(PG8_SA(1, 0), cA + kstep, voffA); PG8_STAGE(PG8_SB(1, 1), cB + bh1 + kstep, voffB);
        PG8_WAIT_V(6); PG8_BAR;
    } else {
        PG8_STAGE(PG8_SB(0, 0), cB, voffB); PG8_STAGE(PG8_SA(0, 0), cA, voffA); PG8_STAGE(PG8_SB(0, 1), cB + hstep, voffB); PG8_STAGE(PG8_SA(0, 1), cA + hstep, voffA);
        if (wr == 1) PG8_BAR;
        PG8_WAIT_V(4); PG8_BAR;
        PG8_STAGE(PG8_SB(1, 0), cB + kstep, voffB); PG8_STAGE(PG8_SA(1, 0), cA + kstep, voffA); PG8_STAGE(PG8_SB(1, 1), cB + hstep + kstep, voffB);
        PG8_WAIT_V(6); PG8_BAR;
    }
    for (;;) {
        const bool has_next = S.next(ui + 1, nxt);
        const char* nA = (has_next && !Sched::GATHER) ? (const char*)g.A + (size_t)nxt.pm * tstep : cA; const char* nB = has_next ? (const char*)g.Bt + (size_t)nxt.pn * tstep : cB;
        for (int t = 0; t < nt; t += 2) {
            const bool last = (t == nt - 2);
            const char* a1 = cA + (size_t)(t + 1) * kstep;
            const char* a2 = last ? nA : cA + (size_t)(t + 2) * kstep; const char* b2 = last ? nB : cB + (size_t)(t + 2) * kstep;
            const char* a3 = a2 + kstep; const char* b3 = b2 + kstep;
            if (last && has_next) S.a_ready(nxt);
            if constexpr (SP2) {
            if constexpr (Sched::GATHER) { if (t == 0)
                bufdma16_asm(make_rsrc4(g.base), (unsigned)lane_id_v() * 16u, (unsigned)__builtin_amdgcn_readfirstlane((int)((const char*)(S.wrow_g + (size_t)cur.pm * 256) - (const char*)g.base)), (unsigned)__builtin_amdgcn_readfirstlane((int)(size_t)(lds + WR_SLOT + wid * 1024))); }
            if constexpr (Sched::GATHER) { if (t == 0 && has_next)
                __builtin_amdgcn_global_load_lds((const unsigned*)(S.vtab + ((size_t)(ui + 1) * 512 + tid) * 4), (PG8_LAS unsigned*)(lds + VT_SLOT + wid * 1024), 16, 0, 0); }
            PG8_LDB(B0, 0, 0); PG8_LDB(B1, 0, 1); PG8_SCHED; PG8_LDA(At, 0, 0); PG8_STAGE_A1(PG8_SA(1, 1), a1);
            PG8_WAIT_V(8); PG8_WAIT_L(0); PG8_BAR; if (t == 0) { PG8_MMA_Z(0, 0, At, B0); PG8_MMA_Z(0, 1, At, B1); } else { PG8_MMA(0, 0, At, B0); PG8_MMA(0, 1, At, B1); } PG8_BAR; PG8_SCHED;
            if constexpr (Sched::GATHER) { if (last && has_next) {
                const u32x4 e4 = *(const PG8_LAS u32x4*)(lds + VT_SLOT + tid * 16); voffA[0] = e4.x; voffA[1] = e4.y; voffA1[0] = e4.z; voffA1[1] = e4.w; } }
            PG8_LDA(At, 0, 1); PG8_STAGE(PG8_SB(0, 0), b2, voffB); PG8_STAGE(PG8_SB(0, 1), b2 + bh1, voffB); PG8_STAGE(PG8_SA(0, 0), a2, voffA);
            PG8_WAIT_V(8); PG8_WAIT_L(0); PG8_BAR; if (t == 0) { PG8_MMA_Z(1, 0, At, B0); PG8_MMA_Z(1, 1, At, B1); } else { PG8_MMA(1, 0, At, B0); PG8_MMA(1, 1, At, B1); } PG8_BAR; PG8_SCHED;
            PG8_LDB(B0, 1, 0); PG8_LDB(B1, 1, 1); PG8_SCHED; PG8_LDA(At, 1, 0); PG8_STAGE_A1(PG8_SA(0, 1), a2);
            PG8_WAIT_V(8); PG8_WAIT_L(0); PG8_BAR; PG8_MMA(0, 0, At, B0); PG8_MMA(0, 1, At, B1); PG8_BAR; PG8_SCHED;
            PG8_LDA(At, 1, 1); PG8_STAGE(PG8_SB(1, 0), b3, voffB); PG8_STAGE(PG8_SB(1, 1), b3 + bh1, voffB); PG8_STAGE(PG8_SA(1, 0), a3, voffA);
            PG8_WAIT_V(8); PG8_WAIT_L(0); PG8_BAR; PG8_MMA(1, 0, At, B0); PG8_MMA(1, 1, At, B1); PG8_BAR; PG8_SCHED;
            } else {
            PG8_LDB(B0, 0, 0); PG8_SCHED; PG8_LDA(At, 0, 0); PG8_STAGE(PG8_SA(1, 1), a1 + hstep, voffA);
            PG8_WAIT_L(8); PG8_BAR; PG8_WAIT_L(0); PG8_MMA(0, 0, At, B0); PG8_BAR; PG8_SCHED;
            PG8_LDB(B1, 0, 1); PG8_STAGE(PG8_SB(0, 0), b2, voffB);
            PG8_BAR; PG8_WAIT_L(0); PG8_MMA(0, 1, At, B1); PG8_BAR;
            PG8_LDA(At, 0, 1); PG8_STAGE(PG8_SA(0, 0), a2, voffA);
            PG8_BAR; PG8_WAIT_L(0); PG8_MMA(1, 0, At, B0); PG8_BAR; PG8_SCHED;
            PG8_STAGE(PG8_SB(0, 1), b2 + hstep, voffB);
            PG8_WAIT_V(6); PG8_BAR; PG8_MMA(1, 1, At, B1); PG8_BAR;
            PG8_LDB(B0, 1, 0); PG8_SCHED; PG8_LDA(At, 1, 0); PG8_STAGE(PG8_SA(0, 1), a2 + hstep, voffA);
            PG8_WAIT_L(8); PG8_BAR; PG8_WAIT_L(0); PG8_MMA(0, 0, At, B0); PG8_BAR; PG8_SCHED;
            PG8_LDB(B1, 1, 1); PG8_STAGE(PG8_SB(1, 0), b3, voffB);
            PG8_BAR; PG8_WAIT_L(0); PG8_MMA(0, 1, At, B1); PG8_BAR;
            PG8_LDA(At, 1, 1); PG8_STAGE(PG8_SA(1, 0), a3, voffA);
            PG8_BAR; PG8_WAIT_L(0); PG8_MMA(1, 0, At, B0); PG8_BAR; PG8_SCHED;
            PG8_STAGE(PG8_SB(1, 1), b3 + hstep, voffB);
            PG8_WAIT_V(6); PG8_BAR; PG8_MMA(1, 1, At, B1); PG8_BAR;
            }
        }
        if constexpr (ALIGN_EPI) { if (wr == 0) PG8_BAR; }
        if constexpr (!Epi::AFTER_DRAIN) { const int le_ = lane_id_v(); E(acc, cur, wr, wc, le_ & 15, le_ >> 4); S.done(cur); }
        if (!has_next) break;
        if constexpr (!SP2) {
#pragma unroll
        for (int a = 0; a < 2; ++a)
#pragma unroll
            for (int b = 0; b < 2; ++b)
#pragma unroll
                for (int m = 0; m < 4; ++m)
#pragma unroll
                    for (int n = 0; n < 2; ++n) acc[a][b][m][n] = (f32x4){0.f, 0.f, 0.f, 0.f}; }
        cur = nxt; cA = nA; cB = nB; ++ui;
        if constexpr (ALIGN_EPI) { if (wr == 1) PG8_BAR; }
    }
    PG8_WAIT_V(0);
    if constexpr (!ALIGN_EPI) { if (wr == 0) PG8_BAR; }
    PG8_BAR;
    if constexpr (Epi::AFTER_DRAIN) { E.fused(acc, cur, wr, wc, fr, fq, lds, wid, lane); S.done(cur); }
#undef PG8_SA
#undef PG8_SB
#undef PG8_STAGE
#undef PG8_LDA
#undef PG8_LDB
#undef PG8_MMA
#undef PG8_WAIT_V
#undef PG8_WAIT_L
#undef PG8_BAR
#undef PG8_SCHED
}
}

#ifndef PG8_SP2
#define PG8_SP2 true
#endif
#ifndef PG8_ALIGN
#define PG8_ALIGN true
#endif
#ifndef DOWN_STAGGER
#define DOWN_STAGGER 0
#endif
#ifndef CONV_NT
#define CONV_NT 1
#endif
#ifndef P5_MAIN_Q
#define P5_MAIN_Q 16
#endif
#ifndef P6_MIN_CONV
#define P6_MIN_CONV 0
#endif
#ifndef PROBE_STAMP
#define PROBE_STAMP -1
#endif
#ifndef PROBE_PIN
#define PROBE_PIN 0
#endif
#ifndef PROBE_NOSTORE
#define PROBE_NOSTORE 0
#endif
#ifndef REP_PHASE
#define REP_PHASE -1
#endif
#ifndef MK_PER_PHASE
#define MK_PER_PHASE 0
#endif

constexpr int NB = 2, SEQ = 4096, D = 2048, M = NB * SEQ;
constexpr int AW = 1024, NQH = 16, NKVH = 4, HD = 64, KVW = 256, CW = 1024, INW = 4608;
constexpr int COL_K = 1024, COL_V = 1280, COL_CB = 1536, COL_CC = 2560, COL_CH = 3584;
constexpr int NE = 64, TOPK = 8, DE = 512, NSLOT = NE + 1;
constexpr int MAXT = 32 + 256 + 64, MAXR = MAXT * 256;
constexpr float ALPHA = 1.189207115002721f;
constexpr float LN_EPS = 1e-5f, RSCALE = 2.5f;
constexpr int NWAVES = 8, NTHR = 512;
constexpr int KSL = 8;

constexpr size_t MiB = 1u << 20;
constexpr size_t WS_CTL = 0, CTL_ZERO_BYTES = 1 * MiB;
constexpr size_t WS_PART = 1 * MiB;
constexpr size_t WS_MODF = 2 * MiB;
constexpr size_t WS_WRT = 3 * MiB;
constexpr size_t WS_ROWTOK = 4 * MiB;
constexpr size_t WS_ROWW = 6 * MiB;
constexpr size_t WS_TOKSLOT = 8 * MiB;
constexpr size_t WS_WROW = 9 * MiB;
constexpr size_t WS_WINT = 10 * MiB;
constexpr size_t WS_WOUTT = 28 * MiB;
constexpr size_t WS_WGUT = 36 * MiB;
constexpr size_t WS_WDT = 296 * MiB;
constexpr size_t WS_X1 = 426 * MiB;
constexpr size_t WS_H = 490 * MiB;
constexpr size_t WS_XG = 578 * MiB;
constexpr size_t WS_HB = 610 * MiB;
constexpr size_t WS_PROJ = 642 * MiB;
constexpr size_t WS_MIX = 714 * MiB;
constexpr size_t WS_Y1 = 746 * MiB;
constexpr size_t WS_VTAB = 930 * MiB;
constexpr size_t WS_END = 946 * MiB;
static_assert(WS_XG + (size_t)MAXR * D * 2 <= WS_VTAB && WS_H + (size_t)MAXR * DE * 2 <= WS_XG && WS_Y1 + (size_t)M * D * 4 <= WS_VTAB, "ws map");
static_assert(WS_WGUT + (size_t)NSLOT * 1024 * D * 2 <= WS_WDT && WS_WDT + (size_t)NSLOT * D * DE * 2 <= WS_X1 && WS_X1 + (size_t)M * D * 4 <= WS_H, "ws map 2");
constexpr int CW_TMO = 0;
constexpr int CW_BAR = 4096;
constexpr int CW_Q = 8192;
constexpr int CW_FIN = 8448;
constexpr int CW_CNT = 16384;

constexpr int RING_OFF = 0, RING_BYTES = 131072;
constexpr int LDSCTL_OFF = RING_BYTES, MISC_OFF = LDSCTL_OFF + 320;
constexpr int TS_OFF = LDSCTL_OFF + 512;
constexpr int POFF_OFF = LDSCTL_OFF + 1280;
constexpr int LDS_BYTES = 155648;

#define GAS __attribute__((address_space(1)))
#define LAS __attribute__((address_space(3)))
typedef unsigned short bf16;
typedef unsigned v4u __attribute__((ext_vector_type(4)));
typedef unsigned v2u __attribute__((ext_vector_type(2)));
typedef float f32x4 __attribute__((ext_vector_type(4)));
typedef short bf16x8 __attribute__((ext_vector_type(8)));
typedef GAS unsigned gu32;
#define RLX_AGENT __ATOMIC_RELAXED, __HIP_MEMORY_SCOPE_AGENT
#define LDS_WAIT() asm volatile("s_waitcnt lgkmcnt(0)" ::: "memory")
#define VM_WAIT() asm volatile("s_waitcnt vmcnt(0)" ::: "memory")
__device__ __forceinline__ unsigned f2bf(float f) { unsigned u = __builtin_bit_cast(unsigned, f); return (u + 0x7fffu + ((u >> 16) & 1u)) >> 16; }
__device__ __forceinline__ unsigned pk2(float lo, float hi) { return f2bf(lo) | (f2bf(hi) << 16); }
__device__ __forceinline__ float bf2f(unsigned h) { return __builtin_bit_cast(float, h << 16); }
__device__ __forceinline__ float bflo(unsigned w) { return __builtin_bit_cast(float, w << 16); }
__device__ __forceinline__ float bfhi(unsigned w) { return __builtin_bit_cast(float, w & 0xffff0000u); }

#define XB_TMO      128
#define XB_XCNT(j)  (256  + 64 * (j))
#define XB_XSUB(j)  (1280 + 64 * (j))
#define XB_XGEN(j)  (2304 + 64 * (j))
#define XB_TOP      3328
#define XB_TOPGEN   3392
#define XCD_BAR_WORDS 3456
#define XB_SPIN_CAP (1u << 18)
__device__ __forceinline__ unsigned xb_ld(unsigned* p)              { return __hip_atomic_load(p, __ATOMIC_RELAXED, __HIP_MEMORY_SCOPE_AGENT); }
__device__ __forceinline__ unsigned xb_add(unsigned* p, unsigned v) { return __hip_atomic_fetch_add(p, v, __ATOMIC_RELAXED, __HIP_MEMORY_SCOPE_AGENT); }
__device__ __forceinline__ unsigned xb_xcc_id() { return (unsigned)__builtin_amdgcn_s_getreg((3 << 11) | 20) & 0xFu; }
#define XB_SPIN(cond, bar) do { unsigned _sp = 0; while (cond) { __builtin_amdgcn_s_sleep(1); \
    if ((++_sp & 255u) == 0u) { if (xb_ld(&(bar)[XB_TMO])) break; if (_sp > XB_SPIN_CAP) { atomicAdd(&(bar)[XB_TMO], 1u); break; } } } } while (0)
struct XcdBarrier { unsigned* bar; unsigned x; volatile LAS unsigned* st; };
__device__ __forceinline__ XcdBarrier xcd_barrier_post(unsigned* bar, volatile LAS unsigned* st) {
    XcdBarrier b; b.bar = bar; b.x = xb_xcc_id(); b.st = st;
    if (threadIdx.x == 0) (void)xb_add(&bar[XB_XCNT(b.x)], 1u);
    return b;
}
__device__ __forceinline__ void xcd_barrier_complete(unsigned* bar, unsigned x, unsigned& nloc, unsigned& nx) {
    const unsigned G = gridDim.x * gridDim.y * gridDim.z;
    unsigned sum, cnt, mine, sp = 0u;
    for (;;) {
        sum = 0u; cnt = 0u; mine = 0u;
#pragma unroll
        for (unsigned j = 0; j < 16; ++j) { const unsigned c = xb_ld(&bar[XB_XCNT(j)]); sum += c; cnt += (c > 0u) ? 1u : 0u; mine = (j == x) ? c : mine; }
        if (sum == G) break;
        __builtin_amdgcn_s_sleep(1);
        if ((++sp & 255u) == 0u) { if (xb_ld(&bar[XB_TMO])) break; if (sp > XB_SPIN_CAP) { atomicAdd(&bar[XB_TMO], 1u); break; } }
    }
    nloc = mine > 0u ? mine : 1u; nx = cnt > 0u ? cnt : 1u;
}
__device__ __forceinline__ void xcd_barrier(const XcdBarrier& b) {
    asm volatile("s_waitcnt vmcnt(0)" ::: "memory");
    __syncthreads();
    if (threadIdx.x == 0) {
        unsigned* bar = b.bar;
        __builtin_amdgcn_s_waitcnt(0);
        unsigned nloc = b.st[0], nx = b.st[1];
        if (nloc == 0u) { xcd_barrier_complete(bar, b.x, nloc, nx); b.st[0] = nloc; b.st[1] = nx; }
        const unsigned old = xb_add(&bar[XB_XSUB(b.x)], 1u);
        const unsigned gen = old / nloc;
        if (old + 1u == (gen + 1u) * nloc) {
            __builtin_amdgcn_fence(__ATOMIC_RELEASE, "agent");
            asm volatile("s_waitcnt vmcnt(0)" ::: "memory");
            const unsigned og = xb_add(&bar[XB_TOP], 1u);
            const unsigned tg = og / nx;
            if (og + 1u == (tg + 1u) * nx) xb_add(&bar[XB_TOPGEN], 1u);
            else XB_SPIN(xb_ld(&bar[XB_TOPGEN]) == tg, bar);
            __builtin_amdgcn_fence(__ATOMIC_ACQUIRE, "agent");
            xb_add(&bar[XB_XGEN(b.x)], 1u);
            asm volatile("s_waitcnt vmcnt(0)" ::: "memory");
        } else {
            XB_SPIN(xb_ld(&bar[XB_XGEN(b.x)]) == gen, bar);
            __builtin_amdgcn_fence(__ATOMIC_ACQUIRE, "agent");
            asm volatile("s_waitcnt vmcnt(0)" ::: "memory");
        }
    }
    __syncthreads();
}

struct Frame {
    LAS unsigned char* lds;
    volatile LAS unsigned* MISC;
    gu32* ctl;
    int tid, lane, wave;
    int vcu, G;
    unsigned char* ws;
    const float *x, *c, *w_mod, *b_mod, *w_in, *conv_w, *sinks, *w_out, *ln1_g, *ln1_b, *w_router, *router_bias, *w_gate, *w_up, *w_down, *ws_gate, *ws_up, *ws_down, *ln2_g, *ln2_b;
    float* out;
};
__device__ __forceinline__ float wave_sum(float v) {
#pragma unroll
    for (int o = 1; o < 64; o <<= 1) v += __shfl_xor(v, o);
    return v;
}

__device__ __forceinline__ void p0_transpose_item(const float* src, int ldw, bf16* dst, int ldt, LAS float* scr, int lane) {
    { const float* sp = src + (size_t)(lane >> 5) * ldw + (lane & 31); LAS float* dp = scr + (lane >> 5) * 33 + (lane & 31);
#pragma unroll 1
      for (int h = 0; h < 2; ++h) { float tv[16];
#pragma unroll
        for (int i = 0; i < 16; ++i) tv[i] = sp[(size_t)(2 * i) * ldw];
#pragma unroll
        for (int i = 0; i < 16; ++i) dp[(2 * i) * 33] = tv[i];
        sp += (size_t)32 * ldw; dp += 32 * 33; } }
    LDS_WAIT(); asm volatile("" ::: "memory");
    const int c = lane & 7;
#pragma unroll
    for (int j = 0; j < 4; ++j) { const int n = (lane >> 3) + 8 * j; const LAS float* s = scr + (8 * c) * 33 + n;
        v4u o; o.x = pk2(s[0 * 33], s[1 * 33]); o.y = pk2(s[2 * 33], s[3 * 33]); o.z = pk2(s[4 * 33], s[5 * 33]); o.w = pk2(s[6 * 33], s[7 * 33]);
        *(GAS v4u*)(dst + (size_t)n * ldt + 8 * c) = o; }
    LDS_WAIT(); asm volatile("" ::: "memory");
}
constexpr int SCRP = 136;
__device__ __forceinline__ void conv64(const float* src, int ldw, bf16* dst, int ldt, LAS unsigned char* scr, int lane) {
    const int kr = lane >> 4, nq = lane & 15;
    const float* sp = src + (size_t)kr * ldw + 4 * nq;
    f32x4 tv[16];
#pragma unroll
    for (int i = 0; i < 16; ++i) tv[i] = CONV_NT ? __builtin_nontemporal_load((const GAS f32x4*)(sp + (size_t)(4 * i) * ldw)) : *(const GAS f32x4*)(sp + (size_t)(4 * i) * ldw);
#pragma unroll
    for (int i = 0; i < 16; ++i) { v2u w; w.x = pk2(tv[i].x, tv[i].y); w.y = pk2(tv[i].z, tv[i].w); *(LAS v2u*)(scr + (4 * i + kr) * SCRP + 8 * nq) = w; }
    LDS_WAIT(); asm volatile("" ::: "memory");
    const int c = lane & 7;
#pragma unroll
    for (int j = 0; j < 8; ++j) { const int n = (lane >> 3) + 8 * j; const LAS unsigned short* p = (const LAS unsigned short*)(scr + (8 * c) * SCRP + 2 * n);
        v4u o; o.x = (unsigned)p[0] | ((unsigned)p[SCRP / 2] << 16); o.y = (unsigned)p[2 * (SCRP / 2)] | ((unsigned)p[3 * (SCRP / 2)] << 16);
        o.z = (unsigned)p[4 * (SCRP / 2)] | ((unsigned)p[5 * (SCRP / 2)] << 16); o.w = (unsigned)p[6 * (SCRP / 2)] | ((unsigned)p[7 * (SCRP / 2)] << 16);
        if (CONV_NT) __builtin_nontemporal_store(o, (GAS v4u*)(dst + (size_t)n * ldt + 8 * c)); else *(GAS v4u*)(dst + (size_t)n * ldt + 8 * c) = o; }
    LDS_WAIT(); asm volatile("" ::: "memory");
}
constexpr int SCRP8 = 68;
__device__ __forceinline__ void conv64_f8(const float* src, int ldw, unsigned char* dst, int ldt, LAS unsigned char* scr, int lane, float scale) {
    const int kr = lane >> 4, nq = lane & 15;
    const float* sp = src + (size_t)kr * ldw + 4 * nq;
    f32x4 tv[16];
#pragma unroll
    for (int i = 0; i < 16; ++i) tv[i] = CONV_NT ? __builtin_nontemporal_load((const GAS f32x4*)(sp + (size_t)(4 * i) * ldw)) : *(const GAS f32x4*)(sp + (size_t)(4 * i) * ldw);
#pragma unroll
    for (int i = 0; i < 16; ++i) { const f32x4 t = tv[i] * scale; int a = __builtin_amdgcn_cvt_pk_fp8_f32(t.x, t.y, 0, false); a = __builtin_amdgcn_cvt_pk_fp8_f32(t.z, t.w, a, true);
        *(LAS unsigned*)(scr + (4 * i + kr) * SCRP8 + 4 * nq) = (unsigned)a; }
    LDS_WAIT(); asm volatile("" ::: "memory");
    const int c = lane & 3;
#pragma unroll
    for (int j = 0; j < 4; ++j) { const int n = (lane >> 2) + 16 * j; const LAS unsigned char* p = scr + (16 * c) * SCRP8 + n;
        unsigned o[4];
#pragma unroll
        for (int q = 0; q < 4; ++q) o[q] = (unsigned)p[(4 * q) * SCRP8] | ((unsigned)p[(4 * q + 1) * SCRP8] << 8) | ((unsigned)p[(4 * q + 2) * SCRP8] << 16) | ((unsigned)p[(4 * q + 3) * SCRP8] << 24);
        v4u ov; ov.x = o[0]; ov.y = o[1]; ov.z = o[2]; ov.w = o[3];
        if (CONV_NT) __builtin_nontemporal_store(ov, (GAS v4u*)(dst + (size_t)n * ldt + 16 * c)); else *(GAS v4u*)(dst + (size_t)n * ldt + 16 * c) = ov; }
    LDS_WAIT(); asm volatile("" ::: "memory");
}
__device__ __forceinline__ void p0_transpose_item_hilo(const float* src, int ldw, bf16* dhi, bf16* dlo, int ldt, LAS float* scr, int lane) {
    { const float* sp = src + (size_t)(lane >> 5) * ldw + (lane & 31); LAS float* dp = scr + (lane >> 5) * 33 + (lane & 31);
#pragma unroll 1
      for (int h = 0; h < 2; ++h) { float tv[16];
#pragma unroll
        for (int i = 0; i < 16; ++i) tv[i] = sp[(size_t)(2 * i) * ldw];
#pragma unroll
        for (int i = 0; i < 16; ++i) dp[(2 * i) * 33] = tv[i];
        sp += (size_t)32 * ldw; dp += 32 * 33; } }
    LDS_WAIT(); asm volatile("" ::: "memory");
    const int c = lane & 7;
#pragma unroll
    for (int j = 0; j < 4; ++j) { const int n = (lane >> 3) + 8 * j; const LAS float* s = scr + (8 * c) * 33 + n;
        float v[8]; unsigned h[8], l[8];
#pragma unroll
        for (int q = 0; q < 8; ++q) { v[q] = s[q * 33]; h[q] = f2bf(v[q]); l[q] = f2bf(v[q] - bf2f(h[q])); }
        v4u o; o.x = h[0] | (h[1] << 16); o.y = h[2] | (h[3] << 16); o.z = h[4] | (h[5] << 16); o.w = h[6] | (h[7] << 16);
        *(GAS v4u*)(dhi + (size_t)n * ldt + 8 * c) = o;
        o.x = l[0] | (l[1] << 16); o.y = l[2] | (l[3] << 16); o.z = l[4] | (l[5] << 16); o.w = l[6] | (l[7] << 16);
        *(GAS v4u*)(dlo + (size_t)n * ldt + 8 * c) = o; }
    LDS_WAIT(); asm volatile("" ::: "memory");
}
constexpr int I_G = (D / 64) * (DE / 64), I_D = (DE / 64) * (D / 64);
constexpr int QB_ITEMS = NE * 2 * I_G, QC_ITEMS = NE * I_D, CONV_CH = 8;
__device__ __forceinline__ void conv_item_gu(Frame& F, int s, int q, LAS float* scr) {
    const int up = q / I_G, q2 = q % I_G, nblk = DE / 64, kb = q2 / nblk, nb = q2 % nblk, n0 = 64 * nb;
    const float* W = up ? (s == 0 ? F.ws_up : F.w_up + (size_t)(s - 1) * D * DE) : (s == 0 ? F.ws_gate : F.w_gate + (size_t)(s - 1) * D * DE);
    const int drow = s * 1024 + (n0 >> 7) * 256 + up * 128 + (n0 & 127);
    if (MOE_F8) conv64_f8(W + (size_t)(64 * kb) * DE + n0, DE, (unsigned char*)(F.ws + WS_WGUT) + (size_t)drow * D + 64 * kb, D, (LAS unsigned char*)scr, F.lane, pg8::F8_SWG);
    else conv64(W + (size_t)(64 * kb) * DE + n0, DE, (bf16*)(F.ws + WS_WGUT) + (size_t)drow * D + 64 * kb, D, (LAS unsigned char*)scr, F.lane);
}
__device__ __forceinline__ void conv_item_dn(Frame& F, int s, int q, LAS float* scr) {
    const int nblk = D / 64, kb = q / nblk, nb = q % nblk;
    const float* W = (s == 0 ? F.ws_down : F.w_down + (size_t)(s - 1) * DE * D);
    if (MOE_F8) conv64_f8(W + (size_t)(64 * kb) * D + 64 * nb, D, (unsigned char*)(F.ws + WS_WDT) + (size_t)(s * D + 64 * nb) * DE + 64 * kb, DE, (LAS unsigned char*)scr, F.lane, pg8::F8_SWD);
    else conv64(W + (size_t)(64 * kb) * D + 64 * nb, D, (bf16*)(F.ws + WS_WDT) + (size_t)(s * D + 64 * nb) * DE + 64 * kb, DE, (LAS unsigned char*)scr, F.lane);
}
__device__ __forceinline__ void drain(Frame& F, int which, int fin_idx, unsigned target) {
    LAS float* scr = (LAS float*)(F.lds + RING_OFF + 32768 + F.wave * 12288);
    const unsigned total = which ? (unsigned)QC_ITEMS : (unsigned)QB_ITEMS;
    for (;;) {
        if (F.tid == 0) {
            unsigned base = 0xffffffffu; bool go = true;
            if (fin_idx >= 0) go = __hip_atomic_load(F.ctl + fin_idx, RLX_AGENT) < target;
            if (go) base = __hip_atomic_fetch_add(F.ctl + CW_Q + 64 * which, (unsigned)CONV_CH, RLX_AGENT);
            F.MISC[16] = base;
        }
        __syncthreads();
        const unsigned base = F.MISC[16];
        __syncthreads();
        if (base >= total) break;
        for (int j = F.wave; j < CONV_CH; j += NWAVES) { const unsigned r = base + j; if (r < total) { if (which) conv_item_dn(F, 1 + (int)(r / I_D), (int)(r % I_D), scr); else conv_item_gu(F, 1 + (int)(r / (2 * I_G)), (int)(r % (2 * I_G)), scr); } }
    }
}
__device__ __forceinline__ void phase_fin(Frame& F, int fin_idx) { __syncthreads(); if (F.tid == 0) __hip_atomic_fetch_add(F.ctl + fin_idx, 1u, RLX_AGENT); }

__device__ __forceinline__ void p0_gemv(Frame& F, int c0, int c1) {
    {
        __syncthreads();
        LAS float* cs = (LAS float*)(F.lds + RING_OFF);
        LAS float* red = (LAS float*)(F.lds + RING_OFF + 16384);
        for (int i = F.tid; i < NB * D; i += NTHR) { const float v = F.c[i]; cs[i] = v / (1.0f + __expf(-v)); }
        __syncthreads();
        float* part = (float*)(F.ws + WS_PART);
        const int nch = c1 - c0;
        for (int it = blockIdx.x; it < nch * KSL; it += F.G) {
            const int chunk = c0 + it % nch, sl = it / nch, k0 = sl * (D / KSL) + F.wave * 32;
            const float* wp = F.w_mod + (size_t)k0 * (6 * D) + chunk * 256 + F.lane * 4;
            f32x4 a0 = {0.f, 0.f, 0.f, 0.f}, a1 = {0.f, 0.f, 0.f, 0.f};
#pragma unroll 8
            for (int k = 0; k < 32; ++k) { const f32x4 w = *(const GAS f32x4*)(wp + (size_t)k * (6 * D)); const float c0 = cs[k0 + k], c1 = cs[D + k0 + k]; a0 += w * c0; a1 += w * c1; }
            *(LAS f32x4*)(red + (F.wave * 2 + 0) * 256 + F.lane * 4) = a0;
            *(LAS f32x4*)(red + (F.wave * 2 + 1) * 256 + F.lane * 4) = a1;
            __syncthreads();
            { const int b = F.tid >> 8, col = F.tid & 255; float s = 0.f;
#pragma unroll
              for (int w = 0; w < 8; ++w) s += red[(w * 2 + b) * 256 + col];
              part[((size_t)sl * 2 + b) * (6 * D) + chunk * 256 + col] = s; }
            __syncthreads();
        }
    }
}
__device__ __forceinline__ void p0_static_conv(Frame& F) {
    __syncthreads();
    LAS float* scr = (LAS float*)(F.lds + RING_OFF + 32768 + F.wave * 12288);
    const int gw = F.vcu * NWAVES + F.wave, NGW = F.G * NWAVES;
    constexpr int I_IN = (D / 64) * (INW / 64), I_OUT = (D / 64) * (D / 64), I_R = (D / 64) * (NE / 32);
    constexpr int NITEMS = I_IN + I_OUT + (2 * I_G + I_D) + I_R;
    bf16* WinT = (bf16*)(F.ws + WS_WINT); bf16* WoutT = (bf16*)(F.ws + WS_WOUTT);
    bf16* WrHi = (bf16*)(F.ws + WS_WRT); bf16* WrLo = WrHi + NE * D;
    for (int it = gw; it < NITEMS; it += NGW) {
        int r = it;
        if (r < I_IN) { const int nblk = INW / 64, kb = r / nblk, nb = r % nblk; conv64(F.w_in + (size_t)(64 * kb) * INW + 64 * nb, INW, WinT + (size_t)(64 * nb) * D + 64 * kb, D, (LAS unsigned char*)scr, F.lane); continue; } r -= I_IN;
        if (r < I_OUT) { const int nblk = D / 64, kb = r / nblk, nb = r % nblk; conv64(F.w_out + (size_t)(64 * kb) * D + 64 * nb, D, WoutT + (size_t)(64 * nb) * D + 64 * kb, D, (LAS unsigned char*)scr, F.lane); continue; } r -= I_OUT;
        if (r < 2 * I_G) { conv_item_gu(F, 0, r, scr); continue; } r -= 2 * I_G;
        if (r < I_D) { conv_item_dn(F, 0, r, scr); continue; } r -= I_D;
        { const int nblk = NE / 32, kb = r / nblk, nb = r % nblk;
          p0_transpose_item_hilo(F.w_router + (size_t)(64 * kb) * NE + 32 * nb, NE, WrHi + (size_t)(32 * nb) * D + 64 * kb, WrLo + (size_t)(32 * nb) * D + 64 * kb, D, scr, F.lane); }
    }
}

__device__ __forceinline__ void modf_reduce(Frame& F) {
    const float* part = (const float*)(F.ws + WS_PART); float* modf = (float*)(F.ws + WS_MODF);
    const int idx = blockIdx.x * NTHR + F.tid;
    if (idx < NB * 6 * D) { const int b = idx / (6 * D), j = idx % (6 * D); float s = F.b_mod[j];
#pragma unroll
        for (int sl = 0; sl < KSL; ++sl) s += part[((size_t)sl * 2 + b) * (6 * D) + j];
        modf[idx] = s; }
}
__device__ __forceinline__ void p1a_modulate(Frame& F) {
    const float* part = (const float*)(F.ws + WS_PART);
    LAS float* sm = (LAS float*)(F.lds + RING_OFF);
    bf16* hb = (bf16*)(F.ws + WS_HB);
    for (int r0 = F.vcu * 32; r0 < M; r0 += F.G * 32) {
        const int b = r0 / SEQ;
        __syncthreads();
        for (int i = F.tid; i < 2 * D; i += NTHR) { float s = F.b_mod[i];
#pragma unroll
            for (int sl = 0; sl < KSL; ++sl) s += part[((size_t)sl * 2 + b) * (6 * D) + i];
            sm[i] = s; }
        __syncthreads();
#pragma unroll 1
        for (int rr = 0; rr < 4; ++rr) {
            const int m = r0 + F.wave * 4 + rr; const GAS f32x4* xr = (const GAS f32x4*)(F.x + (size_t)m * D) + F.lane;
            const LAS f32x4* sh = (const LAS f32x4*)sm + F.lane; const LAS f32x4* sc = (const LAS f32x4*)(sm + D) + F.lane;
            GAS v2u* o = (GAS v2u*)(hb + (size_t)m * D) + F.lane;
#pragma unroll
            for (int j = 0; j < 8; ++j) { const f32x4 v = xr[64 * j], a = sc[64 * j], s = sh[64 * j]; const f32x4 h = v * (a + 1.0f) + s;
                v2u w; w.x = pk2(h.x, h.y); w.y = pk2(h.z, h.w); o[64 * j] = w; }
        }
    }
}

constexpr int KS_PITCH = 144, VT_PITCH = 528, LDS_KS = 0, LDS_VT = 256 * KS_PITCH;
__device__ __forceinline__ void p2_attn_conv(Frame& F) {
    const bf16* proj = (const bf16*)(F.ws + WS_PROJ); bf16* mix = (bf16*)(F.ws + WS_MIX);
    const int fr = F.lane & 15, fq = F.lane >> 4;
    for (int unit = blockIdx.x; unit < NB * (SEQ / 128) * NKVH; unit += F.G) {
        const int hkv = unit % NKVH, nb = (unit / NKVH) % (SEQ / 128), b = unit / (NKVH * (SEQ / 128));
        const int rowbase = b * SEQ + nb * 128 - 128;
        __syncthreads();
#pragma unroll
        for (int it = 0; it < 4; ++it) {
            const int idx = F.tid + NTHR * it, j = idx >> 3, c = idx & 7;
            v4u kv = {0u, 0u, 0u, 0u};
            if (nb > 0 || j >= 128) kv = *(const GAS v4u*)(proj + (size_t)(rowbase + j) * INW + COL_K + hkv * HD + c * 8);
            *(LAS v4u*)(F.lds + LDS_KS + j * KS_PITCH + c * 16) = kv;
        }
#pragma unroll
        for (int it = 0; it < 4; ++it) {
            const int idx = F.tid + NTHR * it, j = idx & 255, c = idx >> 8;
            v4u vv = {0u, 0u, 0u, 0u};
            if (nb > 0 || j >= 128) vv = *(const GAS v4u*)(proj + (size_t)(rowbase + j) * INW + COL_V + hkv * HD + c * 8);
            LAS unsigned short* vt = (LAS unsigned short*)(F.lds + LDS_VT + (c * 8) * VT_PITCH + j * 2);
            vt[0 * (VT_PITCH / 2)] = (unsigned short)(vv.x & 0xffffu); vt[1 * (VT_PITCH / 2)] = (unsigned short)(vv.x >> 16);
            vt[2 * (VT_PITCH / 2)] = (unsigned short)(vv.y & 0xffffu); vt[3 * (VT_PITCH / 2)] = (unsigned short)(vv.y >> 16);
            vt[4 * (VT_PITCH / 2)] = (unsigned short)(vv.z & 0xffffu); vt[5 * (VT_PITCH / 2)] = (unsigned short)(vv.z >> 16);
            vt[6 * (VT_PITCH / 2)] = (unsigned short)(vv.w & 0xffffu); vt[7 * (VT_PITCH / 2)] = (unsigned short)(vv.w >> 16);
        }
        __syncthreads();
        const int g = F.wave & 3, half = F.wave >> 2, h = hkv * 4 + g;
        const float slope2 = exp2f(-0.5f * (float)(h + 1)) * 1.4426950408889634f;
        const float sink2 = F.sinks[h] * 1.4426950408889634f;
        const float qk2 = 0.125f * 1.4426950408889634f;
#pragma unroll 1
        for (int mi = 0; mi < 4; ++mi) {
            const int i = half * 4 + mi, j0 = i >> 1;
            const size_t qrow = (size_t)(b * SEQ + nb * 128 + 16 * i + fr);
            const bf16x8 q0 = *(const GAS bf16x8*)(proj + qrow * INW + h * HD + 8 * fq), q1 = *(const GAS bf16x8*)(proj + qrow * INW + h * HD + 32 + 8 * fq);
            f32x4 s[10];
#pragma unroll
            for (int x = 0; x < 10; ++x) {
                const int tt = 2 * j0 + x;
                const bf16x8 k0 = *(const LAS bf16x8*)(F.lds + LDS_KS + (16 * tt + fr) * KS_PITCH + 16 * fq), k1 = *(const LAS bf16x8*)(F.lds + LDS_KS + (16 * tt + fr) * KS_PITCH + 64 + 16 * fq);
                f32x4 a = {0.f, 0.f, 0.f, 0.f};
                a = __builtin_amdgcn_mfma_f32_16x16x32_bf16(k0, q0, a, 0, 0, 0);
                a = __builtin_amdgcn_mfma_f32_16x16x32_bf16(k1, q1, a, 0, 0, 0);
                s[x] = a;
            }
            float mx = sink2;
#pragma unroll
            for (int x = 0; x < 10; ++x) {
#pragma unroll
                for (int r = 0; r < 4; ++r) {
                    const int kj = 16 * (2 * j0 + x) + 4 * fq + r, dist = 16 * i + fr + 128 - kj;
                    const bool valid = (dist >= 0) && (dist < 128) && (nb > 0 || kj >= 128);
                    const float v = valid ? (s[x][r] * qk2 - slope2 * (float)dist) : -INFINITY;
                    s[x][r] = v; mx = fmaxf(mx, v);
                }
            }
            mx = fmaxf(mx, __shfl_xor(mx, 16)); mx = fmaxf(mx, __shfl_xor(mx, 32));
            float l = 0.f;
#pragma unroll
            for (int x = 0; x < 10; ++x) {
#pragma unroll
                for (int r = 0; r < 4; ++r) { const float p = __builtin_amdgcn_exp2f(s[x][r] - mx); s[x][r] = p; l += p; }
            }
            l += __shfl_xor(l, 16); l += __shfl_xor(l, 32);
            const float inv = 1.0f / (l + __builtin_amdgcn_exp2f(sink2 - mx));
            f32x4 o[4];
#pragma unroll
            for (int dt = 0; dt < 4; ++dt) o[dt] = (f32x4){0.f, 0.f, 0.f, 0.f};
#pragma unroll
            for (int pp = 0; pp < 5; ++pp) {
                const int tt0 = 2 * (j0 + pp);
                v4u pw; pw.x = pk2(s[2 * pp][0] * inv, s[2 * pp][1] * inv); pw.y = pk2(s[2 * pp][2] * inv, s[2 * pp][3] * inv);
                pw.z = pk2(s[2 * pp + 1][0] * inv, s[2 * pp + 1][1] * inv); pw.w = pk2(s[2 * pp + 1][2] * inv, s[2 * pp + 1][3] * inv);
                const bf16x8 pf = __builtin_bit_cast(bf16x8, pw);
#pragma unroll
                for (int dt = 0; dt < 4; ++dt) {
                    const LAS unsigned char* vp = F.lds + LDS_VT + (16 * dt + fr) * VT_PITCH + 32 * tt0 + 8 * fq;
                    const v2u lo = *(const LAS v2u*)vp, hi = *(const LAS v2u*)(vp + 32);
                    v4u vw; vw.x = lo.x; vw.y = lo.y; vw.z = hi.x; vw.w = hi.y;
                    o[dt] = __builtin_amdgcn_mfma_f32_16x16x32_bf16(__builtin_bit_cast(bf16x8, vw), pf, o[dt], 0, 0, 0);
                }
            }
#pragma unroll
            for (int dt = 0; dt < 4; ++dt) { v2u w; w.x = pk2(o[dt][0], o[dt][1]); w.y = pk2(o[dt][2], o[dt][3]);
                *(GAS v2u*)(mix + qrow * D + h * HD + 16 * dt + 4 * fq) = w; }
        }
    }
    for (int item = F.vcu * NTHR + F.tid; item < (M / 8) * (CW / 8); item += F.G * NTHR) {
        const int cch = item % (CW / 8), rb = item / (CW / 8), r0 = rb * 8, t0 = r0 % SEQ, c0 = cch * 8;
        float w0[8], w1[8], w2[8], u1[8], u2[8];
        { const f32x4 a = *(const GAS f32x4*)(F.conv_w + c0), b2 = *(const GAS f32x4*)(F.conv_w + c0 + 4);
          w0[0] = a.x; w0[1] = a.y; w0[2] = a.z; w0[3] = a.w; w0[4] = b2.x; w0[5] = b2.y; w0[6] = b2.z; w0[7] = b2.w; }
        { const f32x4 a = *(const GAS f32x4*)(F.conv_w + CW + c0), b2 = *(const GAS f32x4*)(F.conv_w + CW + c0 + 4);
          w1[0] = a.x; w1[1] = a.y; w1[2] = a.z; w1[3] = a.w; w1[4] = b2.x; w1[5] = b2.y; w1[6] = b2.z; w1[7] = b2.w; }
        { const f32x4 a = *(const GAS f32x4*)(F.conv_w + 2 * CW + c0), b2 = *(const GAS f32x4*)(F.conv_w + 2 * CW + c0 + 4);
          w2[0] = a.x; w2[1] = a.y; w2[2] = a.z; w2[3] = a.w; w2[4] = b2.x; w2[5] = b2.y; w2[6] = b2.z; w2[7] = b2.w; }
        if (t0 == 0) {
#pragma unroll
            for (int q = 0; q < 8; ++q) { u1[q] = 0.f; u2[q] = 0.f; }
        } else {
            const v4u c1 = *(const GAS v4u*)(proj + (size_t)(r0 - 1) * INW + COL_CC + c0), h1 = *(const GAS v4u*)(proj + (size_t)(r0 - 1) * INW + COL_CH + c0);
            const v4u c2 = *(const GAS v4u*)(proj + (size_t)(r0 - 2) * INW + COL_CC + c0), h2 = *(const GAS v4u*)(proj + (size_t)(r0 - 2) * INW + COL_CH + c0);
            u1[0] = bflo(c1.x) * bflo(h1.x); u1[1] = bfhi(c1.x) * bfhi(h1.x); u1[2] = bflo(c1.y) * bflo(h1.y); u1[3] = bfhi(c1.y) * bfhi(h1.y);
            u1[4] = bflo(c1.z) * bflo(h1.z); u1[5] = bfhi(c1.z) * bfhi(h1.z); u1[6] = bflo(c1.w) * bflo(h1.w); u1[7] = bfhi(c1.w) * bfhi(h1.w);
            u2[0] = bflo(c2.x) * bflo(h2.x); u2[1] = bfhi(c2.x) * bfhi(h2.x); u2[2] = bflo(c2.y) * bflo(h2.y); u2[3] = bfhi(c2.y) * bfhi(h2.y);
            u2[4] = bflo(c2.z) * bflo(h2.z); u2[5] = bfhi(c2.z) * bfhi(h2.z); u2[6] = bflo(c2.w) * bflo(h2.w); u2[7] = bfhi(c2.w) * bfhi(h2.w);
        }
#pragma unroll
        for (int rr = 0; rr < 8; ++rr) {
            const size_t ro = (size_t)(r0 + rr) * INW;
            const v4u bv = *(const GAS v4u*)(proj + ro + COL_CB + c0), cv = *(const GAS v4u*)(proj + ro + COL_CC + c0), hv = *(const GAS v4u*)(proj + ro + COL_CH + c0);
            float u0[8], cb[8], y[8];
            u0[0] = bflo(cv.x) * bflo(hv.x); u0[1] = bfhi(cv.x) * bfhi(hv.x); u0[2] = bflo(cv.y) * bflo(hv.y); u0[3] = bfhi(cv.y) * bfhi(hv.y);
            u0[4] = bflo(cv.z) * bflo(hv.z); u0[5] = bfhi(cv.z) * bfhi(hv.z); u0[6] = bflo(cv.w) * bflo(hv.w); u0[7] = bfhi(cv.w) * bfhi(hv.w);
            cb[0] = bflo(bv.x); cb[1] = bfhi(bv.x); cb[2] = bflo(bv.y); cb[3] = bfhi(bv.y); cb[4] = bflo(bv.z); cb[5] = bfhi(bv.z); cb[6] = bflo(bv.w); cb[7] = bfhi(bv.w);
#pragma unroll
            for (int q = 0; q < 8; ++q) { y[q] = cb[q] * (w0[q] * u2[q] + w1[q] * u1[q] + w2[q] * u0[q]); u2[q] = u1[q]; u1[q] = u0[q]; }
            v4u ov; ov.x = pk2(y[0], y[1]); ov.y = pk2(y[2], y[3]); ov.z = pk2(y[4], y[5]); ov.w = pk2(y[6], y[7]);
            *(GAS v4u*)(mix + (size_t)(r0 + rr) * D + AW + c0) = ov;
        }
    }
}

constexpr int P4_STAT = 0, P4_GB = 1024, P4_PART = P4_GB + 4 * D * 4, P4_END = P4_PART + 8 * 32 * 64 * 4;
static_assert(P4_END <= RING_BYTES, "P4 LDS");
__device__ __forceinline__ void p4_ln_router(Frame& F, int u_first, int u_stride) {
    const bf16* y1 = (const bf16*)(F.ws + WS_Y1); bf16* x1 = (bf16*)(F.ws + WS_X1); bf16* xg = (bf16*)(F.ws + WS_XG);
    const float* modf = (const float*)(F.ws + WS_MODF);
    const bf16* WrHi = (const bf16*)(F.ws + WS_WRT); const bf16* WrLo = WrHi + NE * D;
    int* rowtok = (int*)(F.ws + WS_ROWTOK); float* roww = (float*)(F.ws + WS_ROWW); int* tokslot = (int*)(F.ws + WS_TOKSLOT);
    LAS float* stat = (LAS float*)(F.lds + P4_STAT); LAS float* GB = (LAS float*)(F.lds + P4_GB); LAS float* lpart = (LAS float*)(F.lds + P4_PART);
    const int fr = F.lane & 15, fq = F.lane >> 4;
    for (int unit = u_first; unit < M / 32; unit += u_stride) {
        const int row0 = unit * 32, b = row0 / SEQ;
        const float* sh2 = modf + (size_t)b * 6 * D + 3 * D; const float* sc2 = modf + (size_t)b * 6 * D + 4 * D;
        __syncthreads();
        if (F.tid < NE) ((LAS unsigned*)(F.lds + P4_STAT + 512))[F.tid] = 0u;
        for (int k = F.tid; k < D; k += NTHR) { const float a = 1.0f + sc2[k], g = F.ln1_g[k], bb = F.ln1_b[k]; GB[k] = g * a; GB[D + k] = bb * a + sh2[k]; GB[2 * D + k] = g; GB[3 * D + k] = bb; }
        v4u yw[4][4];
#pragma unroll
        for (int rr = 0; rr < 4; ++rr) { const GAS v4u* yr = (const GAS v4u*)(y1 + (size_t)(row0 + F.wave * 4 + rr) * D) + F.lane;
#pragma unroll
            for (int c = 0; c < 4; ++c) yw[rr][c] = yr[64 * c]; }
        __syncthreads();
#pragma unroll
        for (int rr = 0; rr < 4; ++rr) {
            const int r = F.wave * 4 + rr; const size_t m = (size_t)(row0 + r);
            f32x4 v[8]; float s = 0.f;
#pragma unroll
            for (int c = 0; c < 4; ++c) { const v4u w = yw[rr][c]; v[2 * c] = (f32x4){bflo(w.x), bfhi(w.x), bflo(w.y), bfhi(w.y)}; v[2 * c + 1] = (f32x4){bflo(w.z), bfhi(w.z), bflo(w.w), bfhi(w.w)}; }
#pragma unroll
            for (int j = 0; j < 8; ++j) s += (v[j].x + v[j].y) + (v[j].z + v[j].w);
            const float mean = wave_sum(s) * (1.f / D); float s2 = 0.f;
#pragma unroll
            for (int j = 0; j < 8; ++j) { v[j] = v[j] - mean; s2 += (v[j].x * v[j].x + v[j].y * v[j].y) + (v[j].z * v[j].z + v[j].w * v[j].w); }
            const float rstd = 1.f / sqrtf(wave_sum(s2) * (1.f / D) + LN_EPS);
            if (F.lane == 0) { stat[2 * r] = mean; stat[2 * r + 1] = rstd; }
            GAS v2u* xo = (GAS v2u*)(x1 + m * D); GAS v2u* ho = (GAS v2u*)(xg + m * D); GAS unsigned* ho8 = (GAS unsigned*)((unsigned char*)xg + m * D);
#pragma unroll
            for (int j = 0; j < 8; ++j) {
                const int q4 = 128 * (j >> 1) + 2 * F.lane + (j & 1);
                const f32x4 vn = v[j] * rstd;
                const f32x4 xv = vn * *((const LAS f32x4*)(GB + 2 * D) + q4) + *((const LAS f32x4*)(GB + 3 * D) + q4); { v2u xw; xw.x = pk2(xv.x, xv.y); xw.y = pk2(xv.z, xv.w); xo[q4] = xw; }
                const f32x4 hv = vn * *((const LAS f32x4*)GB + q4) + *((const LAS f32x4*)(GB + D) + q4);
                if (MOE_F8) { f32x4 t = hv * pg8::F8_SX;
#pragma unroll
                    for (int q = 0; q < 4; ++q) t[q] = __builtin_fminf(__builtin_fmaxf(t[q], -440.0f), 440.0f);
                    int pa = __builtin_amdgcn_cvt_pk_fp8_f32(t.x, t.y, 0, false); pa = __builtin_amdgcn_cvt_pk_fp8_f32(t.z, t.w, pa, true); ho8[q4] = (unsigned)pa; }
                else { v2u w; w.x = pk2(hv.x, hv.y); w.y = pk2(hv.z, hv.w); ho[q4] = w; }
            }
        }
        __syncthreads();
        {
            f32x4 acc[2][4];
#pragma unroll
            for (int mt = 0; mt < 2; ++mt)
#pragma unroll
                for (int nt = 0; nt < 4; ++nt) acc[mt][nt] = (f32x4){0.f, 0.f, 0.f, 0.f};
            const float mu0 = stat[2 * fr], rs0 = stat[2 * fr + 1], mu1 = stat[2 * (16 + fr)], rs1 = stat[2 * (16 + fr) + 1];
#pragma unroll 4
            for (int ks = F.wave * 8; ks < F.wave * 8 + 8; ++ks) {
                const int k0 = 32 * ks + 8 * fq;
                const f32x4 g0 = *(const LAS f32x4*)(GB + k0), g1 = *(const LAS f32x4*)(GB + k0 + 4), b0 = *(const LAS f32x4*)(GB + D + k0), b1 = *(const LAS f32x4*)(GB + D + k0 + 4);
                bf16x8 whi[4], wlo[4];
#pragma unroll
                for (int nt = 0; nt < 4; ++nt) { whi[nt] = *(const GAS bf16x8*)(WrHi + (size_t)(16 * nt + fr) * D + k0); wlo[nt] = *(const GAS bf16x8*)(WrLo + (size_t)(16 * nt + fr) * D + k0); }
#pragma unroll
                for (int mt = 0; mt < 2; ++mt) {
                    const float mu = mt ? mu1 : mu0, rs = mt ? rs1 : rs0;
                    const v4u yw = *(const GAS v4u*)(y1 + (size_t)(row0 + 16 * mt + fr) * D + k0);
                    const f32x4 ya = {bflo(yw.x), bfhi(yw.x), bflo(yw.y), bfhi(yw.y)}, yb = {bflo(yw.z), bfhi(yw.z), bflo(yw.w), bfhi(yw.w)};
                    const f32x4 ha = (ya - mu) * rs * g0 + b0, hb2 = (yb - mu) * rs * g1 + b1;
                    unsigned hh[8], ll[8];
                    { const float t[8] = {ha.x, ha.y, ha.z, ha.w, hb2.x, hb2.y, hb2.z, hb2.w};
#pragma unroll
                      for (int q = 0; q < 8; ++q) { hh[q] = f2bf(t[q]); ll[q] = f2bf(t[q] - bf2f(hh[q])); } }
                    v4u ah, al; ah.x = hh[0] | (hh[1] << 16); ah.y = hh[2] | (hh[3] << 16); ah.z = hh[4] | (hh[5] << 16); ah.w = hh[6] | (hh[7] << 16);
                    al.x = ll[0] | (ll[1] << 16); al.y = ll[2] | (ll[3] << 16); al.z = ll[4] | (ll[5] << 16); al.w = ll[6] | (ll[7] << 16);
                    const bf16x8 fh = __builtin_bit_cast(bf16x8, ah), fl = __builtin_bit_cast(bf16x8, al);
#pragma unroll
                    for (int nt = 0; nt < 4; ++nt) {
                        acc[mt][nt] = __builtin_amdgcn_mfma_f32_16x16x32_bf16(fh, whi[nt], acc[mt][nt], 0, 0, 0);
                        acc[mt][nt] = __builtin_amdgcn_mfma_f32_16x16x32_bf16(fl, whi[nt], acc[mt][nt], 0, 0, 0);
                        acc[mt][nt] = __builtin_amdgcn_mfma_f32_16x16x32_bf16(fh, wlo[nt], acc[mt][nt], 0, 0, 0);
                    }
                }
            }
#pragma unroll
            for (int mt = 0; mt < 2; ++mt)
#pragma unroll
                for (int nt = 0; nt < 4; ++nt)
#pragma unroll
                    for (int r = 0; r < 4; ++r) lpart[(F.wave * 32 + 16 * mt + 4 * fq + r) * 64 + 16 * nt + fr] = acc[mt][nt][r];
        }
        __syncthreads();
        {
            LAS unsigned* hist = (LAS unsigned*)(F.lds + P4_STAT + 512); LAS unsigned* hbase = hist + 64;
            const int e = F.lane; const float rb = F.router_bias[e];
            bool chosen[4]; float wgt[4]; int erks[4]; unsigned lrank[4];
#pragma unroll
            for (int rr = 0; rr < 4; ++rr) {
                const int r = F.wave * 4 + rr;
                float logit = 0.f;
#pragma unroll
                for (int w = 0; w < 8; ++w) logit += lpart[(w * 32 + r) * 64 + e];
                const float score = 1.0f / (1.0f + __expf(-logit));
                const float sel = score + rb;
                int rk = 0;
#pragma unroll
                for (int x = 1; x < 8; ++x) { const float o = __shfl_xor(sel, x); const int e2 = e ^ x; rk += (o > sel || (o == sel && e2 < e)) ? 1 : 0; }
                float gs = rk < 2 ? sel : 0.f;
                gs += __shfl_xor(gs, 1); gs += __shfl_xor(gs, 2); gs += __shfl_xor(gs, 4);
                int grk = 0; const int gi = e >> 3;
#pragma unroll
                for (int x = 1; x < 8; ++x) { const float o = __shfl_xor(gs, 8 * x); const int g2 = gi ^ x; grk += (o > gs || (o == gs && g2 < gi)) ? 1 : 0; }
                const bool gsel = grk < 4;
                const float mv = gsel ? sel : -INFINITY;
                int erk = 0;
#pragma unroll 9
                for (int x = 1; x < 64; ++x) { const float o = __shfl_xor(mv, x); const int e2 = e ^ x; erk += (o > mv || (o == mv && e2 < e)) ? 1 : 0; }
                chosen[rr] = gsel && erk < TOPK; erks[rr] = erk;
                const float wsum = wave_sum(chosen[rr] ? score : 0.f);
                wgt[rr] = score / wsum * RSCALE;
                lrank[rr] = chosen[rr] ? __hip_atomic_fetch_add(hist + e, 1u, __ATOMIC_RELAXED, __HIP_MEMORY_SCOPE_WORKGROUP) : 0u;
            }
            __syncthreads();
            if (F.tid < NE) { const unsigned n = hist[F.tid]; hbase[F.tid] = n ? __hip_atomic_fetch_add(F.ctl + CW_CNT + 64 * F.tid, n, RLX_AGENT) : 0u; }
            __syncthreads();
            const unsigned pb = hbase[e];
#pragma unroll
            for (int rr = 0; rr < 4; ++rr) if (chosen[rr]) { const int tok = row0 + F.wave * 4 + rr; const unsigned pos = pb + lrank[rr];
                rowtok[e * M + pos] = tok; roww[e * M + pos] = wgt[rr]; tokslot[tok * TOPK + erks[rr]] = e * M + (int)pos; }
        }
    }
}

__device__ __forceinline__ void build_tables(Frame& F) {
    LAS unsigned short* tslot = (LAS unsigned short*)(F.lds + TS_OFF); LAS int* poff = (LAS int*)(F.lds + POFF_OFF); LAS int* cnt = poff + 128; LAS int* nt_p = poff + 256;
    __syncthreads();
    if (F.tid < NE) cnt[F.tid] = (int)__hip_atomic_load(F.ctl + CW_CNT + 64 * F.tid, RLX_AGENT);
    __syncthreads();
    if (F.tid == 0) {
        int t = M / 256; poff[0] = 0;
        for (int i = 0; i < M / 256; ++i) tslot[i] = 0;
        for (int e = 0; e < NE; ++e) { poff[1 + e] = t * 256; int c = cnt[e]; c = c < 0 ? 0 : (c > M ? M : c); const int n = (c + 255) >> 8; for (int i = 0; i < n && t < MAXT; ++i) tslot[t++] = (unsigned short)(1 + e); }
        nt_p[0] = t;
    }
    __syncthreads();
}

__device__ __forceinline__ void p6_setup(Frame& F, int Geff, int c) {
    const LAS unsigned short* tslot = (const LAS unsigned short*)(F.lds + TS_OFF); const LAS int* poff = (const LAS int*)(F.lds + POFF_OFF); const LAS int* cnt = poff + 128; const int ntiles = poff[256];
    const int* rowtok = (const int*)(F.ws + WS_ROWTOK); const float* roww = (const float*)(F.ws + WS_ROWW); float* wrow = (float*)(F.ws + WS_WROW);
    v4u* vt = (v4u*)(F.ws + WS_VTAB) + (size_t)blockIdx.x * 8 * NTHR;
    int R0, C0, R1, C1; pg8::stage_rc(F.tid * 16, R0, C0); pg8::stage_rc(F.tid * 16 + 8192, R1, C1);
#pragma unroll 1
    for (int i = 0; i < 8; ++i) {
        const int L = i * Geff + c; if (L >= ntiles * 4) break;
        const int t = L >> 2, s = tslot[t], e = s - 1, pos0 = t * 256 - poff[s], ce = s ? cnt[e] : 0;
        int rr[4] = {R0, R1, 128 + R0, 128 + R1}; const int cc[4] = {C0, C1, C0, C1}; unsigned off[4];
#pragma unroll
        for (int q = 0; q < 4; ++q) { int tok = t * 256 + rr[q]; if (s) { const int pos = pos0 + rr[q]; tok = pos < ce ? rowtok[e * M + pos] : 0; } off[q] = (unsigned)(tok * (MOE_F8 ? D / 2 : D) + cc[q]) * 2u; }
        v4u o; o.x = off[0]; o.y = off[1]; o.z = off[2]; o.w = off[3]; vt[i * NTHR + F.tid] = o;
        if (F.tid < 256) { float w = 1.0f; if (s) { const int pos = pos0 + F.tid; w = pos < ce ? roww[e * M + pos] : 0.f; } wrow[t * 256 + F.tid] = w; }
    }
    VM_WAIT(); __syncthreads();
}

__device__ __forceinline__ void p7_combine(Frame& F) {
    build_tables(F);
    const LAS int* poff = (const LAS int*)(F.lds + POFF_OFF);
    const unsigned char* Y = (const unsigned char*)(F.ws + WS_XG); const bf16* x1 = (const bf16*)(F.ws + WS_X1); const float* modf = (const float*)(F.ws + WS_MODF);
    const int* tokslot = (const int*)(F.ws + WS_TOKSLOT);
    const int gw = F.vcu * NWAVES + F.wave, NGW = F.G * NWAVES;
    typedef float f32x2 __attribute__((ext_vector_type(2)));
    for (int m = gw; m < M; m += NGW) {
        const int b = m / SEQ; const float* g2 = modf + (size_t)b * 6 * D + 5 * D;
        int ln = F.lane; asm volatile("" : "+v"(ln));
        int rows[9]; rows[0] = m;
#pragma unroll
        for (int k = 0; k < TOPK; ++k) { const int sl = __builtin_amdgcn_readfirstlane(tokslot[m * TOPK + k]), e = sl / M, pos = sl % M; rows[1 + k] = poff[1 + e] + pos; }
        f32x4 v[2][4];
#pragma unroll
        for (int j = 0; j < 2; ++j)
#pragma unroll
            for (int q = 0; q < 4; ++q) v[j][q] = (f32x4){0.f, 0.f, 0.f, 0.f};
        v4u w[9][2];
#pragma unroll
        for (int k = 0; k < 9; ++k) { const GAS v4u* yr = (const GAS v4u*)(Y + (size_t)rows[k] * D); w[k][0] = yr[ln]; w[k][1] = yr[64 + ln]; }
        f32x4 xv[2][4];
        { const GAS v4u* xr0 = (const GAS v4u*)(x1 + (size_t)m * D);
#pragma unroll
          for (int j = 0; j < 2; ++j)
#pragma unroll
              for (int h = 0; h < 2; ++h) { const v4u w = xr0[2 * ln + 128 * j + h];
                  xv[j][2 * h] = (f32x4){bflo(w.x), bfhi(w.x), bflo(w.y), bfhi(w.y)}; xv[j][2 * h + 1] = (f32x4){bflo(w.z), bfhi(w.z), bflo(w.w), bfhi(w.w)}; } }
#pragma unroll
        for (int k = 0; k < 9; ++k)
#pragma unroll
            for (int j = 0; j < 2; ++j) {
                const unsigned ww[4] = {w[k][j].x, w[k][j].y, w[k][j].z, w[k][j].w};
#pragma unroll
                for (int q = 0; q < 4; ++q) { const f32x2 lo = (Y_BF8 == 2) ? __builtin_amdgcn_cvt_pk_f32_fp8((int)ww[q], false) : __builtin_amdgcn_cvt_pk_f32_bf8((int)ww[q], false), hi = (Y_BF8 == 2) ? __builtin_amdgcn_cvt_pk_f32_fp8((int)ww[q], true) : __builtin_amdgcn_cvt_pk_f32_bf8((int)ww[q], true);
                    v[j][q].x += lo.x; v[j][q].y += lo.y; v[j][q].z += hi.x; v[j][q].w += hi.y; }
            }
        const GAS f32x4* gr = (const GAS f32x4*)g2; const int l4 = 4 * ln; float s = 0.f;
#pragma unroll
        for (int j = 0; j < 2; ++j)
#pragma unroll
            for (int q = 0; q < 4; ++q) { v[j][q] = xv[j][q] * ALPHA + (gr[l4 + 256 * j + q] + 1.0f) * (v[j][q] * ((Y_BF8 == 2) ? (1.0f / 64.0f) : 1.0f)); s += (v[j][q].x + v[j][q].y) + (v[j][q].z + v[j][q].w); }
        const float mean = wave_sum(s) * (1.f / D); float s2 = 0.f;
#pragma unroll
        for (int j = 0; j < 2; ++j)
#pragma unroll
            for (int q = 0; q < 4; ++q) { v[j][q] = v[j][q] - mean; s2 += (v[j][q].x * v[j][q].x + v[j][q].y * v[j][q].y) + (v[j][q].z * v[j][q].z + v[j][q].w * v[j][q].w); }
        const float rstd = 1.f / sqrtf(wave_sum(s2) * (1.f / D) + LN_EPS);
        GAS f32x4* o = (GAS f32x4*)(F.out + (size_t)m * D); const GAS f32x4* lg = (const GAS f32x4*)F.ln2_g; const GAS f32x4* lb = (const GAS f32x4*)F.ln2_b;
#pragma unroll
        for (int j = 0; j < 2; ++j)
#pragma unroll
            for (int q = 0; q < 4; ++q) o[l4 + 256 * j + q] = v[j][q] * rstd * lg[l4 + 256 * j + q] + lb[l4 + 256 * j + q];
    }
}

constexpr int NPHASE = 9;
struct Args { const float* in[20]; float* out; unsigned char* ws; int ph_lo, ph_hi; };
__global__ void __launch_bounds__(NWAVES * 64, 2) mk_fwd(Args args) {
    extern __shared__ __attribute__((aligned(16))) unsigned char lds[];
    Frame F;
    F.lds = (LAS unsigned char*)lds;
    F.MISC = (volatile LAS unsigned*)(F.lds + MISC_OFF);
    F.tid = threadIdx.x; F.lane = F.tid & 63; F.wave = __builtin_amdgcn_readfirstlane(F.tid >> 6);
    F.G = gridDim.x; { const int bx = blockIdx.x; F.vcu = (F.G % 8 == 0) ? (bx % 8) * (F.G / 8) + bx / 8 : bx; }
    F.ws = args.ws; F.ctl = (gu32*)(args.ws + WS_CTL);
    F.x = args.in[0]; F.c = args.in[1]; F.w_mod = args.in[2]; F.b_mod = args.in[3]; F.w_in = args.in[4]; F.conv_w = args.in[5]; F.sinks = args.in[6]; F.w_out = args.in[7];
    F.ln1_g = args.in[8]; F.ln1_b = args.in[9]; F.w_router = args.in[10]; F.router_bias = args.in[11]; F.w_gate = args.in[12]; F.w_up = args.in[13]; F.w_down = args.in[14];
    F.ws_gate = args.in[15]; F.ws_up = args.in[16]; F.ws_down = args.in[17]; F.ln2_g = args.in[18]; F.ln2_b = args.in[19]; F.out = args.out;
    for (int u = F.tid; u < (LDS_BYTES - LDSCTL_OFF) / 4; u += NWAVES * 64) ((LAS unsigned*)(F.lds + LDSCTL_OFF))[u] = 0u;
    __syncthreads();
    XcdBarrier bar; bar.bar = (unsigned*)(F.ctl + CW_BAR); bar.x = 0; bar.st = nullptr;
    if (!MK_PER_PHASE) bar = xcd_barrier_post((unsigned*)(F.ctl + CW_BAR), F.MISC + 8);
#define GRID_BAR() do { if (!MK_PER_PHASE) xcd_barrier(bar); } while (0)
    unsigned long long tA = 0;
#define ST_BEGIN(k) do { if (PROBE_STAMP == (k)) tA = __builtin_amdgcn_s_memrealtime(); } while (0)
#define ST_END(k) do { if (PROBE_STAMP == (k)) { const unsigned long long t1 = __builtin_amdgcn_s_memrealtime(), dd = t1 - tA; while (__builtin_amdgcn_s_memrealtime() - t1 < dd) __builtin_amdgcn_s_sleep(8); } } while (0)
    const int lo = args.ph_lo, hi = args.ph_hi;
#define IN(k) (lo <= (k) && (k) < hi && ((F.lane = pg8::lane_id_v()), (F.tid = F.wave * 64 + F.lane), true))
#define BOTH(k) (IN(k) && IN((k) + 1))
    if (IN(0)) { ST_BEGIN(0); p0_gemv(F, 0, 16); if (BOTH(0)) GRID_BAR(); ST_END(0); }
    if (IN(1)) { ST_BEGIN(1); p1a_modulate(F); p0_gemv(F, 16, 48); p0_static_conv(F); if (BOTH(1)) GRID_BAR(); ST_END(1); }
    if (IN(2)) {
        ST_BEGIN(2);
        __syncthreads();
        const bool split = (F.G == 256); const int q = (int)blockIdx.x >> 3, x = (int)blockIdx.x & 7, Geff = split ? 192 : F.G;
        if (!split || q < 24) {
            pg8::Gemm g{(const pg8::bf16_t*)(F.ws + WS_HB), (const pg8::bf16_t*)(F.ws + WS_WINT), M, INW, D, F.ws}; pg8::StaticOrder S; S.init(M, INW, Geff, split ? q * 8 + x : (int)blockIdx.x);
            pg8::EpiBf16<0> E{(pg8::bf16_t*)(F.ws + WS_PROJ), INW, nullptr, 0, 0, 1.f};
            pg8::gemm_phase<pg8::EpiBf16<0>, pg8::StaticOrder, PG8_ALIGN, PG8_SP2>(F.lds + RING_OFF, g, S, E, F.wave);
            phase_fin(F, CW_FIN + 64 * 2);
        } else { drain(F, 0, CW_FIN + 64 * 2, (unsigned)Geff); drain(F, 1, CW_FIN + 64 * 2, (unsigned)Geff); }
        if (BOTH(2)) GRID_BAR();
        ST_END(2);
    }
    if (IN(3)) { ST_BEGIN(3); modf_reduce(F); p2_attn_conv(F); if (BOTH(3)) GRID_BAR(); ST_END(3); }
    if (IN(4)) {
        ST_BEGIN(4);
        _Pragma("unroll") for (int rep = (REP_PHASE == 4 ? 0 : 1); rep < 2; ++rep) {
        __syncthreads();
        pg8::Gemm g{(const pg8::bf16_t*)(F.ws + WS_MIX), (const pg8::bf16_t*)(F.ws + WS_WOUTT), M, D, D, F.ws}; pg8::StaticOrder S; S.init(M, D, F.G, (int)blockIdx.x);
        pg8::EpiResF32 E{F.x, (pg8::bf16_t*)(F.ws + WS_Y1), (const float*)(F.ws + WS_MODF) + 2 * D, D, SEQ, 6 * D, ALPHA};
        pg8::gemm_phase<pg8::EpiResF32, pg8::StaticOrder, PG8_ALIGN, PG8_SP2>(F.lds + RING_OFF, g, S, E, F.wave);
        if (rep == 0) GRID_BAR(); }
        if (BOTH(4)) GRID_BAR();
        ST_END(4);
    }
    if (IN(5)) { ST_BEGIN(5);
        const bool split5 = (F.G == 256) && (P5_MAIN_Q < 32); const int q5 = (int)blockIdx.x >> 3, x5 = (int)blockIdx.x & 7, nmain = split5 ? 8 * P5_MAIN_Q : F.G;
        if (!split5 || q5 < P5_MAIN_Q) { p4_ln_router(F, split5 ? q5 * 8 + x5 : (int)blockIdx.x, nmain); phase_fin(F, CW_FIN + 64 * 5); }
        else { drain(F, 0, CW_FIN + 64 * 5, (unsigned)nmain); drain(F, 1, CW_FIN + 64 * 5, (unsigned)nmain); }
        __syncthreads(); ST_BEGIN(10); drain(F, 0, -1, 0u); ST_END(10); if (BOTH(5)) GRID_BAR(); ST_END(5); }
    if (IN(6)) {
        ST_BEGIN(6); ST_BEGIN(12);
        build_tables(F);
        const int ntiles = ((const LAS int*)(F.lds + POFF_OFF))[256];
        const int units = ntiles * 4, Rn = (units + F.G - 1) / F.G, slack = F.G - (units + Rn - 1) / Rn, R = (F.G == 256 && slack < P6_MIN_CONV) ? Rn + 1 : Rn, Geff = (F.G % 8 == 0) ? (units + R - 1) / R : F.G;
        const int x = (int)blockIdx.x & 7, q = (int)blockIdx.x >> 3;
        int c = (int)blockIdx.x;
        if (F.G % 8 == 0) { int px = 0; for (int xx = 0; xx < x; ++xx) px += (Geff - xx + 7) >> 3; c = px + q; }
        if ((int)blockIdx.x < Geff) {
            p6_setup(F, Geff, c);
            int Kgu = MOE_F8 ? D / 2 : D; asm volatile("" : "+s"(Kgu));
            pg8::Gemm g{(const pg8::bf16_t*)(F.ws + WS_XG), (const pg8::bf16_t*)(F.ws + WS_WGUT), M, NSLOT * 1024, Kgu, F.ws};
            pg8::GroupedOrder<true> S{(const PG8_LAS unsigned short*)(F.lds + TS_OFF), ntiles, 4, Geff, c, (const unsigned*)(F.ws + WS_VTAB) + (size_t)blockIdx.x * 8 * NTHR * 4, 0, (const float*)(F.ws + WS_WROW)};
            pg8::EpiSwiGLU E{(pg8::bf16_t*)(F.ws + WS_H), (const PG8_LAS float*)(F.lds + RING_OFF + pg8::WR_SLOT), DE, 4};
            pg8::gemm_phase<pg8::EpiSwiGLU, pg8::GroupedOrder<true>, PG8_ALIGN, PG8_SP2>(F.lds + RING_OFF, g, S, E, F.wave);
            phase_fin(F, CW_FIN + 64 * 6);
        } else drain(F, 1, CW_FIN + 64 * 6, (unsigned)Geff);
        __syncthreads();
        ST_END(12); ST_BEGIN(11);
        drain(F, 1, -1, 0u);
        ST_END(11);
        if (BOTH(6)) GRID_BAR();
        ST_END(6);
    }
    if (IN(7)) {
        ST_BEGIN(7);
        _Pragma("unroll") for (int rep = (REP_PHASE == 7 ? 0 : 1); rep < 2; ++rep) {
        build_tables(F);
        const int ntiles = ((const LAS int*)(F.lds + POFF_OFF))[256];
        int Kdn = MOE_F8 ? DE / 2 : DE; asm volatile("" : "+s"(Kdn));
        pg8::Gemm g{(const pg8::bf16_t*)(F.ws + WS_H), (const pg8::bf16_t*)(F.ws + WS_WDT), MAXR, NSLOT * D, Kdn, F.ws};
        pg8::GroupedOrder<false> S{(const PG8_LAS unsigned short*)(F.lds + TS_OFF), ntiles, 8, F.G, F.vcu, nullptr, (PROBE_PIN && rep == 0) ? 1 : 0};
        pg8::EpiDown E{(pg8::bf16_t*)(F.ws + WS_XG), D, 8, (PROBE_NOSTORE && rep == 0) ? 1 : 0};
        if (DOWN_STAGGER) {
            const unsigned long long t0 = __builtin_amdgcn_s_memrealtime(), dl = (unsigned long long)(((unsigned)F.vcu >> 3) & 7u) * DOWN_STAGGER;
            while (__builtin_amdgcn_s_memrealtime() - t0 < dl) __builtin_amdgcn_s_sleep(4);
        }
        pg8::gemm_phase<pg8::EpiDown, pg8::GroupedOrder<false>, PG8_ALIGN, PG8_SP2>(F.lds + RING_OFF, g, S, E, F.wave);
        if (rep == 0) GRID_BAR(); }
        if (BOTH(7)) GRID_BAR();
        ST_END(7);
    }
    if (IN(8)) { ST_BEGIN(8); p7_combine(F); VM_WAIT(); ST_END(8); }
#undef IN
#undef BOTH
}

extern "C" void kernel_launch(void* const* d_in, const int* in_sizes, int n_in, void* d_out, int out_size, void* d_ws, size_t ws_size, hipStream_t stream) {
    static int grid = 0;
    if (grid == 0) {
        if (n_in != 20 || in_sizes[0] != M * D || out_size != M * D || ws_size < WS_END) { fprintf(stderr, "kernel_launch: unexpected shapes (n_in %d, in0 %d, out %d, ws %zu)\n", n_in, n_in > 0 ? in_sizes[0] : -1, out_size, ws_size); grid = -1; return; }
        int dev = 0, cus = 0, per_cu = 0;
        if (hipGetDevice(&dev) != hipSuccess || hipDeviceGetAttribute(&cus, hipDeviceAttributeMultiprocessorCount, dev) != hipSuccess) { grid = -1; return; }
        if (hipFuncSetAttribute((const void*)mk_fwd, hipFuncAttributeMaxDynamicSharedMemorySize, LDS_BYTES) != hipSuccess) { fprintf(stderr, "kernel_launch: hipFuncSetAttribute failed\n"); grid = -1; return; }
        if (hipOccupancyMaxActiveBlocksPerMultiprocessor(&per_cu, (const void*)mk_fwd, NWAVES * 64, LDS_BYTES) != hipSuccess || per_cu < 1) fprintf(stderr, "kernel_launch: occupancy query reports %d\n", per_cu);
        (void)hipGetLastError();
        grid = cus;
    }
    if (grid < 0) return;
    if (hipMemsetAsync((char*)d_ws + WS_CTL, 0, CTL_ZERO_BYTES, stream) != hipSuccess) return;
    Args a{};
    for (int i = 0; i < 20; ++i) a.in[i] = (const float*)d_in[i];
    a.out = (float*)d_out; a.ws = (unsigned char*)d_ws;
#if MK_PER_PHASE
    for (int p = 0; p < NPHASE; ++p) { a.ph_lo = p; a.ph_hi = p + 1; hipLaunchKernelGGL(mk_fwd, dim3(grid), dim3(NWAVES * 64), LDS_BYTES, stream, a); }
#else
    a.ph_lo = 0; a.ph_hi = NPHASE; hipLaunchKernelGGL(mk_fwd, dim3(grid), dim3(NWAVES * 64), LDS_BYTES, stream, a);
#endif
}
```

```cpp
#include <hip/hip_runtime.h>
#include <cstdio>
#include <cstdint>
#include <cmath>
#ifndef MOE_F8
#define MOE_F8 1
#endif
#ifndef Y_BF8
#define Y_BF8 2
#endif
namespace pg8 {
constexpr float F8_SX = 8.0f, F8_SWG = 64.0f, F8_SH = 8.0f, F8_SWD = 8.0f;
#define PG8_LAS __attribute__((address_space(3)))
typedef unsigned short bf16_t;
typedef short bf16x8 __attribute__((ext_vector_type(8)));
typedef float f32x4 __attribute__((ext_vector_type(4)));
typedef unsigned u32x4 __attribute__((ext_vector_type(4)));
constexpr int BM = 256, BK = 64, HALF = 128, HTB = HALF * BK * 2  , STAGE_BYTES = 8 * HTB, NXCD = 8, WGM = 8;
constexpr int VT_SLOT = STAGE_BYTES + 4096;
constexpr int WR_SLOT = STAGE_BYTES + 12288;

__host__ __device__ __forceinline__ int lds_byte(int r, int c) { const int st = (r >> 4) * 2 + (c >> 5), rr = r & 15, cc = c & 31, ob = rr * 64 + cc * 2; return st * 1024 + (ob ^ (((ob >> 9) & 1) << 5)); }
__host__ __device__ __forceinline__ void stage_rc(int b, int& R, int& C) { const int st = b / 1024, sb = b % 1024, swz = sb ^ (((sb >> 9) & 1) << 5); R = (st >> 1) * 16 + swz / 64; C = (st & 1) * 32 + (swz % 64) / 2; }
__host__ __device__ __forceinline__ int perm32(int rho) { const int n = rho >> 4, i = rho & 15; return 8 * (i >> 2) + 4 * n + (i & 3); }

__device__ __forceinline__ int lane_id_v() { int l; asm volatile("v_mbcnt_lo_u32_b32 %0, -1, 0\n\tv_mbcnt_hi_u32_b32 %0, -1, %0" : "=v"(l)); return l; }
typedef int rsrc4_t __attribute__((ext_vector_type(4)));
__device__ __forceinline__ rsrc4_t make_rsrc4(const void* base) { const unsigned long long b = (unsigned long long)base; rsrc4_t r; r.x = (int)(unsigned)b; r.y = (int)((unsigned)(b >> 32) & 0xffffu); r.z = 0x7ffffff0; r.w = 0x00020000; return r; }
__device__ __forceinline__ void bufdma16_asm(rsrc4_t rs, unsigned voff, unsigned soff, unsigned lds_dst) { unsigned keep;
    asm volatile("s_nop 4\n\ts_mov_b32 %0, m0\n\ts_mov_b32 m0, %4\n\ts_nop 0\n\tbuffer_load_dwordx4 %1, %2, %3 offen lds\n\ts_mov_b32 m0, %0" : "=&s"(keep) : "v"(voff), "s"(rs), "s"(soff), "s"(lds_dst) : "memory"); }
struct Unit { int pm, pn; };
struct Gemm { const bf16_t* A; const bf16_t* Bt; int M, N, K; const void* base; };

struct StaticOrder {
    static constexpr bool GATHER = false;
    int nM, nN, nwg, G, c;
    __host__ __device__ void init(int M, int N, int G_, int c_) { nM = M / BM; nN = N / BM; nwg = nM * nN; G = G_; c = c_; }
    __host__ __device__ bool next(int i, Unit& u) const {
        const long L = (long)i * G + c; if (L >= nwg) return false;
        int wgid = (int)L; { const int q = nwg / NXCD, r = nwg % NXCD, xcd = wgid % NXCD, off = wgid / NXCD; wgid = (xcd < r ? xcd * (q + 1) : r * (q + 1) + (xcd - r) * q) + off; }
        const int nig = WGM * nN, gid = wgid / nig, fm = gid * WGM, gsz = (nM - fm) < WGM ? (nM - fm) : WGM;
        u.pm = fm + ((wgid % nig) % gsz); u.pn = (wgid % nig) / gsz; return true;
    }
    __device__ __forceinline__ void a_ready(const Unit&) const {}
    __device__ __forceinline__ void done(const Unit&) const {}
};

__device__ __forceinline__ unsigned cvt_pk_bf16(float lo, float hi) { unsigned r; asm volatile("v_cvt_pk_bf16_f32 %0, %1, %2" : "=v"(r) : "v"(lo), "v"(hi)); return r; }
typedef float f32x2 __attribute__((ext_vector_type(2)));
__device__ __forceinline__ f32x2 gelu_pk(f32x2 v) {
    const f32x2 av = __builtin_elementwise_abs(v), d = av * 0.2316418882f + 1.0f;
    f32x2 t; t.x = __builtin_amdgcn_rcpf(d.x); t.y = __builtin_amdgcn_rcpf(d.y);
    f32x2 q = t * 0.5307027145f + (-0.7265760135f); q = q * t + 0.7107068705f; q = q * t + (-0.142248368f); q = q * t + 0.127414796f; q = q * t;
    const f32x2 s = (v * v) * (-0.72134752044f);
    f32x2 e; e.x = __builtin_amdgcn_exp2f(s.x); e.y = __builtin_amdgcn_exp2f(s.y);
    const f32x2 m = v * (q * e), r = v - m;
    f32x2 o; o.x = v.x < 0.f ? m.x : r.x; o.y = v.y < 0.f ? m.y : r.y; return o;
}

template <int ACT  > struct EpiBf16 {
    static constexpr bool PERM = true, AFTER_DRAIN = false, F8 = false; static_assert(ACT == 0 || ACT == 1, "EpiBf16: ACT is 0 (none) or 1 (gelu_pk)");
    bf16_t* O; int ldc; const float* bias; int split_cols; size_t split_stride; float scale0;
    __device__ __forceinline__ void operator()(const f32x4 (&acc)[2][2][4][2], const Unit& u, int wr, int wc, int fr, int fq) const {
        const int row0 = u.pm * BM + wr * 64 + fr; int colt = u.pn * BM; bf16_t* base = O;
        float sc = 1.f; if (split_cols) { const int t = colt / split_cols; base += (size_t)t * split_stride; colt -= t * split_cols; if (t == 0) sc = scale0; }
        const int col0 = colt + wc * 32 + 8 * fq, bcol0 = u.pn * BM + wc * 32 + 8 * fq;
        f32x4 bv[2][2];
#pragma unroll
        for (int bj = 0; bj < 2; ++bj)
#pragma unroll
            for (int n = 0; n < 2; ++n) bv[bj][n] = bias ? *(const f32x4*)(bias + bcol0 + bj * HALF + 4 * n) : (f32x4){0.f, 0.f, 0.f, 0.f};
#pragma unroll
        for (int ai = 0; ai < 2; ++ai)
#pragma unroll
            for (int m = 0; m < 4; ++m) { bf16_t* rowp = base + (size_t)(row0 + ai * HALF + m * 16) * ldc + col0;
#pragma unroll
                for (int bj = 0; bj < 2; ++bj) { f32x4 v0 = acc[ai][bj][m][0] + bv[bj][0], v1 = acc[ai][bj][m][1] + bv[bj][1];
                    if (ACT == 1) { f32x2 a = gelu_pk((f32x2){v0[0], v0[1]}), b = gelu_pk((f32x2){v0[2], v0[3]}), c = gelu_pk((f32x2){v1[0], v1[1]}), d = gelu_pk((f32x2){v1[2], v1[3]});
                        v0 = (f32x4){a.x, a.y, b.x, b.y}; v1 = (f32x4){c.x, c.y, d.x, d.y}; }
                    v0 = v0 * sc; v1 = v1 * sc; u32x4 w; w.x = cvt_pk_bf16(v0[0], v0[1]); w.y = cvt_pk_bf16(v0[2], v0[3]); w.z = cvt_pk_bf16(v1[0], v1[1]); w.w = cvt_pk_bf16(v1[2], v1[3]);
                    *(u32x4*)(rowp + bj * HALF) = w; } }
    }
};

__device__ __forceinline__ float silu_f(float g) { return g * __builtin_amdgcn_rcpf(1.0f + __builtin_amdgcn_exp2f(-1.4426950408889634f * g)); }
struct EpiResF32 {
    static constexpr bool PERM = true, AFTER_DRAIN = false, F8 = false;
    const float* x; bf16_t* y; const float* gate; int ldc; int rows_per_batch; int gate_stride; float alpha;
    __device__ __forceinline__ void operator()(const f32x4 (&acc)[2][2][4][2], const Unit& u, int wr, int wc, int fr, int fq) const {
        const int row0 = u.pm * BM + wr * 64 + fr, col0 = u.pn * BM + wc * 32 + 8 * fq;
        const float* gp = gate + (size_t)((u.pm * BM) / rows_per_batch) * gate_stride + col0;
        f32x4 gv[2][2];
#pragma unroll
        for (int bj = 0; bj < 2; ++bj)
#pragma unroll
            for (int n = 0; n < 2; ++n) gv[bj][n] = *(const f32x4*)(gp + bj * HALF + n * 4) + 1.0f;
#pragma unroll
        for (int ai = 0; ai < 2; ++ai)
#pragma unroll
            for (int m = 0; m < 4; ++m) { const size_t off = (size_t)(row0 + ai * HALF + m * 16) * ldc + col0;
#pragma unroll
                for (int bj = 0; bj < 2; ++bj) { const f32x4 x0 = *(const f32x4*)(x + off + bj * HALF), x1v = *(const f32x4*)(x + off + bj * HALF + 4);
                    const f32x4 v0 = x0 * alpha + gv[bj][0] * acc[ai][bj][m][0], v1 = x1v * alpha + gv[bj][1] * acc[ai][bj][m][1];
                    u32x4 w; w.x = cvt_pk_bf16(v0[0], v0[1]); w.y = cvt_pk_bf16(v0[2], v0[3]); w.z = cvt_pk_bf16(v1[0], v1[1]); w.w = cvt_pk_bf16(v1[2], v1[3]);
                    *(u32x4*)(y + off + bj * HALF) = w; } }
    }
};
struct EpiSwiGLU {
    static constexpr bool PERM = true, AFTER_DRAIN = false, F8 = (MOE_F8 != 0);
    bf16_t* H; const PG8_LAS float* wl; int ldh; int npn;
    __device__ __forceinline__ void operator()(const f32x4 (&acc)[2][2][4][2], const Unit& u, int wr, int wc, int fr, int fq) const {
        const int row0 = u.pm * BM + wr * 64 + fr, col0 = (u.pn % npn) * HALF + wc * 32 + 8 * fq;
        constexpr float inv = F8 ? 1.0f / (F8_SX * F8_SWG) : 1.0f;
#pragma unroll
        for (int ai = 0; ai < 2; ++ai)
#pragma unroll
            for (int m = 0; m < 4; ++m) { const int r = row0 + ai * HALF + m * 16; const float w8 = wl[(wr * 4 + wc) * 256 + wr * 64 + fr + ai * HALF + m * 16] * inv * (F8 ? F8_SH : 1.0f);
                const f32x4 g0 = acc[ai][0][m][0] * inv, g1 = acc[ai][0][m][1] * inv, u0 = acc[ai][1][m][0] * w8, u1 = acc[ai][1][m][1] * w8;
                float h[8];
#pragma unroll
                for (int q = 0; q < 4; ++q) { h[q] = silu_f(g0[q]) * u0[q]; h[4 + q] = silu_f(g1[q]) * u1[q]; }
                if (F8) {
                    typedef unsigned u32x2 __attribute__((ext_vector_type(2)));
                    if (F8_SH > 8.0f) {
#pragma unroll
                        for (int q = 0; q < 8; ++q) h[q] = __builtin_fminf(__builtin_fmaxf(h[q], -440.0f), 440.0f); }
                    int a = __builtin_amdgcn_cvt_pk_fp8_f32(h[0], h[1], 0, false); a = __builtin_amdgcn_cvt_pk_fp8_f32(h[2], h[3], a, true);
                    int b = __builtin_amdgcn_cvt_pk_fp8_f32(h[4], h[5], 0, false); b = __builtin_amdgcn_cvt_pk_fp8_f32(h[6], h[7], b, true);
                    u32x2 w; w.x = (unsigned)a; w.y = (unsigned)b; *(u32x2*)((unsigned char*)H + (size_t)r * ldh + col0) = w;
                } else {
                    u32x4 w; w.x = cvt_pk_bf16(h[0], h[1]); w.y = cvt_pk_bf16(h[2], h[3]); w.z = cvt_pk_bf16(h[4], h[5]); w.w = cvt_pk_bf16(h[6], h[7]);
                    *(u32x4*)(H + (size_t)r * ldh + col0) = w; } }
    }
};
struct EpiDown {
    static constexpr int PERM = Y_BF8 ? 2 : 1; static constexpr bool AFTER_DRAIN = false, F8 = (MOE_F8 != 0);
    bf16_t* Y; int ldc; int npn; int nostore;
    __device__ __forceinline__ void operator()(const f32x4 (&acc)[2][2][4][2], const Unit& u, int wr, int wc, int fr, int fq) const {
        const int row0 = u.pm * BM + wr * 64 + fr;
        if (Y_BF8) {
            const int col0 = (u.pn % npn) * BM + wc * 64 + 16 * fq;
#pragma unroll
            for (int ai = 0; ai < 2; ++ai)
#pragma unroll
                for (int m = 0; m < 4; ++m) { const int r = row0 + ai * HALF + m * 16; u32x4 w;
#pragma unroll
                    for (int bj = 0; bj < 2; ++bj)
#pragma unroll
                        for (int n = 0; n < 2; ++n) { const f32x4 v = acc[ai][bj][m][n] * (F8 ? 1.0f / (F8_SH * F8_SWD) : 1.0f); int a;
                            if (Y_BF8 == 2) { constexpr float ys = F8 ? 64.0f / (F8_SH * F8_SWD) : 64.0f; f32x4 sv = acc[ai][bj][m][n]; if (ys != 1.0f) sv = sv * ys;
#pragma unroll
                                for (int q = 0; q < 4; ++q) sv[q] = __builtin_amdgcn_fmed3f(sv[q], -440.0f, 440.0f);
                                a = __builtin_amdgcn_cvt_pk_fp8_f32(sv[0], sv[1], 0, false); a = __builtin_amdgcn_cvt_pk_fp8_f32(sv[2], sv[3], a, true);
                            } else { a = __builtin_amdgcn_cvt_pk_bf8_f32(v[0], v[1], 0, false); a = __builtin_amdgcn_cvt_pk_bf8_f32(v[2], v[3], a, true); }
                            w[2 * bj + n] = (unsigned)a; }
                    if (!nostore || w.x == 0x12345678u) *(u32x4*)((unsigned char*)Y + (size_t)r * ldc + col0) = w; }
        } else {
            const int col0 = (u.pn % npn) * BM + wc * 32 + 8 * fq;
#pragma unroll
            for (int ai = 0; ai < 2; ++ai)
#pragma unroll
                for (int m = 0; m < 4; ++m) { const int r = row0 + ai * HALF + m * 16;
#pragma unroll
                    for (int bj = 0; bj < 2; ++bj) { const f32x4 v0 = acc[ai][bj][m][0] * (F8 ? 1.0f / (F8_SH * F8_SWD) : 1.0f), v1 = acc[ai][bj][m][1] * (F8 ? 1.0f / (F8_SH * F8_SWD) : 1.0f);
                        u32x4 w; w.x = cvt_pk_bf16(v0[0], v0[1]); w.y = cvt_pk_bf16(v0[2], v0[3]); w.z = cvt_pk_bf16(v1[0], v1[1]); w.w = cvt_pk_bf16(v1[2], v1[3]);
                        if (!nostore || w.x == 0x12345678u) *(u32x4*)(Y + (size_t)r * ldc + col0 + bj * HALF) = w; } }
        }
    }
};
template <bool GATHER_> struct GroupedOrder {
    static constexpr bool GATHER = GATHER_;
    const PG8_LAS unsigned short* tslot; int ntiles, npn, G, c; const unsigned* vtab; int pin = 0; const float* wrow_g = nullptr;
    __device__ __forceinline__ bool next(int i, Unit& u) const {
        const int L = i * G + c; if (L >= ntiles * npn) return false;
        const int t = L / npn, p = L - t * npn; u.pm = t; u.pn = (int)tslot[t] * npn + p; if (pin) { u.pm = c & 3; u.pn = c & 7; } return true;
    }
    __device__ __forceinline__ void a_ready(const Unit&) const {}
    __device__ __forceinline__ void done(const Unit&) const {}
};


template <class Epi, class Sched, bool ALIGN_EPI = false, bool SP2 = false>
__device__ __forceinline__ void gemm_phase(PG8_LAS unsigned char* lds, const Gemm g, const Sched& S, const Epi& E, const int wid) {
    const int lane = lane_id_v(), tid = wid * 64 + lane, wr = wid >> 2, wc = wid & 3, fr = lane & 15, fq = lane >> 4;
    const int K = g.K, nt = K / BK;
    unsigned voffA[2], voffA1[2], voffB[2];
#pragma unroll
    for (int i = 0; i < 2; ++i) { int R, C; stage_rc(tid * 16 + i * 8192, R, C); const int rho = R & 31;
        const int Rb = ((int)Epi::PERM == 2) ? (64 * (R >> 5) + 16 * ((rho & 15) >> 2) + 4 * (rho >> 4) + (rho & 3)) : (Epi::PERM ? ((R & ~31) + perm32(rho)) : R);
        voffA[i] = (unsigned)(R * K + C) * 2u; voffA1[i] = voffA[i] + (unsigned)(HALF * K * 2); voffB[i] = (unsigned)(Rb * K + C) * 2u; }
    const size_t kstep = (size_t)(BK * 2);
    const size_t hstep = (size_t)HALF * K * 2;
    const size_t tstep = 2 * hstep;
    const size_t bh1 = ((int)Epi::PERM == 2) ? (size_t)8 * K * 2 : hstep;
    const unsigned ldsw = (unsigned)wid * 1024u;
    const int aoff = lds_byte(wr * 64 + fr, fq * 8), boff = lds_byte(wc * 32 + fr, fq * 8);
#define PG8_SA(b, h) (((b) * 2 + (h)) * HTB)
#define PG8_SB(b, h) ((4 + (b) * 2 + (h)) * HTB)
    const __amdgpu_buffer_rsrc_t rs_ = __builtin_amdgcn_make_buffer_rsrc((void*)g.base, (short)0, 0x7ffffff0, 0x00020000);
#define PG8_STAGE(bufoff, gbase, voff) do { _Pragma("unroll") for (int _i = 0; _i < 2; ++_i) \
        __builtin_amdgcn_raw_ptr_buffer_load_lds(rs_, (PG8_LAS unsigned*)(lds + (bufoff) + ldsw + _i * 8192), 16, (int)(voff)[_i], (int)((const char*)(gbase) - (const char*)g.base), 0, 0); } while (0)
#define PG8_STAGE_A1(bufoff, gbase) do { if constexpr (Sched::GATHER) PG8_STAGE(bufoff, gbase, voffA1); else PG8_STAGE(bufoff, (gbase) + hstep, voffA); } while (0)
#define PG8_LDA(dst, b, h) do { if constexpr (Epi::F8) { _Pragma("unroll") for (int m = 0; m < 4; ++m) { const i32x4_ l0_ = *(const PG8_LAS i32x4_*)(lds + PG8_SA(b, h) + aoff + m * 2048), l1_ = *(const PG8_LAS i32x4_*)(lds + PG8_SA(b, h) + aoff + m * 2048 + 1024); dst##8[m] = __builtin_shufflevector(l0_, l1_, 0, 1, 2, 3, 4, 5, 6, 7); } } \
        else { _Pragma("unroll") for (int m = 0; m < 4; ++m) _Pragma("unroll") for (int k = 0; k < 2; ++k) dst[m][k] = *(const PG8_LAS bf16x8*)(lds + PG8_SA(b, h) + aoff + m * 2048 + k * 1024); } } while (0)
#define PG8_LDB(dst, b, h) do { if constexpr (Epi::F8) { _Pragma("unroll") for (int n = 0; n < 2; ++n) { const i32x4_ l0_ = *(const PG8_LAS i32x4_*)(lds + PG8_SB(b, h) + boff + n * 2048), l1_ = *(const PG8_LAS i32x4_*)(lds + PG8_SB(b, h) + boff + n * 2048 + 1024); dst##8[n] = __builtin_shufflevector(l0_, l1_, 0, 1, 2, 3, 4, 5, 6, 7); } } \
        else { _Pragma("unroll") for (int n = 0; n < 2; ++n) _Pragma("unroll") for (int k = 0; k < 2; ++k) dst[n][k] = *(const PG8_LAS bf16x8*)(lds + PG8_SB(b, h) + boff + n * 2048 + k * 1024); } } while (0)
#define PG8_MMA(ai, bj, At, Bt) do { __builtin_amdgcn_s_setprio(1); \
        if constexpr (Epi::F8) { _Pragma("unroll") for (int m = 0; m < 4; ++m) _Pragma("unroll") for (int n = 0; n < 2; ++n) \
                acc[ai][bj][m][n] = __builtin_amdgcn_mfma_scale_f32_16x16x128_f8f6f4(Bt##8[n], At##8[m], acc[ai][bj][m][n], 0, 0, 0, 0, 0, 0); \
        } else { _Pragma("unroll") for (int m = 0; m < 4; ++m) _Pragma("unroll") for (int n = 0; n < 2; ++n) _Pragma("unroll") for (int k = 0; k < 2; ++k) \
        acc[ai][bj][m][n] = __builtin_amdgcn_mfma_f32_16x16x32_bf16(Bt[n][k], At[m][k], acc[ai][bj][m][n], 0, 0, 0); } __builtin_amdgcn_s_setprio(0); } while (0)
#define PG8_MMA_Z(ai, bj, At, Bt) do { __builtin_amdgcn_s_setprio(1); const f32x4 z_ = {0.f, 0.f, 0.f, 0.f}; \
        if constexpr (Epi::F8) { _Pragma("unroll") for (int m = 0; m < 4; ++m) _Pragma("unroll") for (int n = 0; n < 2; ++n) \
                acc[ai][bj][m][n] = __builtin_amdgcn_mfma_scale_f32_16x16x128_f8f6f4(Bt##8[n], At##8[m], z_, 0, 0, 0, 0, 0, 0); \
        } else { _Pragma("unroll") for (int m = 0; m < 4; ++m) _Pragma("unroll") for (int n = 0; n < 2; ++n) { \
        acc[ai][bj][m][n] = __builtin_amdgcn_mfma_f32_16x16x32_bf16(Bt[n][0], At[m][0], z_, 0, 0, 0); acc[ai][bj][m][n] = __builtin_amdgcn_mfma_f32_16x16x32_bf16(Bt[n][1], At[m][1], acc[ai][bj][m][n], 0, 0, 0); } } __builtin_amdgcn_s_setprio(0); } while (0)
#define PG8_WAIT_V(n) asm volatile("s_waitcnt vmcnt(" #n ")" ::: "memory")
#define PG8_WAIT_L(n) asm volatile("s_waitcnt lgkmcnt(" #n ")" ::: "memory")
#define PG8_BAR __builtin_amdgcn_s_barrier()
#define PG8_SCHED __builtin_amdgcn_sched_barrier(0)
    Unit cur, nxt; int ui = 0;
    if (!S.next(0, cur)) return;
    f32x4 acc[2][2][4][2];
#pragma unroll
    for (int a = 0; a < 2; ++a)
#pragma unroll
        for (int b = 0; b < 2; ++b)
#pragma unroll
            for (int m = 0; m < 4; ++m)
#pragma unroll
                for (int n = 0; n < 2; ++n) { acc[a][b][m][n] = (f32x4){0.f, 0.f, 0.f, 0.f}; if constexpr (Epi::F8 && !SP2) asm volatile("" : "+v"(acc[a][b][m][n])); }
    typedef int i32x4_ __attribute__((ext_vector_type(4))); typedef int i32x8_ __attribute__((ext_vector_type(8)));
    bf16x8 At[4][2], B0[2][2], B1[2][2]; i32x8_ At8[4], B08[2], B18[2];
    const char* cA = Sched::GATHER ? (const char*)g.A : (const char*)g.A + (size_t)cur.pm * tstep; const char* cB = (const char*)g.Bt + (size_t)cur.pn * tstep;
    S.a_ready(cur);
    if constexpr (Sched::GATHER) {
        static_assert(SP2, "gather: SP2 loop only");
        __builtin_amdgcn_global_load_lds((const unsigned*)(S.vtab + ((size_t)0 * 512 + tid) * 4), (PG8_LAS unsigned*)(lds + VT_SLOT + wid * 1024), 16, 0, 0);
        PG8_WAIT_V(0);
        const u32x4 e4 = *(const PG8_LAS u32x4*)(lds + VT_SLOT + tid * 16); voffA[0] = e4.x; voffA[1] = e4.y; voffA1[0] = e4.z; voffA1[1] = e4.w;
    }
    if constexpr (SP2) {
        PG8_STAGE(PG8_SB(0, 0), cB, voffB); PG8_STAGE(PG8_SB(0, 1), cB + bh1, voffB); PG8_STAGE(PG8_SA(0, 0), cA, voffA); PG8_STAGE_A1(PG8_SA(0, 1), cA);
        if (wr == 1) PG8_BAR;
        PG8_WAIT_V(2); PG8_BAR;
        PG8_STAGE(PG8_SB(1, 0), cB + kstep, voffB); PG8_STAGE(PG8_SA(1, 0), cA + kstep, voffA); PG8_STAGE(PG8_SB(1, 1), cB + bh1 + kstep, voffB);
        PG8_WAIT_V(6); PG8_BAR;
    } else {
        PG8_STAGE(PG8_SB(0, 0), cB, voffB); PG8_STAGE(PG8_SA(0, 0), cA, voffA); PG8_STAGE(PG8_SB(0, 1), cB + hstep, voffB); PG8_STAGE(PG8_SA(0, 1), cA + hstep, voffA);
        if (wr == 1) PG8_BAR;
        PG8_WAIT_V(4); PG8_BAR;
        PG8_STAGE(PG8_SB(1, 0), cB + kstep, voffB); PG8_STAGE(PG8_SA(1, 0), cA + kstep, voffA); PG8_STAGE(PG8_SB(1, 1), cB + hstep + kstep, voffB);
        PG8_WAIT_V(6); PG8_BAR;
    }
    for (;;) {
        const bool has_next = S.next(ui + 1, nxt);
        const char* nA = (has_next && !Sched::GATHER) ? (const char*)g.A + (size_t)nxt.pm * tstep : cA; const char* nB = has_next ? (const char*)g.Bt + (size_t)nxt.pn * tstep : cB;
        for (int t = 0; t < nt; t += 2) {
            const bool last = (t == nt - 2);
            const char* a1 = cA + (size_t)(t + 1) * kstep;
            const char* a2 = last ? nA : cA + (size_t)(t + 2) * kstep; const char* b2 = last ? nB : cB + (size_t)(t + 2) * kstep;
            const char* a3 = a2 + kstep; const char* b3 = b2 + kstep;
            if (last && has_next) S.a_ready(nxt);
            if constexpr (SP2) {
            if constexpr (Sched::GATHER) { if (t == 0)
                bufdma16_asm(make_rsrc4(g.base), (unsigned)lane_id_v() * 16u, (unsigned)__builtin_amdgcn_readfirstlane((int)((const char*)(S.wrow_g + (size_t)cur.pm * 256) - (const char*)g.base)), (unsigned)__builtin_amdgcn_readfirstlane((int)(size_t)(lds + WR_SLOT + wid * 1024))); }
            if constexpr (Sched::GATHER) { if (t == 0 && has_next)
                __builtin_amdgcn_global_load_lds((const unsigned*)(S.vtab + ((size_t)(ui + 1) * 512 + tid) * 4), (PG8_LAS unsigned*)(lds + VT_SLOT + wid * 1024), 16, 0, 0); }
            PG8_LDB(B0, 0, 0); PG8_LDB(B1, 0, 1); PG8_SCHED; PG8_LDA(At, 0, 0); PG8_STAGE_A1(PG8_SA(1, 1), a1);
            PG8_WAIT_V(8); PG8_WAIT_L(0); PG8_BAR; if (t == 0) { PG8_MMA_Z(0, 0, At, B0); PG8_MMA_Z(0, 1, At, B1); } else { PG8_MMA(0, 0, At, B0); PG8_MMA(0, 1, At, B1); } PG8_BAR; PG8_SCHED;
            if constexpr (Sched::GATHER) { if (last && has_next) {
                const u32x4 e4 = *(const PG8_LAS u32x4*)(lds + VT_SLOT + tid * 16); voffA[0] = e4.x; voffA[1] = e4.y; voffA1[0] = e4.z; voffA1[1] = e4.w; } }
            PG8_LDA(At, 0, 1); PG8_STAGE(PG8_SB(0, 0), b2, voffB); PG8_STAGE(PG8_SB(0, 1), b2 + bh1, voffB); PG8_STAGE(PG8_SA(0, 0), a2, voffA);
            PG8_WAIT_V(8); PG8_WAIT_L(0); PG8_BAR; if (t == 0) { PG8_MMA_Z(1, 0, At, B0); PG8_MMA_Z(1, 1, At, B1); } else { PG8_MMA(1, 0, At, B0); PG8_MMA(1, 1, At, B1); } PG8_BAR; PG8_SCHED;
            PG8_LDB(B0, 1, 0); PG8_LDB(B1, 1, 1); PG8_SCHED; PG8_LDA(At, 1, 0); PG8_STAGE_A1(PG8_SA(0, 1), a2);
            PG8_WAIT_V(8); PG8_WAIT_L(0); PG8_BAR; PG8_MMA(0, 0, At, B0); PG8_MMA(0, 1, At, B1); PG8_BAR; PG8_SCHED;
            PG8_LDA(At, 1, 1); PG8_STAGE(PG8_SB(1, 0), b3, voffB); PG8_STAGE(PG8_SB(1, 1), b3 + bh1, voffB); PG8_STAGE(PG8_SA(1, 0), a3, voffA);
            PG8_WAIT_V(8); PG8_WAIT_L(0); PG8_BAR; PG8_MMA(1, 0, At, B0); PG8_MMA(1, 1, At, B1); PG8_BAR; PG8_SCHED;
            } else {
            PG8_LDB(B0, 0, 0); PG8_SCHED; PG8_LDA(At, 0, 0); PG8_STAGE(PG8_SA(1, 1), a1 + hstep, voffA);
            PG8_WAIT_L(8); PG8_BAR; PG8_WAIT_L(0); PG8_MMA(0, 0, At, B0); PG8_BAR; PG8_SCHED;
            PG8_LDB(B1, 0, 1); PG8_STAGE(PG8_SB(0, 0), b2, voffB);
            PG8_BAR; PG8_WAIT_L(0); PG8_MMA(0, 1, At, B1); PG8_BAR;
            PG8_LDA(At, 0, 1); PG8_STAGE(PG8_SA(0, 0), a2, voffA);
            PG8_BAR; PG8_WAIT_L(0); PG8_MMA(1, 0, At, B0); PG8_BAR; PG8_SCHED;
            PG8_STAGE(PG8_SB(0, 1), b2 + hstep, voffB);
            PG8_WAIT_V(6); PG8_BAR; PG8_MMA(1, 1, At, B1); PG8_BAR;
            PG8_LDB(B0, 1, 0); PG8_SCHED; PG8_LDA(At, 1, 0); PG8_STAGE(PG8_SA(0, 1), a2 + hstep, voffA);
            PG8_WAIT_L(8); PG8_BAR; PG8_WAIT_L(0); PG8_MMA(0, 0, At, B0); PG8_BAR; PG8_SCHED;
            PG8_LDB(B1, 1, 1); PG8_STAGE(PG8_SB(1, 0), b3, voffB);
            PG8_BAR; PG8_WAIT_L(0); PG8_MMA(0, 1, At, B1); PG8_BAR;
            PG8_LDA(At, 1, 1); PG8_STAGE(PG8_SA(1, 0), a3, voffA);
            PG8_BAR; PG8_WAIT_L(0); PG8_MMA(1, 0, At, B0); PG8_BAR; PG8_SCHED;
            PG8_STAGE(PG8_SB(1, 1), b3 + hstep, voffB);
            PG8_WAIT_V(6); PG8_BAR; PG8_MMA(1, 1, At, B1); PG8_BAR;
            }
        }
        if constexpr (ALIGN_EPI) { if (wr == 0) PG8_BAR; }
        if constexpr (!Epi::AFTER_DRAIN) { const int le_ = lane_id_v(); E(acc, cur, wr, wc, le_ & 15, le_ >> 4); S.done(cur); }
        if (!has_next) break;
        if constexpr (!SP2) {
#pragma unroll
        for (int a = 0; a < 2; ++a)
#pragma unroll
            for (int b = 0; b < 2; ++b)
#pragma unroll
                for (int m = 0; m < 4; ++m)
#pragma unroll
                    for (int n = 0; n < 2; ++n) acc[a][b][m][n] = (f32x4){0.f, 0.f, 0.f, 0.f}; }
        cur = nxt; cA = nA; cB = nB; ++ui;
        if constexpr (ALIGN_EPI) { if (wr == 1) PG8_BAR; }
    }
    PG8_WAIT_V(0);
    if constexpr (!ALIGN_EPI) { if (wr == 0) PG8_BAR; }
    PG8_BAR;
    if constexpr (Epi::AFTER_DRAIN) { E.fused(acc, cur, wr, wc, fr, fq, lds, wid, lane); S.done(cur); }
#undef PG8_SA
#undef PG8_SB
#undef PG8_STAGE
#undef PG8_LDA
#undef PG8_LDB
#undef PG8_MMA
#undef PG8_WAIT_V
#undef PG8_WAIT_L
#undef PG8_BAR
#undef PG8_SCHED
}
}

#ifndef PG8_SP2
#define PG8_SP2 true
#endif
#ifndef PG8_ALIGN
#define PG8_ALIGN true
#endif
#ifndef DOWN_STAGGER
#define DOWN_STAGGER 0
#endif
#ifndef CONV_NT
#define CONV_NT 1
#endif
#ifndef P5_MAIN_Q
#define P5_MAIN_Q 16
#endif
#ifndef P6_MIN_CONV
#define P6_MIN_CONV 0
#endif
#ifndef PROBE_STAMP
#define PROBE_STAMP -1
#endif
#ifndef PROBE_PIN
#define PROBE_PIN 0
#endif
#ifndef PROBE_NOSTORE
#define PROBE_NOSTORE 0
#endif
#ifndef REP_PHASE
#define REP_PHASE -1
#endif
#ifndef MK_PER_PHASE
#define MK_PER_PHASE 0
#endif

constexpr int NB = 2, SEQ = 4096, D = 2048, M = NB * SEQ;
constexpr int AW = 1024, NQH = 16, NKVH = 4, HD = 64, KVW = 256, CW = 1024, INW = 4608;
constexpr int COL_K = 1024, COL_V = 1280, COL_CB = 1536, COL_CC = 2560, COL_CH = 3584;
constexpr int NE = 64, TOPK = 8, DE = 512, NSLOT = NE + 1;
constexpr int MAXT = 32 + 256 + 64, MAXR = MAXT * 256;
constexpr float ALPHA = 1.189207115002721f;
constexpr float LN_EPS = 1e-5f, RSCALE = 2.5f;
constexpr int NWAVES = 8, NTHR = 512;
constexpr int KSL = 8;

constexpr size_t MiB = 1u << 20;
constexpr size_t WS_CTL = 0, CTL_ZERO_BYTES = 1 * MiB;
constexpr size_t WS_PART = 1 * MiB;
constexpr size_t WS_MODF = 2 * MiB;
constexpr size_t WS_WRT = 3 * MiB;
constexpr size_t WS_ROWTOK = 4 * MiB;
constexpr size_t WS_ROWW = 6 * MiB;
constexpr size_t WS_TOKSLOT = 8 * MiB;
constexpr size_t WS_WROW = 9 * MiB;
constexpr size_t WS_WINT = 10 * MiB;
constexpr size_t WS_WOUTT = 28 * MiB;
constexpr size_t WS_WGUT = 36 * MiB;
constexpr size_t WS_WDT = 296 * MiB;
constexpr size_t WS_X1 = 426 * MiB;
constexpr size_t WS_H = 490 * MiB;
constexpr size_t WS_XG = 578 * MiB;
constexpr size_t WS_HB = 610 * MiB;
constexpr size_t WS_PROJ = 642 * MiB;
constexpr size_t WS_MIX = 714 * MiB;
constexpr size_t WS_Y1 = 746 * MiB;
constexpr size_t WS_VTAB = 930 * MiB;
constexpr size_t WS_END = 946 * MiB;
static_assert(WS_XG + (size_t)MAXR * D * 2 <= WS_VTAB && WS_H + (size_t)MAXR * DE * 2 <= WS_XG && WS_Y1 + (size_t)M * D * 4 <= WS_VTAB, "ws map");
static_assert(WS_WGUT + (size_t)NSLOT * 1024 * D * 2 <= WS_WDT && WS_WDT + (size_t)NSLOT * D * DE * 2 <= WS_X1 && WS_X1 + (size_t)M * D * 4 <= WS_H, "ws map 2");
constexpr int CW_TMO = 0;
constexpr int CW_BAR = 4096;
constexpr int CW_Q = 8192;
constexpr int CW_FIN = 8448;
constexpr int CW_CNT = 16384;

constexpr int RING_OFF = 0, RING_BYTES = 131072;
constexpr int LDSCTL_OFF = RING_BYTES, MISC_OFF = LDSCTL_OFF + 320;
constexpr int TS_OFF = LDSCTL_OFF + 512;
constexpr int POFF_OFF = LDSCTL_OFF + 1280;
constexpr int LDS_BYTES = 155648;

#define GAS __attribute__((address_space(1)))
#define LAS __attribute__((address_space(3)))
typedef unsigned short bf16;
typedef unsigned v4u __attribute__((ext_vector_type(4)));
typedef unsigned v2u __attribute__((ext_vector_type(2)));
typedef float f32x4 __attribute__((ext_vector_type(4)));
typedef short bf16x8 __attribute__((ext_vector_type(8)));
typedef GAS unsigned gu32;
#define RLX_AGENT __ATOMIC_RELAXED, __HIP_MEMORY_SCOPE_AGENT
#define LDS_WAIT() asm volatile("s_waitcnt lgkmcnt(0)" ::: "memory")
#define VM_WAIT() asm volatile("s_waitcnt vmcnt(0)" ::: "memory")
__device__ __forceinline__ unsigned f2bf(float f) { unsigned u = __builtin_bit_cast(unsigned, f); return (u + 0x7fffu + ((u >> 16) & 1u)) >> 16; }
__device__ __forceinline__ unsigned pk2(float lo, float hi) { return f2bf(lo) | (f2bf(hi) << 16); }
__device__ __forceinline__ float bf2f(unsigned h) { return __builtin_bit_cast(float, h << 16); }
__device__ __forceinline__ float bflo(unsigned w) { return __builtin_bit_cast(float, w << 16); }
__device__ __forceinline__ float bfhi(unsigned w) { return __builtin_bit_cast(float, w & 0xffff0000u); }

#define XB_TMO      128
#define XB_XCNT(j)  (256  + 64 * (j))
#define XB_XSUB(j)  (1280 + 64 * (j))
#define XB_XGEN(j)  (2304 + 64 * (j))
#define XB_TOP      3328
#define XB_TOPGEN   3392
#define XCD_BAR_WORDS 3456
#define XB_SPIN_CAP (1u << 18)
__device__ __forceinline__ unsigned xb_ld(unsigned* p)              { return __hip_atomic_load(p, __ATOMIC_RELAXED, __HIP_MEMORY_SCOPE_AGENT); }
__device__ __forceinline__ unsigned xb_add(unsigned* p, unsigned v) { return __hip_atomic_fetch_add(p, v, __ATOMIC_RELAXED, __HIP_MEMORY_SCOPE_AGENT); }
__device__ __forceinline__ unsigned xb_xcc_id() { return (unsigned)__builtin_amdgcn_s_getreg((3 << 11) | 20) & 0xFu; }
#define XB_SPIN(cond, bar) do { unsigned _sp = 0; while (cond) { __builtin_amdgcn_s_sleep(1); \
    if ((++_sp & 255u) == 0u) { if (xb_ld(&(bar)[XB_TMO])) break; if (_sp > XB_SPIN_CAP) { atomicAdd(&(bar)[XB_TMO], 1u); break; } } } } while (0)
struct XcdBarrier { unsigned* bar; unsigned x; volatile LAS unsigned* st; };
__device__ __forceinline__ XcdBarrier xcd_barrier_post(unsigned* bar, volatile LAS unsigned* st) {
    XcdBarrier b; b.bar = bar; b.x = xb_xcc_id(); b.st = st;
    if (threadIdx.x == 0) (void)xb_add(&bar[XB_XCNT(b.x)], 1u);
    return b;
}
__device__ __forceinline__ void xcd_barrier_complete(unsigned* bar, unsigned x, unsigned& nloc, unsigned& nx) {
    const unsigned G = gridDim.x * gridDim.y * gridDim.z;
    unsigned sum, cnt, mine, sp = 0u;
    for (;;) {
        sum = 0u; cnt = 0u; mine = 0u;
#pragma unroll
        for (unsigned j = 0; j < 16; ++j) { const unsigned c = xb_ld(&bar[XB_XCNT(j)]); sum += c; cnt += (c > 0u) ? 1u : 0u; mine = (j == x) ? c : mine; }
        if (sum == G) break;
        __builtin_amdgcn_s_sleep(1);
        if ((++sp & 255u) == 0u) { if (xb_ld(&bar[XB_TMO])) break; if (sp > XB_SPIN_CAP) { atomicAdd(&bar[XB_TMO], 1u); break; } }
    }
    nloc = mine > 0u ? mine : 1u; nx = cnt > 0u ? cnt : 1u;
}
__device__ __forceinline__ void xcd_barrier(const XcdBarrier& b) {
    asm volatile("s_waitcnt vmcnt(0)" ::: "memory");
    __syncthreads();
    if (threadIdx.x == 0) {
        unsigned* bar = b.bar;
        __builtin_amdgcn_s_waitcnt(0);
        unsigned nloc = b.st[0], nx = b.st[1];
        if (nloc == 0u) { xcd_barrier_complete(bar, b.x, nloc, nx); b.st[0] = nloc; b.st[1] = nx; }
        const unsigned old = xb_add(&bar[XB_XSUB(b.x)], 1u);
        const unsigned gen = old / nloc;
        if (old + 1u == (gen + 1u) * nloc) {
            __builtin_amdgcn_fence(__ATOMIC_RELEASE, "agent");
            asm volatile("s_waitcnt vmcnt(0)" ::: "memory");
            const unsigned og = xb_add(&bar[XB_TOP], 1u);
            const unsigned tg = og / nx;
            if (og + 1u == (tg + 1u) * nx) xb_add(&bar[XB_TOPGEN], 1u);
            else XB_SPIN(xb_ld(&bar[XB_TOPGEN]) == tg, bar);
            __builtin_amdgcn_fence(__ATOMIC_ACQUIRE, "agent");
            xb_add(&bar[XB_XGEN(b.x)], 1u);
            asm volatile("s_waitcnt vmcnt(0)" ::: "memory");
        } else {
            XB_SPIN(xb_ld(&bar[XB_XGEN(b.x)]) == gen, bar);
            __builtin_amdgcn_fence(__ATOMIC_ACQUIRE, "agent");
            asm volatile("s_waitcnt vmcnt(0)" ::: "memory");
        }
    }
    __syncthreads();
}

struct Frame {
    LAS unsigned char* lds;
    volatile LAS unsigned* MISC;
    gu32* ctl;
    int tid, lane, wave;
    int vcu, G;
    unsigned char* ws;
    const float *x, *c, *w_mod, *b_mod, *w_in, *conv_w, *sinks, *w_out, *ln1_g, *ln1_b, *w_router, *router_bias, *w_gate, *w_up, *w_down, *ws_gate, *ws_up, *ws_down, *ln2_g, *ln2_b;
    float* out;
};
__device__ __forceinline__ float wave_sum(float v) {
#pragma unroll
    for (int o = 1; o < 64; o <<= 1) v += __shfl_xor(v, o);
    return v;
}

__device__ __forceinline__ void p0_transpose_item(const float* src, int ldw, bf16* dst, int ldt, LAS float* scr, int lane) {
    { const float* sp = src + (size_t)(lane >> 5) * ldw + (lane & 31); LAS float* dp = scr + (lane >> 5) * 33 + (lane & 31);
#pragma unroll 1
      for (int h = 0; h < 2; ++h) { float tv[16];
#pragma unroll
        for (int i = 0; i < 16; ++i) tv[i] = sp[(size_t)(2 * i) * ldw];
#pragma unroll
        for (int i = 0; i < 16; ++i) dp[(2 * i) * 33] = tv[i];
        sp += (size_t)32 * ldw; dp += 32 * 33; } }
    LDS_WAIT(); asm volatile("" ::: "memory");
    const int c = lane & 7;
#pragma unroll
    for (int j = 0; j < 4; ++j) { const int n = (lane >> 3) + 8 * j; const LAS float* s = scr + (8 * c) * 33 + n;
        v4u o; o.x = pk2(s[0 * 33], s[1 * 33]); o.y = pk2(s[2 * 33], s[3 * 33]); o.z = pk2(s[4 * 33], s[5 * 33]); o.w = pk2(s[6 * 33], s[7 * 33]);
        *(GAS v4u*)(dst + (size_t)n * ldt + 8 * c) = o; }
    LDS_WAIT(); asm volatile("" ::: "memory");
}
constexpr int SCRP = 136;
__device__ __forceinline__ void conv64(const float* src, int ldw, bf16* dst, int ldt, LAS unsigned char* scr, int lane) {
    const int kr = lane >> 4, nq = lane & 15;
    const float* sp = src + (size_t)kr * ldw + 4 * nq;
    f32x4 tv[16];
#pragma unroll
    for (int i = 0; i < 16; ++i) tv[i] = CONV_NT ? __builtin_nontemporal_load((const GAS f32x4*)(sp + (size_t)(4 * i) * ldw)) : *(const GAS f32x4*)(sp + (size_t)(4 * i) * ldw);
#pragma unroll
    for (int i = 0; i < 16; ++i) { v2u w; w.x = pk2(tv[i].x, tv[i].y); w.y = pk2(tv[i].z, tv[i].w); *(LAS v2u*)(scr + (4 * i + kr) * SCRP + 8 * nq) = w; }
    LDS_WAIT(); asm volatile("" ::: "memory");
    const int c = lane & 7;
#pragma unroll
    for (int j = 0; j < 8; ++j) { const int n = (lane >> 3) + 8 * j; const LAS unsigned short* p = (const LAS unsigned short*)(scr + (8 * c) * SCRP + 2 * n);
        v4u o; o.x = (unsigned)p[0] | ((unsigned)p[SCRP / 2] << 16); o.y = (unsigned)p[2 * (SCRP / 2)] | ((unsigned)p[3 * (SCRP / 2)] << 16);
        o.z = (unsigned)p[4 * (SCRP / 2)] | ((unsigned)p[5 * (SCRP / 2)] << 16); o.w = (unsigned)p[6 * (SCRP / 2)] | ((unsigned)p[7 * (SCRP / 2)] << 16);
        if (CONV_NT) __builtin_nontemporal_store(o, (GAS v4u*)(dst + (size_t)n * ldt + 8 * c)); else *(GAS v4u*)(dst + (size_t)n * ldt + 8 * c) = o; }
    LDS_WAIT(); asm volatile("" ::: "memory");
}
constexpr int SCRP8 = 68;
__device__ __forceinline__ void conv64_f8(const float* src, int ldw, unsigned char* dst, int ldt, LAS unsigned char* scr, int lane, float scale) {
    const int kr = lane >> 4, nq = lane & 15;
    const float* sp = src + (size_t)kr * ldw + 4 * nq;
    f32x4 tv[16];
#pragma unroll
    for (int i = 0; i < 16; ++i) tv[i] = CONV_NT ? __builtin_nontemporal_load((const GAS f32x4*)(sp + (size_t)(4 * i) * ldw)) : *(const GAS f32x4*)(sp + (size_t)(4 * i) * ldw);
#pragma unroll
    for (int i = 0; i < 16; ++i) { const f32x4 t = tv[i] * scale; int a = __builtin_amdgcn_cvt_pk_fp8_f32(t.x, t.y, 0, false); a = __builtin_amdgcn_cvt_pk_fp8_f32(t.z, t.w, a, true);
        *(LAS unsigned*)(scr + (4 * i + kr) * SCRP8 + 4 * nq) = (unsigned)a; }
    LDS_WAIT(); asm volatile("" ::: "memory");
    const int c = lane & 3;
#pragma unroll
    for (int j = 0; j < 4; ++j) { const int n = (lane >> 2) + 16 * j; const LAS unsigned char* p = scr + (16 * c) * SCRP8 + n;
        unsigned o[4];
#pragma unroll
        for (int q = 0; q < 4; ++q) o[q] = (unsigned)p[(4 * q) * SCRP8] | ((unsigned)p[(4 * q + 1) * SCRP8] << 8) | ((unsigned)p[(4 * q + 2) * SCRP8] << 16) | ((unsigned)p[(4 * q + 3) * SCRP8] << 24);
        v4u ov; ov.x = o[0]; ov.y = o[1]; ov.z = o[2]; ov.w = o[3];
        if (CONV_NT) __builtin_nontemporal_store(ov, (GAS v4u*)(dst + (size_t)n * ldt + 16 * c)); else *(GAS v4u*)(dst + (size_t)n * ldt + 16 * c) = ov; }
    LDS_WAIT(); asm volatile("" ::: "memory");
}
__device__ __forceinline__ void p0_transpose_item_hilo(const float* src, int ldw, bf16* dhi, bf16* dlo, int ldt, LAS float* scr, int lane) {
    { const float* sp = src + (size_t)(lane >> 5) * ldw + (lane & 31); LAS float* dp = scr + (lane >> 5) * 33 + (lane & 31);
#pragma unroll 1
      for (int h = 0; h < 2; ++h) { float tv[16];
#pragma unroll
        for (int i = 0; i < 16; ++i) tv[i] = sp[(size_t)(2 * i) * ldw];
#pragma unroll
        for (int i = 0; i < 16; ++i) dp[(2 * i) * 33] = tv[i];
        sp += (size_t)32 * ldw; dp += 32 * 33; } }
    LDS_WAIT(); asm volatile("" ::: "memory");
    const int c = lane & 7;
#pragma unroll
    for (int j = 0; j < 4; ++j) { const int n = (lane >> 3) + 8 * j; const LAS float* s = scr + (8 * c) * 33 + n;
        float v[8]; unsigned h[8], l[8];
#pragma unroll
        for (int q = 0; q < 8; ++q) { v[q] = s[q * 33]; h[q] = f2bf(v[q]); l[q] = f2bf(v[q] - bf2f(h[q])); }
        v4u o; o.x = h[0] | (h[1] << 16); o.y = h[2] | (h[3] << 16); o.z = h[4] | (h[5] << 16); o.w = h[6] | (h[7] << 16);
        *(GAS v4u*)(dhi + (size_t)n * ldt + 8 * c) = o;
        o.x = l[0] | (l[1] << 16); o.y = l[2] | (l[3] << 16); o.z = l[4] | (l[5] << 16); o.w = l[6] | (l[7] << 16);
        *(GAS v4u*)(dlo + (size_t)n * ldt + 8 * c) = o; }
    LDS_WAIT(); asm volatile("" ::: "memory");
}
constexpr int I_G = (D / 64) * (DE / 64), I_D = (DE / 64) * (D / 64);
constexpr int QB_ITEMS = NE * 2 * I_G, QC_ITEMS = NE * I_D, CONV_CH = 8;
__device__ __forceinline__ void conv_item_gu(Frame& F, int s, int q, LAS float* scr) {
    const int up = q / I_G, q2 = q % I_G, nblk = DE / 64, kb = q2 / nblk, nb = q2 % nblk, n0 = 64 * nb;
    const float* W = up ? (s == 0 ? F.ws_up : F.w_up + (size_t)(s - 1) * D * DE) : (s == 0 ? F.ws_gate : F.w_gate + (size_t)(s - 1) * D * DE);
    const int drow = s * 1024 + (n0 >> 7) * 256 + up * 128 + (n0 & 127);
    if (MOE_F8) conv64_f8(W + (size_t)(64 * kb) * DE + n0, DE, (unsigned char*)(F.ws + WS_WGUT) + (size_t)drow * D + 64 * kb, D, (LAS unsigned char*)scr, F.lane, pg8::F8_SWG);
    else conv64(W + (size_t)(64 * kb) * DE + n0, DE, (bf16*)(F.ws + WS_WGUT) + (size_t)drow * D + 64 * kb, D, (LAS unsigned char*)scr, F.lane);
}
__device__ __forceinline__ void conv_item_dn(Frame& F, int s, int q, LAS float* scr) {
    const int nblk = D / 64, kb = q / nblk, nb = q % nblk;
    const float* W = (s == 0 ? F.ws_down : F.w_down + (size_t)(s - 1) * DE * D);
    if (MOE_F8) conv64_f8(W + (size_t)(64 * kb) * D + 64 * nb, D, (unsigned char*)(F.ws + WS_WDT) + (size_t)(s * D + 64 * nb) * DE + 64 * kb, DE, (LAS unsigned char*)scr, F.lane, pg8::F8_SWD);
    else conv64(W + (size_t)(64 * kb) * D + 64 * nb, D, (bf16*)(F.ws + WS_WDT) + (size_t)(s * D + 64 * nb) * DE + 64 * kb, DE, (LAS unsigned char*)scr, F.lane);
}
__device__ __forceinline__ void drain(Frame& F, int which, int fin_idx, unsigned target) {
    LAS float* scr = (LAS float*)(F.lds + RING_OFF + 32768 + F.wave * 12288);
    const unsigned total = which ? (unsigned)QC_ITEMS : (unsigned)QB_ITEMS;
    for (;;) {
        if (F.tid == 0) {
            unsigned base = 0xffffffffu; bool go = true;
            if (fin_idx >= 0) go = __hip_atomic_load(F.ctl + fin_idx, RLX_AGENT) < target;
            if (go) base = __hip_atomic_fetch_add(F.ctl + CW_Q + 64 * which, (unsigned)CONV_CH, RLX_AGENT);
            F.MISC[16] = base;
        }
        __syncthreads();
        const unsigned base = F.MISC[16];
        __syncthreads();
        if (base >= total) break;
        for (int j = F.wave; j < CONV_CH; j += NWAVES) { const unsigned r = base + j; if (r < total) { if (which) conv_item_dn(F, 1 + (int)(r / I_D), (int)(r % I_D), scr); else conv_item_gu(F, 1 + (int)(r / (2 * I_G)), (int)(r % (2 * I_G)), scr); } }
    }
}
__device__ __forceinline__ void phase_fin(Frame& F, int fin_idx) { __syncthreads(); if (F.tid == 0) __hip_atomic_fetch_add(F.ctl + fin_idx, 1u, RLX_AGENT); }

__device__ __forceinline__ void p0_gemv(Frame& F, int c0, int c1) {
    {
        __syncthreads();
        LAS float* cs = (LAS float*)(F.lds + RING_OFF);
        LAS float* red = (LAS float*)(F.lds + RING_OFF + 16384);
        for (int i = F.tid; i < NB * D; i += NTHR) { const float v = F.c[i]; cs[i] = v / (1.0f + __expf(-v)); }
        __syncthreads();
        float* part = (float*)(F.ws + WS_PART);
        const int nch = c1 - c0;
        for (int it = blockIdx.x; it < nch * KSL; it += F.G) {
            const int chunk = c0 + it % nch, sl = it / nch, k0 = sl * (D / KSL) + F.wave * 32;
            const float* wp = F.w_mod + (size_t)k0 * (6 * D) + chunk * 256 + F.lane * 4;
            f32x4 a0 = {0.f, 0.f, 0.f, 0.f}, a1 = {0.f, 0.f, 0.f, 0.f};
#pragma unroll 8
            for (int k = 0; k < 32; ++k) { const f32x4 w = *(const GAS f32x4*)(wp + (size_t)k * (6 * D)); const float c0 = cs[k0 + k], c1 = cs[D + k0 + k]; a0 += w * c0; a1 += w * c1; }
            *(LAS f32x4*)(red + (F.wave * 2 + 0) * 256 + F.lane * 4) = a0;
            *(LAS f32x4*)(red + (F.wave * 2 + 1) * 256 + F.lane * 4) = a1;
            __syncthreads();
            { const int b = F.tid >> 8, col = F.tid & 255; float s = 0.f;
#pragma unroll
              for (int w = 0; w < 8; ++w) s += red[(w * 2 + b) * 256 + col];
              part[((size_t)sl * 2 + b) * (6 * D) + chunk * 256 + col] = s; }
            __syncthreads();
        }
    }
}
__device__ __forceinline__ void p0_static_conv(Frame& F) {
    __syncthreads();
    LAS float* scr = (LAS float*)(F.lds + RING_OFF + 32768 + F.wave * 12288);
    const int gw = F.vcu * NWAVES + F.wave, NGW = F.G * NWAVES;
    constexpr int I_IN = (D / 64) * (INW / 64), I_OUT = (D / 64) * (D / 64), I_R = (D / 64) * (NE / 32);
    constexpr int NITEMS = I_IN + I_OUT + (2 * I_G + I_D) + I_R;
    bf16* WinT = (bf16*)(F.ws + WS_WINT); bf16* WoutT = (bf16*)(F.ws + WS_WOUTT);
    bf16* WrHi = (bf16*)(F.ws + WS_WRT); bf16* WrLo = WrHi + NE * D;
    for (int it = gw; it < NITEMS; it += NGW) {
        int r = it;
        if (r < I_IN) { const int nblk = INW / 64, kb = r / nblk, nb = r % nblk; conv64(F.w_in + (size_t)(64 * kb) * INW + 64 * nb, INW, WinT + (size_t)(64 * nb) * D + 64 * kb, D, (LAS unsigned char*)scr, F.lane); continue; } r -= I_IN;
        if (r < I_OUT) { const int nblk = D / 64, kb = r / nblk, nb = r % nblk; conv64(F.w_out + (size_t)(64 * kb) * D + 64 * nb, D, WoutT + (size_t)(64 * nb) * D + 64 * kb, D, (LAS unsigned char*)scr, F.lane); continue; } r -= I_OUT;
        if (r < 2 * I_G) { conv_item_gu(F, 0, r, scr); continue; } r -= 2 * I_G;
        if (r < I_D) { conv_item_dn(F, 0, r, scr); continue; } r -= I_D;
        { const int nblk = NE / 32, kb = r / nblk, nb = r % nblk;
          p0_transpose_item_hilo(F.w_router + (size_t)(64 * kb) * NE + 32 * nb, NE, WrHi + (size_t)(32 * nb) * D + 64 * kb, WrLo + (size_t)(32 * nb) * D + 64 * kb, D, scr, F.lane); }
    }
}

__device__ __forceinline__ void modf_reduce(Frame& F) {
    const float* part = (const float*)(F.ws + WS_PART); float* modf = (float*)(F.ws + WS_MODF);
    const int idx = blockIdx.x * NTHR + F.tid;
    if (idx < NB * 6 * D) { const int b = idx / (6 * D), j = idx % (6 * D); float s = F.b_mod[j];
#pragma unroll
        for (int sl = 0; sl < KSL; ++sl) s += part[((size_t)sl * 2 + b) * (6 * D) + j];
        modf[idx] = s; }
}
__device__ __forceinline__ void p1a_modulate(Frame& F) {
    const float* part = (const float*)(F.ws + WS_PART);
    LAS float* sm = (LAS float*)(F.lds + RING_OFF);
    bf16* hb = (bf16*)(F.ws + WS_HB);
    for (int r0 = F.vcu * 32; r0 < M; r0 += F.G * 32) {
        const int b = r0 / SEQ;
        __syncthreads();
        for (int i = F.tid; i < 2 * D; i += NTHR) { float s = F.b_mod[i];
#pragma unroll
            for (int sl = 0; sl < KSL; ++sl) s += part[((size_t)sl * 2 + b) * (6 * D) + i];
            sm[i] = s; }
        __syncthreads();
#pragma unroll 1
        for (int rr = 0; rr < 4; ++rr) {
            const int m = r0 + F.wave * 4 + rr; const GAS f32x4* xr = (const GAS f32x4*)(F.x + (size_t)m * D) + F.lane;
            const LAS f32x4* sh = (const LAS f32x4*)sm + F.lane; const LAS f32x4* sc = (const LAS f32x4*)(sm + D) + F.lane;
            GAS v2u* o = (GAS v2u*)(hb + (size_t)m * D) + F.lane;
#pragma unroll
            for (int j = 0; j < 8; ++j) { const f32x4 v = xr[64 * j], a = sc[64 * j], s = sh[64 * j]; const f32x4 h = v * (a + 1.0f) + s;
                v2u w; w.x = pk2(h.x, h.y); w.y = pk2(h.z, h.w); o[64 * j] = w; }
        }
    }
}

constexpr int KS_PITCH = 144, VT_PITCH = 528, LDS_KS = 0, LDS_VT = 256 * KS_PITCH;
__device__ __forceinline__ void p2_attn_conv(Frame& F) {
    const bf16* proj = (const bf16*)(F.ws + WS_PROJ); bf16* mix = (bf16*)(F.ws + WS_MIX);
    const int fr = F.lane & 15, fq = F.lane >> 4;
    for (int unit = blockIdx.x; unit < NB * (SEQ / 128) * NKVH; unit += F.G) {
        const int hkv = unit % NKVH, nb = (unit / NKVH) % (SEQ / 128), b = unit / (NKVH * (SEQ / 128));
        const int rowbase = b * SEQ + nb * 128 - 128;
        __syncthreads();
#pragma unroll
        for (int it = 0; it < 4; ++it) {
            const int idx = F.tid + NTHR * it, j = idx >> 3, c = idx & 7;
            v4u kv = {0u, 0u, 0u, 0u};
            if (nb > 0 || j >= 128) kv = *(const GAS v4u*)(proj + (size_t)(rowbase + j) * INW + COL_K + hkv * HD + c * 8);
            *(LAS v4u*)(F.lds + LDS_KS + j * KS_PITCH + c * 16) = kv;
        }
#pragma unroll
        for (int it = 0; it < 4; ++it) {
            const int idx = F.tid + NTHR * it, j = idx & 255, c = idx >> 8;
            v4u vv = {0u, 0u, 0u, 0u};
            if (nb > 0 || j >= 128) vv = *(const GAS v4u*)(proj + (size_t)(rowbase + j) * INW + COL_V + hkv * HD + c * 8);
            LAS unsigned short* vt = (LAS unsigned short*)(F.lds + LDS_VT + (c * 8) * VT_PITCH + j * 2);
            vt[0 * (VT_PITCH / 2)] = (unsigned short)(vv.x & 0xffffu); vt[1 * (VT_PITCH / 2)] = (unsigned short)(vv.x >> 16);
            vt[2 * (VT_PITCH / 2)] = (unsigned short)(vv.y & 0xffffu); vt[3 * (VT_PITCH / 2)] = (unsigned short)(vv.y >> 16);
            vt[4 * (VT_PITCH / 2)] = (unsigned short)(vv.z & 0xffffu); vt[5 * (VT_PITCH / 2)] = (unsigned short)(vv.z >> 16);
            vt[6 * (VT_PITCH / 2)] = (unsigned short)(vv.w & 0xffffu); vt[7 * (VT_PITCH / 2)] = (unsigned short)(vv.w >> 16);
        }
        __syncthreads();
        const int g = F.wave & 3, half = F.wave >> 2, h = hkv * 4 + g;
        const float slope2 = exp2f(-0.5f * (float)(h + 1)) * 1.4426950408889634f;
        const float sink2 = F.sinks[h] * 1.4426950408889634f;
        const float qk2 = 0.125f * 1.4426950408889634f;
#pragma unroll 1
        for (int mi = 0; mi < 4; ++mi) {
            const int i = half * 4 + mi, j0 = i >> 1;
            const size_t qrow = (size_t)(b * SEQ + nb * 128 + 16 * i + fr);
            const bf16x8 q0 = *(const GAS bf16x8*)(proj + qrow * INW + h * HD + 8 * fq), q1 = *(const GAS bf16x8*)(proj + qrow * INW + h * HD + 32 + 8 * fq);
            f32x4 s[10];
#pragma unroll
            for (int x = 0; x < 10; ++x) {
                const int tt = 2 * j0 + x;
                const bf16x8 k0 = *(const LAS bf16x8*)(F.lds + LDS_KS + (16 * tt + fr) * KS_PITCH + 16 * fq), k1 = *(const LAS bf16x8*)(F.lds + LDS_KS + (16 * tt + fr) * KS_PITCH + 64 + 16 * fq);
                f32x4 a = {0.f, 0.f, 0.f, 0.f};
                a = __builtin_amdgcn_mfma_f32_16x16x32_bf16(k0, q0, a, 0, 0, 0);
                a = __builtin_amdgcn_mfma_f32_16x16x32_bf16(k1, q1, a, 0, 0, 0);
                s[x] = a;
            }
            float mx = sink2;
#pragma unroll
            for (int x = 0; x < 10; ++x) {
#pragma unroll
                for (int r = 0; r < 4; ++r) {
                    const int kj = 16 * (2 * j0 + x) + 4 * fq + r, dist = 16 * i + fr + 128 - kj;
                    const bool valid = (dist >= 0) && (dist < 128) && (nb > 0 || kj >= 128);
                    const float v = valid ? (s[x][r] * qk2 - slope2 * (float)dist) : -INFINITY;
                    s[x][r] = v; mx = fmaxf(mx, v);
                }
            }
            mx = fmaxf(mx, __shfl_xor(mx, 16)); mx = fmaxf(mx, __shfl_xor(mx, 32));
            float l = 0.f;
#pragma unroll
            for (int x = 0; x < 10; ++x) {
#pragma unroll
                for (int r = 0; r < 4; ++r) { const float p = __builtin_amdgcn_exp2f(s[x][r] - mx); s[x][r] = p; l += p; }
            }
            l += __shfl_xor(l, 16); l += __shfl_xor(l, 32);
            const float inv = 1.0f / (l + __builtin_amdgcn_exp2f(sink2 - mx));
            f32x4 o[4];
#pragma unroll
            for (int dt = 0; dt < 4; ++dt) o[dt] = (f32x4){0.f, 0.f, 0.f, 0.f};
#pragma unroll
            for (int pp = 0; pp < 5; ++pp) {
                const int tt0 = 2 * (j0 + pp);
                v4u pw; pw.x = pk2(s[2 * pp][0] * inv, s[2 * pp][1] * inv); pw.y = pk2(s[2 * pp][2] * inv, s[2 * pp][3] * inv);
                pw.z = pk2(s[2 * pp + 1][0] * inv, s[2 * pp + 1][1] * inv); pw.w = pk2(s[2 * pp + 1][2] * inv, s[2 * pp + 1][3] * inv);
                const bf16x8 pf = __builtin_bit_cast(bf16x8, pw);
#pragma unroll
                for (int dt = 0; dt < 4; ++dt) {
                    const LAS unsigned char* vp = F.lds + LDS_VT + (16 * dt + fr) * VT_PITCH + 32 * tt0 + 8 * fq;
                    const v2u lo = *(const LAS v2u*)vp, hi = *(const LAS v2u*)(vp + 32);
                    v4u vw; vw.x = lo.x; vw.y = lo.y; vw.z = hi.x; vw.w = hi.y;
                    o[dt] = __builtin_amdgcn_mfma_f32_16x16x32_bf16(__builtin_bit_cast(bf16x8, vw), pf, o[dt], 0, 0, 0);
                }
            }
#pragma unroll
            for (int dt = 0; dt < 4; ++dt) { v2u w; w.x = pk2(o[dt][0], o[dt][1]); w.y = pk2(o[dt][2], o[dt][3]);
                *(GAS v2u*)(mix + qrow * D + h * HD + 16 * dt + 4 * fq) = w; }
        }
    }
    for (int item = F.vcu * NTHR + F.tid; item < (M / 8) * (CW / 8); item += F.G * NTHR) {
        const int cch = item % (CW / 8), rb = item / (CW / 8), r0 = rb * 8, t0 = r0 % SEQ, c0 = cch * 8;
        float w0[8], w1[8], w2[8], u1[8], u2[8];
        { const f32x4 a = *(const GAS f32x4*)(F.conv_w + c0), b2 = *(const GAS f32x4*)(F.conv_w + c0 + 4);
          w0[0] = a.x; w0[1] = a.y; w0[2] = a.z; w0[3] = a.w; w0[4] = b2.x; w0[5] = b2.y; w0[6] = b2.z; w0[7] = b2.w; }
        { const f32x4 a = *(const GAS f32x4*)(F.conv_w + CW + c0), b2 = *(const GAS f32x4*)(F.conv_w + CW + c0 + 4);
          w1[0] = a.x; w1[1] = a.y; w1[2] = a.z; w1[3] = a.w; w1[4] = b2.x; w1[5] = b2.y; w1[6] = b2.z; w1[7] = b2.w; }
        { const f32x4 a = *(const GAS f32x4*)(F.conv_w + 2 * CW + c0), b2 = *(const GAS f32x4*)(F.conv_w + 2 * CW + c0 + 4);
          w2[0] = a.x; w2[1] = a.y; w2[2] = a.z; w2[3] = a.w; w2[4] = b2.x; w2[5] = b2.y; w2[6] = b2.z; w2[7] = b2.w; }
        if (t0 == 0) {
#pragma unroll
            for (int q = 0; q < 8; ++q) { u1[q] = 0.f; u2[q] = 0.f; }
        } else {
            const v4u c1 = *(const GAS v4u*)(proj + (size_t)(r0 - 1) * INW + COL_CC + c0), h1 = *(const GAS v4u*)(proj + (size_t)(r0 - 1) * INW + COL_CH + c0);
            const v4u c2 = *(const GAS v4u*)(proj + (size_t)(r0 - 2) * INW + COL_CC + c0), h2 = *(const GAS v4u*)(proj + (size_t)(r0 - 2) * INW + COL_CH + c0);
            u1[0] = bflo(c1.x) * bflo(h1.x); u1[1] = bfhi(c1.x) * bfhi(h1.x); u1[2] = bflo(c1.y) * bflo(h1.y); u1[3] = bfhi(c1.y) * bfhi(h1.y);
            u1[4] = bflo(c1.z) * bflo(h1.z); u1[5] = bfhi(c1.z) * bfhi(h1.z); u1[6] = bflo(c1.w) * bflo(h1.w); u1[7] = bfhi(c1.w) * bfhi(h1.w);
            u2[0] = bflo(c2.x) * bflo(h2.x); u2[1] = bfhi(c2.x) * bfhi(h2.x); u2[2] = bflo(c2.y) * bflo(h2.y); u2[3] = bfhi(c2.y) * bfhi(h2.y);
            u2[4] = bflo(c2.z) * bflo(h2.z); u2[5] = bfhi(c2.z) * bfhi(h2.z); u2[6] = bflo(c2.w) * bflo(h2.w); u2[7] = bfhi(c2.w) * bfhi(h2.w);
        }
#pragma unroll
        for (int rr = 0; rr < 8; ++rr) {
            const size_t ro = (size_t)(r0 + rr) * INW;
            const v4u bv = *(const GAS v4u*)(proj + ro + COL_CB + c0), cv = *(const GAS v4u*)(proj + ro + COL_CC + c0), hv = *(const GAS v4u*)(proj + ro + COL_CH + c0);
            float u0[8], cb[8], y[8];
            u0[0] = bflo(cv.x) * bflo(hv.x); u0[1] = bfhi(cv.x) * bfhi(hv.x); u0[2] = bflo(cv.y) * bflo(hv.y); u0[3] = bfhi(cv.y) * bfhi(hv.y);
            u0[4] = bflo(cv.z) * bflo(hv.z); u0[5] = bfhi(cv.z) * bfhi(hv.z); u0[6] = bflo(cv.w) * bflo(hv.w); u0[7] = bfhi(cv.w) * bfhi(hv.w);
            cb[0] = bflo(bv.x); cb[1] = bfhi(bv.x); cb[2] = bflo(bv.y); cb[3] = bfhi(bv.y); cb[4] = bflo(bv.z); cb[5] = bfhi(bv.z); cb[6] = bflo(bv.w); cb[7] = bfhi(bv.w);
#pragma unroll
            for (int q = 0; q < 8; ++q) { y[q] = cb[q] * (w0[q] * u2[q] + w1[q] * u1[q] + w2[q] * u0[q]); u2[q] = u1[q]; u1[q] = u0[q]; }
            v4u ov; ov.x = pk2(y[0], y[1]); ov.y = pk2(y[2], y[3]); ov.z = pk2(y[4], y[5]); ov.w = pk2(y[6], y[7]);
            *(GAS v4u*)(mix + (size_t)(r0 + rr) * D + AW + c0) = ov;
        }
    }
}

constexpr int P4_STAT = 0, P4_GB = 1024, P4_PART = P4_GB + 4 * D * 4, P4_END = P4_PART + 8 * 32 * 64 * 4;
static_assert(P4_END <= RING_BYTES, "P4 LDS");
__device__ __forceinline__ void p4_ln_router(Frame& F, int u_first, int u_stride, int u_count) {
    const bf16* y1 = (const bf16*)(F.ws + WS_Y1); bf16* x1 = (bf16*)(F.ws + WS_X1); bf16* xg = (bf16*)(F.ws + WS_XG);
    const float* modf = (const float*)(F.ws + WS_MODF);
    const bf16* WrHi = (const bf16*)(F.ws + WS_WRT); const bf16* WrLo = WrHi + NE * D;
    int* rowtok = (int*)(F.ws + WS_ROWTOK); float* roww = (float*)(F.ws + WS_ROWW); int* tokslot = (int*)(F.ws + WS_TOKSLOT);
    LAS float* stat = (LAS float*)(F.lds + P4_STAT); LAS float* GB = (LAS float*)(F.lds + P4_GB); LAS float* lpart = (LAS float*)(F.lds + P4_PART);
    const int fr = F.lane & 15, fq = F.lane >> 4;
    int prev_b = -1;
    for (int ui_ = 0, unit = u_first; ui_ < u_count && unit < M / 32; ++ui_, unit += u_stride) {
        const int row0 = unit * 32, b = row0 / SEQ;
        const float* sh2 = modf + (size_t)b * 6 * D + 3 * D; const float* sc2 = modf + (size_t)b * 6 * D + 4 * D;
        __syncthreads();
        if (F.tid < NE) ((LAS unsigned*)(F.lds + P4_STAT + 512))[F.tid] = 0u;
        if (b != prev_b) { prev_b = b;
        for (int k = F.tid; k < D; k += NTHR) { const float a = 1.0f + sc2[k], g = F.ln1_g[k], bb = F.ln1_b[k]; GB[k] = g * a; GB[D + k] = bb * a + sh2[k]; GB[2 * D + k] = g; GB[3 * D + k] = bb; } }
        v4u yw[4][4];
#pragma unroll
        for (int rr = 0; rr < 4; ++rr) { const GAS v4u* yr = (const GAS v4u*)(y1 + (size_t)(row0 + F.wave * 4 + rr) * D) + F.lane;
#pragma unroll
            for (int c = 0; c < 4; ++c) yw[rr][c] = yr[64 * c]; }
        __syncthreads();
#pragma unroll
        for (int rr = 0; rr < 4; ++rr) {
            const int r = F.wave * 4 + rr; const size_t m = (size_t)(row0 + r);
            f32x4 v[8]; float s = 0.f;
#pragma unroll
            for (int c = 0; c < 4; ++c) { const v4u w = yw[rr][c]; v[2 * c] = (f32x4){bflo(w.x), bfhi(w.x), bflo(w.y), bfhi(w.y)}; v[2 * c + 1] = (f32x4){bflo(w.z), bfhi(w.z), bflo(w.w), bfhi(w.w)}; }
#pragma unroll
            for (int j = 0; j < 8; ++j) s += (v[j].x + v[j].y) + (v[j].z + v[j].w);
            const float mean = wave_sum(s) * (1.f / D); float s2 = 0.f;
#pragma unroll
            for (int j = 0; j < 8; ++j) { v[j] = v[j] - mean; s2 += (v[j].x * v[j].x + v[j].y * v[j].y) + (v[j].z * v[j].z + v[j].w * v[j].w); }
            const float rstd = 1.f / sqrtf(wave_sum(s2) * (1.f / D) + LN_EPS);
            if (F.lane == 0) { stat[2 * r] = mean; stat[2 * r + 1] = rstd; }
            GAS v2u* xo = (GAS v2u*)(x1 + m * D); GAS v2u* ho = (GAS v2u*)(xg + m * D); GAS unsigned* ho8 = (GAS unsigned*)((unsigned char*)xg + m * D);
#pragma unroll
            for (int j = 0; j < 8; ++j) {
                const int q4 = 128 * (j >> 1) + 2 * F.lane + (j & 1);
                const f32x4 vn = v[j] * rstd;
                const f32x4 xv = vn * *((const LAS f32x4*)(GB + 2 * D) + q4) + *((const LAS f32x4*)(GB + 3 * D) + q4); { v2u xw; xw.x = pk2(xv.x, xv.y); xw.y = pk2(xv.z, xv.w); xo[q4] = xw; }
                const f32x4 hv = vn * *((const LAS f32x4*)GB + q4) + *((const LAS f32x4*)(GB + D) + q4);
                if (MOE_F8) { f32x4 t = hv * pg8::F8_SX;
#pragma unroll
                    for (int q = 0; q < 4; ++q) t[q] = __builtin_fminf(__builtin_fmaxf(t[q], -440.0f), 440.0f);
                    int pa = __builtin_amdgcn_cvt_pk_fp8_f32(t.x, t.y, 0, false); pa = __builtin_amdgcn_cvt_pk_fp8_f32(t.z, t.w, pa, true); ho8[q4] = (unsigned)pa; }
                else { v2u w; w.x = pk2(hv.x, hv.y); w.y = pk2(hv.z, hv.w); ho[q4] = w; }
            }
        }
        __syncthreads();
        {
            f32x4 acc[2][4];
#pragma unroll
            for (int mt = 0; mt < 2; ++mt)
#pragma unroll
                for (int nt = 0; nt < 4; ++nt) acc[mt][nt] = (f32x4){0.f, 0.f, 0.f, 0.f};
            const float mu0 = stat[2 * fr], rs0 = stat[2 * fr + 1], mu1 = stat[2 * (16 + fr)], rs1 = stat[2 * (16 + fr) + 1];
#pragma unroll 4
            for (int ks = F.wave * 8; ks < F.wave * 8 + 8; ++ks) {
                const int k0 = 32 * ks + 8 * fq;
                const f32x4 g0 = *(const LAS f32x4*)(GB + k0), g1 = *(const LAS f32x4*)(GB + k0 + 4), b0 = *(const LAS f32x4*)(GB + D + k0), b1 = *(const LAS f32x4*)(GB + D + k0 + 4);
                bf16x8 whi[4], wlo[4];
#pragma unroll
                for (int nt = 0; nt < 4; ++nt) { whi[nt] = *(const GAS bf16x8*)(WrHi + (size_t)(16 * nt + fr) * D + k0); wlo[nt] = *(const GAS bf16x8*)(WrLo + (size_t)(16 * nt + fr) * D + k0); }
#pragma unroll
                for (int mt = 0; mt < 2; ++mt) {
                    const float mu = mt ? mu1 : mu0, rs = mt ? rs1 : rs0;
                    const v4u yw = *(const GAS v4u*)(y1 + (size_t)(row0 + 16 * mt + fr) * D + k0);
                    const f32x4 ya = {bflo(yw.x), bfhi(yw.x), bflo(yw.y), bfhi(yw.y)}, yb = {bflo(yw.z), bfhi(yw.z), bflo(yw.w), bfhi(yw.w)};
                    const f32x4 ha = (ya - mu) * rs * g0 + b0, hb2 = (yb - mu) * rs * g1 + b1;
                    unsigned hh[8], ll[8];
                    { const float t[8] = {ha.x, ha.y, ha.z, ha.w, hb2.x, hb2.y, hb2.z, hb2.w};
#pragma unroll
                      for (int q = 0; q < 8; ++q) { hh[q] = f2bf(t[q]); ll[q] = f2bf(t[q] - bf2f(hh[q])); } }
                    v4u ah, al; ah.x = hh[0] | (hh[1] << 16); ah.y = hh[2] | (hh[3] << 16); ah.z = hh[4] | (hh[5] << 16); ah.w = hh[6] | (hh[7] << 16);
                    al.x = ll[0] | (ll[1] << 16); al.y = ll[2] | (ll[3] << 16); al.z = ll[4] | (ll[5] << 16); al.w = ll[6] | (ll[7] << 16);
                    const bf16x8 fh = __builtin_bit_cast(bf16x8, ah), fl = __builtin_bit_cast(bf16x8, al);
#pragma unroll
                    for (int nt = 0; nt < 4; ++nt) {
                        acc[mt][nt] = __builtin_amdgcn_mfma_f32_16x16x32_bf16(fh, whi[nt], acc[mt][nt], 0, 0, 0);
                        acc[mt][nt] = __builtin_amdgcn_mfma_f32_16x16x32_bf16(fl, whi[nt], acc[mt][nt], 0, 0, 0);
                        acc[mt][nt] = __builtin_amdgcn_mfma_f32_16x16x32_bf16(fh, wlo[nt], acc[mt][nt], 0, 0, 0);
                    }
                }
            }
#pragma unroll
            for (int mt = 0; mt < 2; ++mt)
#pragma unroll
                for (int nt = 0; nt < 4; ++nt)
#pragma unroll
                    for (int r = 0; r < 4; ++r) lpart[(F.wave * 32 + 16 * mt + 4 * fq + r) * 64 + 16 * nt + fr] = acc[mt][nt][r];
        }
        __syncthreads();
        {
            LAS unsigned* hist = (LAS unsigned*)(F.lds + P4_STAT + 512); LAS unsigned* hbase = hist + 64;
            const int e = F.lane; const float rb = F.router_bias[e];
            bool chosen[4]; float wgt[4]; int erks[4]; unsigned lrank[4];
#pragma unroll
            for (int rr = 0; rr < 4; ++rr) {
                const int r = F.wave * 4 + rr;
                float logit = 0.f;
#pragma unroll
                for (int w = 0; w < 8; ++w) logit += lpart[(w * 32 + r) * 64 + e];
                const float score = 1.0f / (1.0f + __expf(-logit));
                const float sel = score + rb;
                int rk = 0;
#pragma unroll
                for (int x = 1; x < 8; ++x) { const float o = __shfl_xor(sel, x); const int e2 = e ^ x; rk += (o > sel || (o == sel && e2 < e)) ? 1 : 0; }
                float gs = rk < 2 ? sel : 0.f;
                gs += __shfl_xor(gs, 1); gs += __shfl_xor(gs, 2); gs += __shfl_xor(gs, 4);
                int grk = 0; const int gi = e >> 3;
#pragma unroll
                for (int x = 1; x < 8; ++x) { const float o = __shfl_xor(gs, 8 * x); const int g2 = gi ^ x; grk += (o > gs || (o == gs && g2 < gi)) ? 1 : 0; }
                const bool gsel = grk < 4;
                const float mv = gsel ? sel : -INFINITY;
                int erk = 0;
#pragma unroll 9
                for (int x = 1; x < 64; ++x) { const float o = __shfl_xor(mv, x); const int e2 = e ^ x; erk += (o > mv || (o == mv && e2 < e)) ? 1 : 0; }
                chosen[rr] = gsel && erk < TOPK; erks[rr] = erk;
                const float wsum = wave_sum(chosen[rr] ? score : 0.f);
                wgt[rr] = score / wsum * RSCALE;
                lrank[rr] = chosen[rr] ? __hip_atomic_fetch_add(hist + e, 1u, __ATOMIC_RELAXED, __HIP_MEMORY_SCOPE_WORKGROUP) : 0u;
            }
            __syncthreads();
            if (F.tid < NE) { const unsigned n = hist[F.tid]; hbase[F.tid] = n ? __hip_atomic_fetch_add(F.ctl + CW_CNT + 64 * F.tid, n, RLX_AGENT) : 0u; }
            __syncthreads();
            const unsigned pb = hbase[e];
#pragma unroll
            for (int rr = 0; rr < 4; ++rr) if (chosen[rr]) { const int tok = row0 + F.wave * 4 + rr; const unsigned pos = pb + lrank[rr];
                rowtok[e * M + pos] = tok; roww[e * M + pos] = wgt[rr]; tokslot[tok * TOPK + erks[rr]] = e * M + (int)pos; }
        }
    }
}

__device__ __forceinline__ void build_tables(Frame& F) {
    LAS unsigned short* tslot = (LAS unsigned short*)(F.lds + TS_OFF); LAS int* poff = (LAS int*)(F.lds + POFF_OFF); LAS int* cnt = poff + 128; LAS int* nt_p = poff + 256;
    __syncthreads();
    if (F.tid < NE) cnt[F.tid] = (int)__hip_atomic_load(F.ctl + CW_CNT + 64 * F.tid, RLX_AGENT);
    __syncthreads();
    if (F.tid == 0) {
        int t = M / 256; poff[0] = 0;
        for (int i = 0; i < M / 256; ++i) tslot[i] = 0;
        for (int e = 0; e < NE; ++e) { poff[1 + e] = t * 256; int c = cnt[e]; c = c < 0 ? 0 : (c > M ? M : c); const int n = (c + 255) >> 8; for (int i = 0; i < n && t < MAXT; ++i) tslot[t++] = (unsigned short)(1 + e); }
        nt_p[0] = t;
    }
    __syncthreads();
}

__device__ __forceinline__ void p6_setup(Frame& F, int Geff, int c) {
    const LAS unsigned short* tslot = (const LAS unsigned short*)(F.lds + TS_OFF); const LAS int* poff = (const LAS int*)(F.lds + POFF_OFF); const LAS int* cnt = poff + 128; const int ntiles = poff[256];
    const int* rowtok = (const int*)(F.ws + WS_ROWTOK); const float* roww = (const float*)(F.ws + WS_ROWW); float* wrow = (float*)(F.ws + WS_WROW);
    v4u* vt = (v4u*)(F.ws + WS_VTAB) + (size_t)blockIdx.x * 8 * NTHR;
    int R0, C0, R1, C1; pg8::stage_rc(F.tid * 16, R0, C0); pg8::stage_rc(F.tid * 16 + 8192, R1, C1);
#pragma unroll 1
    for (int i = 0; i < 8; ++i) {
        const int L = i * Geff + c; if (L >= ntiles * 4) break;
        const int t = L >> 2, s = tslot[t], e = s - 1, pos0 = t * 256 - poff[s], ce = s ? cnt[e] : 0;
        int rr[4] = {R0, R1, 128 + R0, 128 + R1}; const int cc[4] = {C0, C1, C0, C1}; unsigned off[4];
#pragma unroll
        for (int q = 0; q < 4; ++q) { int tok = t * 256 + rr[q]; if (s) { const int pos = pos0 + rr[q]; tok = pos < ce ? rowtok[e * M + pos] : 0; } off[q] = (unsigned)(tok * (MOE_F8 ? D / 2 : D) + cc[q]) * 2u; }
        v4u o; o.x = off[0]; o.y = off[1]; o.z = off[2]; o.w = off[3]; vt[i * NTHR + F.tid] = o;
        if (F.tid < 256) { float w = 1.0f; if (s) { const int pos = pos0 + F.tid; w = pos < ce ? roww[e * M + pos] : 0.f; } wrow[t * 256 + F.tid] = w; }
    }
    VM_WAIT(); __syncthreads();
}

__device__ __forceinline__ void p7_combine(Frame& F) {
    build_tables(F);
    const LAS int* poff = (const LAS int*)(F.lds + POFF_OFF);
    const unsigned char* Y = (const unsigned char*)(F.ws + WS_XG); const bf16* x1 = (const bf16*)(F.ws + WS_X1); const float* modf = (const float*)(F.ws + WS_MODF);
    const int* tokslot = (const int*)(F.ws + WS_TOKSLOT);
    const int gw = F.vcu * NWAVES + F.wave, NGW = F.G * NWAVES;
    typedef float f32x2 __attribute__((ext_vector_type(2)));
    for (int m = gw; m < M; m += NGW) {
        const int b = m / SEQ; const float* g2 = modf + (size_t)b * 6 * D + 5 * D;
        int ln = F.lane; asm volatile("" : "+v"(ln));
        int rows[9]; rows[0] = m;
#pragma unroll
        for (int k = 0; k < TOPK; ++k) { const int sl = __builtin_amdgcn_readfirstlane(tokslot[m * TOPK + k]), e = sl / M, pos = sl % M; rows[1 + k] = poff[1 + e] + pos; }
        f32x4 v[2][4];
#pragma unroll
        for (int j = 0; j < 2; ++j)
#pragma unroll
            for (int q = 0; q < 4; ++q) v[j][q] = (f32x4){0.f, 0.f, 0.f, 0.f};
        v4u w[9][2];
#pragma unroll
        for (int k = 0; k < 9; ++k) { const GAS v4u* yr = (const GAS v4u*)(Y + (size_t)rows[k] * D); w[k][0] = yr[ln]; w[k][1] = yr[64 + ln]; }
        f32x4 xv[2][4];
        { const GAS v4u* xr0 = (const GAS v4u*)(x1 + (size_t)m * D);
#pragma unroll
          for (int j = 0; j < 2; ++j)
#pragma unroll
              for (int h = 0; h < 2; ++h) { const v4u w = xr0[2 * ln + 128 * j + h];
                  xv[j][2 * h] = (f32x4){bflo(w.x), bfhi(w.x), bflo(w.y), bfhi(w.y)}; xv[j][2 * h + 1] = (f32x4){bflo(w.z), bfhi(w.z), bflo(w.w), bfhi(w.w)}; } }
#pragma unroll
        for (int k = 0; k < 9; ++k)
#pragma unroll
            for (int j = 0; j < 2; ++j) {
                const unsigned ww[4] = {w[k][j].x, w[k][j].y, w[k][j].z, w[k][j].w};
#pragma unroll
                for (int q = 0; q < 4; ++q) { const f32x2 lo = (Y_BF8 == 2) ? __builtin_amdgcn_cvt_pk_f32_fp8((int)ww[q], false) : __builtin_amdgcn_cvt_pk_f32_bf8((int)ww[q], false), hi = (Y_BF8 == 2) ? __builtin_amdgcn_cvt_pk_f32_fp8((int)ww[q], true) : __builtin_amdgcn_cvt_pk_f32_bf8((int)ww[q], true);
                    v[j][q].x += lo.x; v[j][q].y += lo.y; v[j][q].z += hi.x; v[j][q].w += hi.y; }
            }
        const GAS f32x4* gr = (const GAS f32x4*)g2; const int l4 = 4 * ln; float s = 0.f;
#pragma unroll
        for (int j = 0; j < 2; ++j)
#pragma unroll
            for (int q = 0; q < 4; ++q) { v[j][q] = xv[j][q] * ALPHA + (gr[l4 + 256 * j + q] + 1.0f) * (v[j][q] * ((Y_BF8 == 2) ? (1.0f / 64.0f) : 1.0f)); s += (v[j][q].x + v[j][q].y) + (v[j][q].z + v[j][q].w); }
        const float mean = wave_sum(s) * (1.f / D); float s2 = 0.f;
#pragma unroll
        for (int j = 0; j < 2; ++j)
#pragma unroll
            for (int q = 0; q < 4; ++q) { v[j][q] = v[j][q] - mean; s2 += (v[j][q].x * v[j][q].x + v[j][q].y * v[j][q].y) + (v[j][q].z * v[j][q].z + v[j][q].w * v[j][q].w); }
        const float rstd = 1.f / sqrtf(wave_sum(s2) * (1.f / D) + LN_EPS);
        GAS f32x4* o = (GAS f32x4*)(F.out + (size_t)m * D); const GAS f32x4* lg = (const GAS f32x4*)F.ln2_g; const GAS f32x4* lb = (const GAS f32x4*)F.ln2_b;
#pragma unroll
        for (int j = 0; j < 2; ++j)
#pragma unroll
            for (int q = 0; q < 4; ++q) o[l4 + 256 * j + q] = v[j][q] * rstd * lg[l4 + 256 * j + q] + lb[l4 + 256 * j + q];
    }
}

constexpr int NPHASE = 9;
struct Args { const float* in[20]; float* out; unsigned char* ws; int ph_lo, ph_hi; };
__global__ void __launch_bounds__(NWAVES * 64, 2) mk_fwd(Args args) {
    extern __shared__ __attribute__((aligned(16))) unsigned char lds[];
    Frame F;
    F.lds = (LAS unsigned char*)lds;
    F.MISC = (volatile LAS unsigned*)(F.lds + MISC_OFF);
    F.tid = threadIdx.x; F.lane = F.tid & 63; F.wave = __builtin_amdgcn_readfirstlane(F.tid >> 6);
    F.G = gridDim.x; { const int bx = blockIdx.x; F.vcu = (F.G % 8 == 0) ? (bx % 8) * (F.G / 8) + bx / 8 : bx; }
    F.ws = args.ws; F.ctl = (gu32*)(args.ws + WS_CTL);
    F.x = args.in[0]; F.c = args.in[1]; F.w_mod = args.in[2]; F.b_mod = args.in[3]; F.w_in = args.in[4]; F.conv_w = args.in[5]; F.sinks = args.in[6]; F.w_out = args.in[7];
    F.ln1_g = args.in[8]; F.ln1_b = args.in[9]; F.w_router = args.in[10]; F.router_bias = args.in[11]; F.w_gate = args.in[12]; F.w_up = args.in[13]; F.w_down = args.in[14];
    F.ws_gate = args.in[15]; F.ws_up = args.in[16]; F.ws_down = args.in[17]; F.ln2_g = args.in[18]; F.ln2_b = args.in[19]; F.out = args.out;
    for (int u = F.tid; u < (LDS_BYTES - LDSCTL_OFF) / 4; u += NWAVES * 64) ((LAS unsigned*)(F.lds + LDSCTL_OFF))[u] = 0u;
    __syncthreads();
    XcdBarrier bar; bar.bar = (unsigned*)(F.ctl + CW_BAR); bar.x = 0; bar.st = nullptr;
    if (!MK_PER_PHASE) bar = xcd_barrier_post((unsigned*)(F.ctl + CW_BAR), F.MISC + 8);
#define GRID_BAR() do { if (!MK_PER_PHASE) xcd_barrier(bar); } while (0)
    unsigned long long tA = 0;
#define ST_BEGIN(k) do { if (PROBE_STAMP == (k)) tA = __builtin_amdgcn_s_memrealtime(); } while (0)
#define ST_END(k) do { if (PROBE_STAMP == (k)) { const unsigned long long t1 = __builtin_amdgcn_s_memrealtime(), dd = t1 - tA; while (__builtin_amdgcn_s_memrealtime() - t1 < dd) __builtin_amdgcn_s_sleep(8); } } while (0)
    const int lo = args.ph_lo, hi = args.ph_hi;
#define IN(k) (lo <= (k) && (k) < hi && ((F.lane = pg8::lane_id_v()), (F.tid = F.wave * 64 + F.lane), true))
#define BOTH(k) (IN(k) && IN((k) + 1))
    if (IN(0)) { ST_BEGIN(0); p0_gemv(F, 0, 16); if (BOTH(0)) GRID_BAR(); ST_END(0); }
    if (IN(1)) { ST_BEGIN(1); p1a_modulate(F); p0_gemv(F, 16, 48); p0_static_conv(F); if (BOTH(1)) GRID_BAR(); ST_END(1); }
    if (IN(2)) {
        ST_BEGIN(2);
        __syncthreads();
        const bool split = (F.G == 256); const int q = (int)blockIdx.x >> 3, x = (int)blockIdx.x & 7, Geff = split ? 192 : F.G;
        if (!split || q < 24) {
            pg8::Gemm g{(const pg8::bf16_t*)(F.ws + WS_HB), (const pg8::bf16_t*)(F.ws + WS_WINT), M, INW, D, F.ws}; pg8::StaticOrder S; S.init(M, INW, Geff, split ? q * 8 + x : (int)blockIdx.x);
            pg8::EpiBf16<0> E{(pg8::bf16_t*)(F.ws + WS_PROJ), INW, nullptr, 0, 0, 1.f};
            pg8::gemm_phase<pg8::EpiBf16<0>, pg8::StaticOrder, PG8_ALIGN, PG8_SP2>(F.lds + RING_OFF, g, S, E, F.wave);
            phase_fin(F, CW_FIN + 64 * 2);
        } else { drain(F, 0, CW_FIN + 64 * 2, (unsigned)Geff); drain(F, 1, CW_FIN + 64 * 2, (unsigned)Geff); }
        if (BOTH(2)) GRID_BAR();
        ST_END(2);
    }
    if (IN(3)) { ST_BEGIN(3); modf_reduce(F); p2_attn_conv(F); if (BOTH(3)) GRID_BAR(); ST_END(3); }
    if (IN(4)) {
        ST_BEGIN(4);
        _Pragma("unroll") for (int rep = (REP_PHASE == 4 ? 0 : 1); rep < 2; ++rep) {
        __syncthreads();
        pg8::Gemm g{(const pg8::bf16_t*)(F.ws + WS_MIX), (const pg8::bf16_t*)(F.ws + WS_WOUTT), M, D, D, F.ws}; pg8::StaticOrder S; S.init(M, D, F.G, (int)blockIdx.x);
        pg8::EpiResF32 E{F.x, (pg8::bf16_t*)(F.ws + WS_Y1), (const float*)(F.ws + WS_MODF) + 2 * D, D, SEQ, 6 * D, ALPHA};
        pg8::gemm_phase<pg8::EpiResF32, pg8::StaticOrder, PG8_ALIGN, PG8_SP2>(F.lds + RING_OFF, g, S, E, F.wave);
        if (rep == 0) GRID_BAR(); }
        if (BOTH(4)) GRID_BAR();
        ST_END(4);
    }
    if (IN(5)) { ST_BEGIN(5);
        const bool split5 = (F.G == 256) && (P5_MAIN_Q < 32); const int q5 = (int)blockIdx.x >> 3, x5 = (int)blockIdx.x & 7, nmain = split5 ? 8 * P5_MAIN_Q : F.G;
        if (!split5 || q5 < P5_MAIN_Q) { p4_ln_router(F, split5 ? (q5 * 8 + x5) * (256 / nmain) : (int)blockIdx.x, split5 ? 1 : nmain, split5 ? 256 / nmain : 1 << 20); phase_fin(F, CW_FIN + 64 * 5); }
        else { drain(F, 0, CW_FIN + 64 * 5, (unsigned)nmain); drain(F, 1, CW_FIN + 64 * 5, (unsigned)nmain); }
        __syncthreads(); ST_BEGIN(10); drain(F, 0, -1, 0u); ST_END(10); if (BOTH(5)) GRID_BAR(); ST_END(5); }
    if (IN(6)) {
        ST_BEGIN(6); ST_BEGIN(12);
        build_tables(F);
        const int ntiles = ((const LAS int*)(F.lds + POFF_OFF))[256];
        const int units = ntiles * 4, Rn = (units + F.G - 1) / F.G, slack = F.G - (units + Rn - 1) / Rn, R = (F.G == 256 && slack < P6_MIN_CONV) ? Rn + 1 : Rn, Geff = (F.G % 8 == 0) ? (units + R - 1) / R : F.G;
        const int x = (int)blockIdx.x & 7, q = (int)blockIdx.x >> 3;
        int c = (int)blockIdx.x;
        if (F.G % 8 == 0) { int px = 0; for (int xx = 0; xx < x; ++xx) px += (Geff - xx + 7) >> 3; c = px + q; }
        if ((int)blockIdx.x < Geff) {
            p6_setup(F, Geff, c);
            int Kgu = MOE_F8 ? D / 2 : D; asm volatile("" : "+s"(Kgu));
            pg8::Gemm g{(const pg8::bf16_t*)(F.ws + WS_XG), (const pg8::bf16_t*)(F.ws + WS_WGUT), M, NSLOT * 1024, Kgu, F.ws};
            pg8::GroupedOrder<true> S{(const PG8_LAS unsigned short*)(F.lds + TS_OFF), ntiles, 4, Geff, c, (const unsigned*)(F.ws + WS_VTAB) + (size_t)blockIdx.x * 8 * NTHR * 4, 0, (const float*)(F.ws + WS_WROW)};
            pg8::EpiSwiGLU E{(pg8::bf16_t*)(F.ws + WS_H), (const PG8_LAS float*)(F.lds + RING_OFF + pg8::WR_SLOT), DE, 4};
            pg8::gemm_phase<pg8::EpiSwiGLU, pg8::GroupedOrder<true>, PG8_ALIGN, PG8_SP2>(F.lds + RING_OFF, g, S, E, F.wave);
            phase_fin(F, CW_FIN + 64 * 6);
        } else drain(F, 1, CW_FIN + 64 * 6, (unsigned)Geff);
        __syncthreads();
        ST_END(12); ST_BEGIN(11);
        drain(F, 1, -1, 0u);
        ST_END(11);
        if (BOTH(6)) GRID_BAR();
        ST_END(6);
    }
    if (IN(7)) {
        ST_BEGIN(7);
        _Pragma("unroll") for (int rep = (REP_PHASE == 7 ? 0 : 1); rep < 2; ++rep) {
        build_tables(F);
        const int ntiles = ((const LAS int*)(F.lds + POFF_OFF))[256];
        int Kdn = MOE_F8 ? DE / 2 : DE; asm volatile("" : "+s"(Kdn));
        pg8::Gemm g{(const pg8::bf16_t*)(F.ws + WS_H), (const pg8::bf16_t*)(F.ws + WS_WDT), MAXR, NSLOT * D, Kdn, F.ws};
        pg8::GroupedOrder<false> S{(const PG8_LAS unsigned short*)(F.lds + TS_OFF), ntiles, 8, F.G, F.vcu, nullptr, (PROBE_PIN && rep == 0) ? 1 : 0};
        pg8::EpiDown E{(pg8::bf16_t*)(F.ws + WS_XG), D, 8, (PROBE_NOSTORE && rep == 0) ? 1 : 0};
        if (DOWN_STAGGER) {
            const unsigned long long t0 = __builtin_amdgcn_s_memrealtime(), dl = (unsigned long long)(((unsigned)F.vcu >> 3) & 7u) * DOWN_STAGGER;
            while (__builtin_amdgcn_s_memrealtime() - t0 < dl) __builtin_amdgcn_s_sleep(4);
        }
        pg8::gemm_phase<pg8::EpiDown, pg8::GroupedOrder<false>, PG8_ALIGN, PG8_SP2>(F.lds + RING_OFF, g, S, E, F.wave);
        if (rep == 0) GRID_BAR(); }
        if (BOTH(7)) GRID_BAR();
        ST_END(7);
    }
    if (IN(8)) { ST_BEGIN(8); p7_combine(F); VM_WAIT(); ST_END(8); }
#undef IN
#undef BOTH
}

extern "C" void kernel_launch(void* const* d_in, const int* in_sizes, int n_in, void* d_out, int out_size, void* d_ws, size_t ws_size, hipStream_t stream) {
    static int grid = 0;
    if (grid == 0) {
        if (n_in != 20 || in_sizes[0] != M * D || out_size != M * D || ws_size < WS_END) { fprintf(stderr, "kernel_launch: unexpected shapes (n_in %d, in0 %d, out %d, ws %zu)\n", n_in, n_in > 0 ? in_sizes[0] : -1, out_size, ws_size); grid = -1; return; }
        int dev = 0, cus = 0, per_cu = 0;
        if (hipGetDevice(&dev) != hipSuccess || hipDeviceGetAttribute(&cus, hipDeviceAttributeMultiprocessorCount, dev) != hipSuccess) { grid = -1; return; }
        if (hipFuncSetAttribute((const void*)mk_fwd, hipFuncAttributeMaxDynamicSharedMemorySize, LDS_BYTES) != hipSuccess) { fprintf(stderr, "kernel_launch: hipFuncSetAttribute failed\n"); grid = -1; return; }
        if (hipOccupancyMaxActiveBlocksPerMultiprocessor(&per_cu, (const void*)mk_fwd, NWAVES * 64, LDS_BYTES) != hipSuccess || per_cu < 1) fprintf(stderr, "kernel_launch: occupancy query reports %d\n", per_cu);
        (void)hipGetLastError();
        grid = cus;
    }
    if (grid < 0) return;
    if (hipMemsetAsync((char*)d_ws + WS_CTL, 0, CTL_ZERO_BYTES, stream) != hipSuccess) return;
    Args a{};
    for (int i = 0; i < 20; ++i) a.in[i] = (const float*)d_in[i];
    a.out = (float*)d_out; a.ws = (unsigned char*)d_ws;
#if MK_PER_PHASE
    for (int p = 0; p < NPHASE; ++p) { a.ph_lo = p; a.ph_hi = p + 1; hipLaunchKernelGGL(mk_fwd, dim3(grid), dim3(NWAVES * 64), LDS_BYTES, stream, a); }
#else
    a.ph_lo = 0; a.ph_hi = NPHASE; hipLaunchKernelGGL(mk_fwd, dim3(grid), dim3(NWAVES * 64), LDS_BYTES, stream, a);
#endif
}
```

```cpp
#include <hip/hip_runtime.h>
#include <cstdio>
#include <cstdint>
#include <cmath>
#ifndef MOE_F8
#define MOE_F8 1
#endif
#ifndef Y_BF8
#define Y_BF8 2
#endif
namespace pg8 {
constexpr float F8_SX = 8.0f, F8_SWG = 64.0f, F8_SH = 8.0f, F8_SWD = 8.0f;
#define PG8_LAS __attribute__((address_space(3)))
typedef unsigned short bf16_t;
typedef short bf16x8 __attribute__((ext_vector_type(8)));
typedef float f32x4 __attribute__((ext_vector_type(4)));
typedef unsigned u32x4 __attribute__((ext_vector_type(4)));
constexpr int BM = 256, BK = 64, HALF = 128, HTB = HALF * BK * 2  , STAGE_BYTES = 8 * HTB, NXCD = 8, WGM = 8;
constexpr int VT_SLOT = STAGE_BYTES + 4096;
constexpr int WR_SLOT = STAGE_BYTES + 12288;

__host__ __device__ __forceinline__ int lds_byte(int r, int c) { const int st = (r >> 4) * 2 + (c >> 5), rr = r & 15, cc = c & 31, ob = rr * 64 + cc * 2; return st * 1024 + (ob ^ (((ob >> 9) & 1) << 5)); }
__host__ __device__ __forceinline__ void stage_rc(int b, int& R, int& C) { const int st = b / 1024, sb = b % 1024, swz = sb ^ (((sb >> 9) & 1) << 5); R = (st >> 1) * 16 + swz / 64; C = (st & 1) * 32 + (swz % 64) / 2; }
__host__ __device__ __forceinline__ int perm32(int rho) { const int n = rho >> 4, i = rho & 15; return 8 * (i >> 2) + 4 * n + (i & 3); }

__device__ __forceinline__ int lane_id_v() { int l; asm volatile("v_mbcnt_lo_u32_b32 %0, -1, 0\n\tv_mbcnt_hi_u32_b32 %0, -1, %0" : "=v"(l)); return l; }
typedef int rsrc4_t __attribute__((ext_vector_type(4)));
__device__ __forceinline__ rsrc4_t make_rsrc4(const void* base) { const unsigned long long b = (unsigned long long)base; rsrc4_t r; r.x = (int)(unsigned)b; r.y = (int)((unsigned)(b >> 32) & 0xffffu); r.z = 0x7ffffff0; r.w = 0x00020000; return r; }
__device__ __forceinline__ void bufdma16_asm(rsrc4_t rs, unsigned voff, unsigned soff, unsigned lds_dst) { unsigned keep;
    asm volatile("s_nop 4\n\ts_mov_b32 %0, m0\n\ts_mov_b32 m0, %4\n\ts_nop 0\n\tbuffer_load_dwordx4 %1, %2, %3 offen lds\n\ts_mov_b32 m0, %0" : "=&s"(keep) : "v"(voff), "s"(rs), "s"(soff), "s"(lds_dst) : "memory"); }
struct Unit { int pm, pn; };
struct Gemm { const bf16_t* A; const bf16_t* Bt; int M, N, K; const void* base; };

struct StaticOrder {
    static constexpr bool GATHER = false;
    int nM, nN, nwg, G, c;
    __host__ __device__ void init(int M, int N, int G_, int c_) { nM = M / BM; nN = N / BM; nwg = nM * nN; G = G_; c = c_; }
    __host__ __device__ bool next(int i, Unit& u) const {
        const long L = (long)i * G + c; if (L >= nwg) return false;
        int wgid = (int)L; { const int q = nwg / NXCD, r = nwg % NXCD, xcd = wgid % NXCD, off = wgid / NXCD; wgid = (xcd < r ? xcd * (q + 1) : r * (q + 1) + (xcd - r) * q) + off; }
        const int nig = WGM * nN, gid = wgid / nig, fm = gid * WGM, gsz = (nM - fm) < WGM ? (nM - fm) : WGM;
        u.pm = fm + ((wgid % nig) % gsz); u.pn = (wgid % nig) / gsz; return true;
    }
    __device__ __forceinline__ void a_ready(const Unit&) const {}
    __device__ __forceinline__ void done(const Unit&) const {}
};

__device__ __forceinline__ unsigned cvt_pk_bf16(float lo, float hi) { unsigned r; asm volatile("v_cvt_pk_bf16_f32 %0, %1, %2" : "=v"(r) : "v"(lo), "v"(hi)); return r; }
typedef float f32x2 __attribute__((ext_vector_type(2)));
__device__ __forceinline__ f32x2 gelu_pk(f32x2 v) {
    const f32x2 av = __builtin_elementwise_abs(v), d = av * 0.2316418882f + 1.0f;
    f32x2 t; t.x = __builtin_amdgcn_rcpf(d.x); t.y = __builtin_amdgcn_rcpf(d.y);
    f32x2 q = t * 0.5307027145f + (-0.7265760135f); q = q * t + 0.7107068705f; q = q * t + (-0.142248368f); q = q * t + 0.127414796f; q = q * t;
    const f32x2 s = (v * v) * (-0.72134752044f);
    f32x2 e; e.x = __builtin_amdgcn_exp2f(s.x); e.y = __builtin_amdgcn_exp2f(s.y);
    const f32x2 m = v * (q * e), r = v - m;
    f32x2 o; o.x = v.x < 0.f ? m.x : r.x; o.y = v.y < 0.f ? m.y : r.y; return o;
}

template <int ACT  > struct EpiBf16 {
    static constexpr bool PERM = true, AFTER_DRAIN = false, F8 = false; static_assert(ACT == 0 || ACT == 1, "EpiBf16: ACT is 0 (none) or 1 (gelu_pk)");
    bf16_t* O; int ldc; const float* bias; int split_cols; size_t split_stride; float scale0;
    __device__ __forceinline__ void operator()(const f32x4 (&acc)[2][2][4][2], const Unit& u, int wr, int wc, int fr, int fq) const {
        const int row0 = u.pm * BM + wr * 64 + fr; int colt = u.pn * BM; bf16_t* base = O;
        float sc = 1.f; if (split_cols) { const int t = colt / split_cols; base += (size_t)t * split_stride; colt -= t * split_cols; if (t == 0) sc = scale0; }
        const int col0 = colt + wc * 32 + 8 * fq, bcol0 = u.pn * BM + wc * 32 + 8 * fq;
        f32x4 bv[2][2];
#pragma unroll
        for (int bj = 0; bj < 2; ++bj)
#pragma unroll
            for (int n = 0; n < 2; ++n) bv[bj][n] = bias ? *(const f32x4*)(bias + bcol0 + bj * HALF + 4 * n) : (f32x4){0.f, 0.f, 0.f, 0.f};
#pragma unroll
        for (int ai = 0; ai < 2; ++ai)
#pragma unroll
            for (int m = 0; m < 4; ++m) { bf16_t* rowp = base + (size_t)(row0 + ai * HALF + m * 16) * ldc + col0;
#pragma unroll
                for (int bj = 0; bj < 2; ++bj) { f32x4 v0 = acc[ai][bj][m][0] + bv[bj][0], v1 = acc[ai][bj][m][1] + bv[bj][1];
                    if (ACT == 1) { f32x2 a = gelu_pk((f32x2){v0[0], v0[1]}), b = gelu_pk((f32x2){v0[2], v0[3]}), c = gelu_pk((f32x2){v1[0], v1[1]}), d = gelu_pk((f32x2){v1[2], v1[3]});
                        v0 = (f32x4){a.x, a.y, b.x, b.y}; v1 = (f32x4){c.x, c.y, d.x, d.y}; }
                    v0 = v0 * sc; v1 = v1 * sc; u32x4 w; w.x = cvt_pk_bf16(v0[0], v0[1]); w.y = cvt_pk_bf16(v0[2], v0[3]); w.z = cvt_pk_bf16(v1[0], v1[1]); w.w = cvt_pk_bf16(v1[2], v1[3]);
                    *(u32x4*)(rowp + bj * HALF) = w; } }
    }
};

__device__ __forceinline__ float silu_f(float g) { return g * __builtin_amdgcn_rcpf(1.0f + __builtin_amdgcn_exp2f(-1.4426950408889634f * g)); }
struct EpiResF32 {
    static constexpr bool PERM = true, AFTER_DRAIN = false, F8 = false;
    const float* x; bf16_t* y; const float* gate; int ldc; int rows_per_batch; int gate_stride; float alpha;
    __device__ __forceinline__ void operator()(const f32x4 (&acc)[2][2][4][2], const Unit& u, int wr, int wc, int fr, int fq) const {
        const int row0 = u.pm * BM + wr * 64 + fr, col0 = u.pn * BM + wc * 32 + 8 * fq;
        const float* gp = gate + (size_t)((u.pm * BM) / rows_per_batch) * gate_stride + col0;
        f32x4 gv[2][2];
#pragma unroll
        for (int bj = 0; bj < 2; ++bj)
#pragma unroll
            for (int n = 0; n < 2; ++n) gv[bj][n] = *(const f32x4*)(gp + bj * HALF + n * 4) + 1.0f;
#pragma unroll
        for (int ai = 0; ai < 2; ++ai)
#pragma unroll
            for (int m = 0; m < 4; ++m) { const size_t off = (size_t)(row0 + ai * HALF + m * 16) * ldc + col0;
#pragma unroll
                for (int bj = 0; bj < 2; ++bj) { const f32x4 x0 = *(const f32x4*)(x + off + bj * HALF), x1v = *(const f32x4*)(x + off + bj * HALF + 4);
                    const f32x4 v0 = x0 * alpha + gv[bj][0] * acc[ai][bj][m][0], v1 = x1v * alpha + gv[bj][1] * acc[ai][bj][m][1];
                    u32x4 w; w.x = cvt_pk_bf16(v0[0], v0[1]); w.y = cvt_pk_bf16(v0[2], v0[3]); w.z = cvt_pk_bf16(v1[0], v1[1]); w.w = cvt_pk_bf16(v1[2], v1[3]);
                    *(u32x4*)(y + off + bj * HALF) = w; } }
    }
};
struct EpiSwiGLU {
    static constexpr bool PERM = true, AFTER_DRAIN = false, F8 = (MOE_F8 != 0);
    bf16_t* H; const PG8_LAS float* wl; int ldh; int npn;
    __device__ __forceinline__ void operator()(const f32x4 (&acc)[2][2][4][2], const Unit& u, int wr, int wc, int fr, int fq) const {
        const int row0 = u.pm * BM + wr * 64 + fr, col0 = (u.pn % npn) * HALF + wc * 32 + 8 * fq;
        constexpr float inv = F8 ? 1.0f / (F8_SX * F8_SWG) : 1.0f;
#pragma unroll
        for (int ai = 0; ai < 2; ++ai)
#pragma unroll
            for (int m = 0; m < 4; ++m) { const int r = row0 + ai * HALF + m * 16; const float w8 = wl[(wr * 4 + wc) * 256 + wr * 64 + fr + ai * HALF + m * 16] * inv * (F8 ? F8_SH : 1.0f);
                const f32x4 g0 = acc[ai][0][m][0] * inv, g1 = acc[ai][0][m][1] * inv, u0 = acc[ai][1][m][0] * w8, u1 = acc[ai][1][m][1] * w8;
                float h[8];
#pragma unroll
                for (int q = 0; q < 4; ++q) { h[q] = silu_f(g0[q]) * u0[q]; h[4 + q] = silu_f(g1[q]) * u1[q]; }
                if (F8) {
                    typedef unsigned u32x2 __attribute__((ext_vector_type(2)));
                    if (F8_SH > 8.0f) {
#pragma unroll
                        for (int q = 0; q < 8; ++q) h[q] = __builtin_fminf(__builtin_fmaxf(h[q], -440.0f), 440.0f); }
                    int a = __builtin_amdgcn_cvt_pk_fp8_f32(h[0], h[1], 0, false); a = __builtin_amdgcn_cvt_pk_fp8_f32(h[2], h[3], a, true);
                    int b = __builtin_amdgcn_cvt_pk_fp8_f32(h[4], h[5], 0, false); b = __builtin_amdgcn_cvt_pk_fp8_f32(h[6], h[7], b, true);
                    u32x2 w; w.x = (unsigned)a; w.y = (unsigned)b; *(u32x2*)((unsigned char*)H + (size_t)r * ldh + col0) = w;
                } else {
                    u32x4 w; w.x = cvt_pk_bf16(h[0], h[1]); w.y = cvt_pk_bf16(h[2], h[3]); w.z = cvt_pk_bf16(h[4], h[5]); w.w = cvt_pk_bf16(h[6], h[7]);
                    *(u32x4*)(H + (size_t)r * ldh + col0) = w; } }
    }
};
struct EpiDown {
    static constexpr int PERM = Y_BF8 ? 2 : 1; static constexpr bool AFTER_DRAIN = false, F8 = (MOE_F8 != 0);
    bf16_t* Y; int ldc; int npn; int nostore;
    __device__ __forceinline__ void operator()(const f32x4 (&acc)[2][2][4][2], const Unit& u, int wr, int wc, int fr, int fq) const {
        const int row0 = u.pm * BM + wr * 64 + fr;
        if (Y_BF8) {
            const int col0 = (u.pn % npn) * BM + wc * 64 + 16 * fq;
#pragma unroll
            for (int ai = 0; ai < 2; ++ai)
#pragma unroll
                for (int m = 0; m < 4; ++m) { const int r = row0 + ai * HALF + m * 16; u32x4 w;
#pragma unroll
                    for (int bj = 0; bj < 2; ++bj)
#pragma unroll
                        for (int n = 0; n < 2; ++n) { const f32x4 v = acc[ai][bj][m][n] * (F8 ? 1.0f / (F8_SH * F8_SWD) : 1.0f); int a;
                            if (Y_BF8 == 2) { constexpr float ys = F8 ? 64.0f / (F8_SH * F8_SWD) : 64.0f; f32x4 sv = acc[ai][bj][m][n]; if (ys != 1.0f) sv = sv * ys;
#pragma unroll
                                for (int q = 0; q < 4; ++q) sv[q] = __builtin_amdgcn_fmed3f(sv[q], -440.0f, 440.0f);
                                a = __builtin_amdgcn_cvt_pk_fp8_f32(sv[0], sv[1], 0, false); a = __builtin_amdgcn_cvt_pk_fp8_f32(sv[2], sv[3], a, true);
                            } else { a = __builtin_amdgcn_cvt_pk_bf8_f32(v[0], v[1], 0, false); a = __builtin_amdgcn_cvt_pk_bf8_f32(v[2], v[3], a, true); }
                            w[2 * bj + n] = (unsigned)a; }
                    if (!nostore || w.x == 0x12345678u) *(u32x4*)((unsigned char*)Y + (size_t)r * ldc + col0) = w; }
        } else {
            const int col0 = (u.pn % npn) * BM + wc * 32 + 8 * fq;
#pragma unroll
            for (int ai = 0; ai < 2; ++ai)
#pragma unroll
                for (int m = 0; m < 4; ++m) { const int r = row0 + ai * HALF + m * 16;
#pragma unroll
                    for (int bj = 0; bj < 2; ++bj) { const f32x4 v0 = acc[ai][bj][m][0] * (F8 ? 1.0f / (F8_SH * F8_SWD) : 1.0f), v1 = acc[ai][bj][m][1] * (F8 ? 1.0f / (F8_SH * F8_SWD) : 1.0f);
                        u32x4 w; w.x = cvt_pk_bf16(v0[0], v0[1]); w.y = cvt_pk_bf16(v0[2], v0[3]); w.z = cvt_pk_bf16(v1[0], v1[1]); w.w = cvt_pk_bf16(v1[2], v1[3]);
                        if (!nostore || w.x == 0x12345678u) *(u32x4*)(Y + (size_t)r * ldc + col0 + bj * HALF) = w; } }
        }
    }
};
template <bool GATHER_> struct GroupedOrder {
    static constexpr bool GATHER = GATHER_;
    const PG8_LAS unsigned short* tslot; int ntiles, npn, G, c; const unsigned* vtab; int pin = 0; const float* wrow_g = nullptr;
    __device__ __forceinline__ bool next(int i, Unit& u) const {
        const int L = i * G + c; if (L >= ntiles * npn) return false;
        const int t = L / npn, p = L - t * npn; u.pm = t; u.pn = (int)tslot[t] * npn + p; if (pin) { u.pm = c & 3; u.pn = c & 7; } return true;
    }
    __device__ __forceinline__ void a_ready(const Unit&) const {}
    __device__ __forceinline__ void done(const Unit&) const {}
};


template <class Epi, class Sched, bool ALIGN_EPI = false, bool SP2 = false>
__device__ __forceinline__ void gemm_phase(PG8_LAS unsigned char* lds, const Gemm g, const Sched& S, const Epi& E, const int wid) {
    const int lane = lane_id_v(), tid = wid * 64 + lane, wr = wid >> 2, wc = wid & 3, fr = lane & 15, fq = lane >> 4;
    const int K = g.K, nt = K / BK;
    unsigned voffA[2], voffA1[2], voffB[2];
#pragma unroll
    for (int i = 0; i < 2; ++i) { int R, C; stage_rc(tid * 16 + i * 8192, R, C); const int rho = R & 31;
        const int Rb = ((int)Epi::PERM == 2) ? (64 * (R >> 5) + 16 * ((rho & 15) >> 2) + 4 * (rho >> 4) + (rho & 3)) : (Epi::PERM ? ((R & ~31) + perm32(rho)) : R);
        voffA[i] = (unsigned)(R * K + C) * 2u; voffA1[i] = voffA[i] + (unsigned)(HALF * K * 2); voffB[i] = (unsigned)(Rb * K + C) * 2u; }
    const size_t kstep = (size_t)(BK * 2);
    const size_t hstep = (size_t)HALF * K * 2;
    const size_t tstep = 2 * hstep;
    const size_t bh1 = ((int)Epi::PERM == 2) ? (size_t)8 * K * 2 : hstep;
    const unsigned ldsw = (unsigned)wid * 1024u;
    const int aoff = lds_byte(wr * 64 + fr, fq * 8), boff = lds_byte(wc * 32 + fr, fq * 8);
#define PG8_SA(b, h) (((b) * 2 + (h)) * HTB)
#define PG8_SB(b, h) ((4 + (b) * 2 + (h)) * HTB)
    const __amdgpu_buffer_rsrc_t rs_ = __builtin_amdgcn_make_buffer_rsrc((void*)g.base, (short)0, 0x7ffffff0, 0x00020000);
#define PG8_STAGE(bufoff, gbase, voff) do { _Pragma("unroll") for (int _i = 0; _i < 2; ++_i) \
        __builtin_amdgcn_raw_ptr_buffer_load_lds(rs_, (PG8_LAS unsigned*)(lds + (bufoff) + ldsw + _i * 8192), 16, (int)(voff)[_i], (int)((const char*)(gbase) - (const char*)g.base), 0, 0); } while (0)
#define PG8_STAGE_A1(bufoff, gbase) do { if constexpr (Sched::GATHER) PG8_STAGE(bufoff, gbase, voffA1); else PG8_STAGE(bufoff, (gbase) + hstep, voffA); } while (0)
#define PG8_LDA(dst, b, h) do { if constexpr (Epi::F8) { _Pragma("unroll") for (int m = 0; m < 4; ++m) { const i32x4_ l0_ = *(const PG8_LAS i32x4_*)(lds + PG8_SA(b, h) + aoff + m * 2048), l1_ = *(const PG8_LAS i32x4_*)(lds + PG8_SA(b, h) + aoff + m * 2048 + 1024); dst##8[m] = __builtin_shufflevector(l0_, l1_, 0, 1, 2, 3, 4, 5, 6, 7); } } \
        else { _Pragma("unroll") for (int m = 0; m < 4; ++m) _Pragma("unroll") for (int k = 0; k < 2; ++k) dst[m][k] = *(const PG8_LAS bf16x8*)(lds + PG8_SA(b, h) + aoff + m * 2048 + k * 1024); } } while (0)
#define PG8_LDB(dst, b, h) do { if constexpr (Epi::F8) { _Pragma("unroll") for (int n = 0; n < 2; ++n) { const i32x4_ l0_ = *(const PG8_LAS i32x4_*)(lds + PG8_SB(b, h) + boff + n * 2048), l1_ = *(const PG8_LAS i32x4_*)(lds + PG8_SB(b, h) + boff + n * 2048 + 1024); dst##8[n] = __builtin_shufflevector(l0_, l1_, 0, 1, 2, 3, 4, 5, 6, 7); } } \
        else { _Pragma("unroll") for (int n = 0; n < 2; ++n) _Pragma("unroll") for (int k = 0; k < 2; ++k) dst[n][k] = *(const PG8_LAS bf16x8*)(lds + PG8_SB(b, h) + boff + n * 2048 + k * 1024); } } while (0)
#define PG8_MMA(ai, bj, At, Bt) do { __builtin_amdgcn_s_setprio(1); \
        if constexpr (Epi::F8) { _Pragma("unroll") for (int m = 0; m < 4; ++m) _Pragma("unroll") for (int n = 0; n < 2; ++n) \
                acc[ai][bj][m][n] = __builtin_amdgcn_mfma_scale_f32_16x16x128_f8f6f4(Bt##8[n], At##8[m], acc[ai][bj][m][n], 0, 0, 0, 0, 0, 0); \
        } else { _Pragma("unroll") for (int m = 0; m < 4; ++m) _Pragma("unroll") for (int n = 0; n < 2; ++n) _Pragma("unroll") for (int k = 0; k < 2; ++k) \
        acc[ai][bj][m][n] = __builtin_amdgcn_mfma_f32_16x16x32_bf16(Bt[n][k], At[m][k], acc[ai][bj][m][n], 0, 0, 0); } __builtin_amdgcn_s_setprio(0); } while (0)
#define PG8_MMA_Z(ai, bj, At, Bt) do { __builtin_amdgcn_s_setprio(1); const f32x4 z_ = {0.f, 0.f, 0.f, 0.f}; \
        if constexpr (Epi::F8) { _Pragma("unroll") for (int m = 0; m < 4; ++m) _Pragma("unroll") for (int n = 0; n < 2; ++n) \
                acc[ai][bj][m][n] = __builtin_amdgcn_mfma_scale_f32_16x16x128_f8f6f4(Bt##8[n], At##8[m], z_, 0, 0, 0, 0, 0, 0); \
        } else { _Pragma("unroll") for (int m = 0; m < 4; ++m) _Pragma("unroll") for (int n = 0; n < 2; ++n) { \
        acc[ai][bj][m][n] = __builtin_amdgcn_mfma_f32_16x16x32_bf16(Bt[n][0], At[m][0], z_, 0, 0, 0); acc[ai][bj][m][n] = __builtin_amdgcn_mfma_f32_16x16x32_bf16(Bt[n][1], At[m][1], acc[ai][bj][m][n], 0, 0, 0); } } __builtin_amdgcn_s_setprio(0); } while (0)
#define PG8_WAIT_V(n) asm volatile("s_waitcnt vmcnt(" #n ")" ::: "memory")
#define PG8_WAIT_L(n) asm volatile("s_waitcnt lgkmcnt(" #n ")" ::: "memory")
#define PG8_BAR __builtin_amdgcn_s_barrier()
#define PG8_SCHED __builtin_amdgcn_sched_barrier(0)
    Unit cur, nxt; int ui = 0;
    if (!S.next(0, cur)) return;
    f32x4 acc[2][2][4][2];
#pragma unroll
    for (int a = 0; a < 2; ++a)
#pragma unroll
        for (int b = 0; b < 2; ++b)
#pragma unroll
            for (int m = 0; m < 4; ++m)
#pragma unroll
                for (int n = 0; n < 2; ++n) { acc[a][b][m][n] = (f32x4){0.f, 0.f, 0.f, 0.f}; if constexpr (Epi::F8 && !SP2) asm volatile("" : "+v"(acc[a][b][m][n])); }
    typedef int i32x4_ __attribute__((ext_vector_type(4))); typedef int i32x8_ __attribute__((ext_vector_type(8)));
    bf16x8 At[4][2], B0[2][2], B1[2][2]; i32x8_ At8[4], B08[2], B18[2];
    const char* cA = Sched::GATHER ? (const char*)g.A : (const char*)g.A + (size_t)cur.pm * tstep; const char* cB = (const char*)g.Bt + (size_t)cur.pn * tstep;
    S.a_ready(cur);
    if constexpr (Sched::GATHER) {
        static_assert(SP2, "gather: SP2 loop only");
        __builtin_amdgcn_global_load_lds((const unsigned*)(S.vtab + ((size_t)0 * 512 + tid) * 4), (PG8_LAS unsigned*)(lds + VT_SLOT + wid * 1024), 16, 0, 0);
        PG8_WAIT_V(0);
        const u32x4 e4 = *(const PG8_LAS u32x4*)(lds + VT_SLOT + tid * 16); voffA[0] = e4.x; voffA[1] = e4.y; voffA1[0] = e4.z; voffA1[1] = e4.w;
    }
    if constexpr (SP2) {
        PG8_STAGE(PG8_SB(0, 0), cB, voffB); PG8_STAGE(PG8_SB(0, 1), cB + bh1, voffB); PG8_STAGE(PG8_SA(0, 0), cA, voffA); PG8_STAGE_A1(PG8_SA(0, 1), cA);
        if (wr == 1) PG8_BAR;
        PG8_WAIT_V(2); PG8_BAR;
        PG8_STAGE(PG8_SB(1, 0), cB + kstep, voffB); PG8_STAGE(PG8_SA(1, 0), cA + kstep, voffA); PG8_STAGE(PG8_SB(1, 1), cB + bh1 + kstep, voffB);
        PG8_WAIT_V(6); PG8_BAR;
    } else {
        PG8_STAGE(PG8_SB(0, 0), cB, voffB); PG8_STAGE(PG8_SA(0, 0), cA, voffA); PG8_STAGE(PG8_SB(0, 1), cB + hstep, voffB); PG8_STAGE(PG8_SA(0, 1), cA + hstep, voffA);
        if (wr == 1) PG8_BAR;
        PG8_WAIT_V(4); PG8_BAR;
        PG8_STAGE(PG8_SB(1, 0), cB + kstep, voffB); PG8_STAGE(PG8_SA(1, 0), cA + kstep, voffA); PG8_STAGE(PG8_SB(1, 1), cB + hstep + kstep, voffB);
        PG8_WAIT_V(6); PG8_BAR;
    }
    for (;;) {
        const bool has_next = S.next(ui + 1, nxt);
        const char* nA = (has_next && !Sched::GATHER) ? (const char*)g.A + (size_t)nxt.pm * tstep : cA; const char* nB = has_next ? (const char*)g.Bt + (size_t)nxt.pn * tstep : cB;
        for (int t = 0; t < nt; t += 2) {
            const bool last = (t == nt - 2);
            const char* a1 = cA + (size_t)(t + 1) * kstep;
            const char* a2 = last ? nA : cA + (size_t)(t + 2) * kstep; const char* b2 = last ? nB : cB + (size_t)(t + 2) * kstep;
            const char* a3 = a2 + kstep; const char* b3 = b2 + kstep;
            if (last && has_next) S.a_ready(nxt);
            if constexpr (SP2) {
            if constexpr (Sched::GATHER) { if (t == 0)
                bufdma16_asm(make_rsrc4(g.base), (unsigned)lane_id_v() * 16u, (unsigned)__builtin_amdgcn_readfirstlane((int)((const char*)(S.wrow_g + (size_t)cur.pm * 256) - (const char*)g.base)), (unsigned)__builtin_amdgcn_readfirstlane((int)(size_t)(lds + WR_SLOT + wid * 1024))); }
            if constexpr (Sched::GATHER) { if (t == 0 && has_next)
                __builtin_amdgcn_global_load_lds((const unsigned*)(S.vtab + ((size_t)(ui + 1) * 512 + tid) * 4), (PG8_LAS unsigned*)(lds + VT_SLOT + wid * 1024), 16, 0, 0); }
            PG8_LDB(B0, 0, 0); PG8_LDB(B1, 0, 1); PG8_SCHED; PG8_LDA(At, 0, 0); PG8_STAGE_A1(PG8_SA(1, 1), a1);
            PG8_WAIT_V(8); PG8_WAIT_L(0); PG8_BAR; if (t == 0) { PG8_MMA_Z(0, 0, At, B0); PG8_MMA_Z(0, 1, At, B1); } else { PG8_MMA(0, 0, At, B0); PG8_MMA(0, 1, At, B1); } PG8_BAR; PG8_SCHED;
            if constexpr (Sched::GATHER) { if (last && has_next) {
                const u32x4 e4 = *(const PG8_LAS u32x4*)(lds + VT_SLOT + tid * 16); voffA[0] = e4.x; voffA[1] = e4.y; voffA1[0] = e4.z; voffA1[1] = e4.w; } }
            PG8_LDA(At, 0, 1); PG8_STAGE(PG8_SB(0, 0), b2, voffB); PG8_STAGE(PG8_SB(0, 1), b2 + bh1, voffB); PG8_STAGE(PG8_SA(0, 0), a2, voffA);
            PG8_WAIT_V(8); PG8_WAIT_L(0); PG8_BAR; if (t == 0) { PG8_MMA_Z(1, 0, At, B0); PG8_MMA_Z(1, 1, At, B1); } else { PG8_MMA(1, 0, At, B0); PG8_MMA(1, 1, At, B1); } PG8_BAR; PG8_SCHED;
            PG8_LDB(B0, 1, 0); PG8_LDB(B1, 1, 1); PG8_SCHED; PG8_LDA(At, 1, 0); PG8_STAGE_A1(PG8_SA(0, 1), a2);
            PG8_WAIT_V(8); PG8_WAIT_L(0); PG8_BAR; PG8_MMA(0, 0, At, B0); PG8_MMA(0, 1, At, B1); PG8_BAR; PG8_SCHED;
            PG8_LDA(At, 1, 1); PG8_STAGE(PG8_SB(1, 0), b3, voffB); PG8_STAGE(PG8_SB(1, 1), b3 + bh1, voffB); PG8_STAGE(PG8_SA(1, 0), a3, voffA);
            PG8_WAIT_V(8); PG8_WAIT_L(0); PG8_BAR; PG8_MMA(1, 0, At, B0); PG8_MMA(1, 1, At, B1); PG8_BAR; PG8_SCHED;
            } else {
            PG8_LDB(B0, 0, 0); PG8_SCHED; PG8_LDA(At, 0, 0); PG8_STAGE(PG8_SA(1, 1), a1 + hstep, voffA);
            PG8_WAIT_L(8); PG8_BAR; PG8_WAIT_L(0); PG8_MMA(0, 0, At, B0); PG8_BAR; PG8_SCHED;
            PG8_LDB(B1, 0, 1); PG8_STAGE(PG8_SB(0, 0), b2, voffB);
            PG8_BAR; PG8_WAIT_L(0); PG8_MMA(0, 1, At, B1); PG8_BAR;
            PG8_LDA(At, 0, 1); PG8_STAGE(PG8_SA(0, 0), a2, voffA);
            PG8_BAR; PG8_WAIT_L(0); PG8_MMA(1, 0, At, B0); PG8_BAR; PG8_SCHED;
            PG8_STAGE(PG8_SB(0, 1), b2 + hstep, voffB);
            PG8_WAIT_V(6); PG8_BAR; PG8_MMA(1, 1, At, B1); PG8_BAR;
            PG8_LDB(B0, 1, 0); PG8_SCHED; PG8_LDA(At, 1, 0); PG8_STAGE(PG8_SA(0, 1), a2 + hstep, voffA);
            PG8_WAIT_L(8); PG8_BAR; PG8_WAIT_L(0); PG8_MMA(0, 0, At, B0); PG8_BAR; PG8_SCHED;
            PG8_LDB(B1, 1, 1); PG8_STAGE(PG8_SB(1, 0), b3, voffB);
            PG8_BAR; PG8_WAIT_L(0); PG8_MMA(0, 1, At, B1); PG8_BAR;
            PG8_LDA(At, 1, 1); PG8_STAGE(PG8_SA(1, 0), a3, voffA);
            PG8_BAR; PG8_WAIT_L(0); PG8_MMA(1, 0, At, B0); PG8_BAR; PG8_SCHED;
            PG8_STAGE(PG8_SB(1, 1), b3 + hstep, voffB);
            PG8_WAIT_V(6); PG8_BAR; PG8_MMA(1, 1, At, B1); PG8_BAR;
            }
        }
        if constexpr (ALIGN_EPI) { if (wr == 0) PG8_BAR; }
        if constexpr (!Epi::AFTER_DRAIN) { const int le_ = lane_id_v(); E(acc, cur, wr, wc, le_ & 15, le_ >> 4); S.done(cur); }
        if (!has_next) break;
        if constexpr (!SP2) {
#pragma unroll
        for (int a = 0; a < 2; ++a)
#pragma unroll
            for (int b = 0; b < 2; ++b)
#pragma unroll
                for (int m = 0; m < 4; ++m)
#pragma unroll
                    for (int n = 0; n < 2; ++n) acc[a][b][m][n] = (f32x4){0.f, 0.f, 0.f, 0.f}; }
        cur = nxt; cA = nA; cB = nB; ++ui;
        if constexpr (ALIGN_EPI) { if (wr == 1) PG8_BAR; }
    }
    PG8_WAIT_V(0);
    if constexpr (!ALIGN_EPI) { if (wr == 0) PG8_BAR; }
    PG8_BAR;
    if constexpr (Epi::AFTER_DRAIN) { E.fused(acc, cur, wr, wc, fr, fq, lds, wid, lane); S.done(cur); }
#undef PG8_SA
#undef PG8_SB
#undef PG8_STAGE
#undef PG8_LDA
#undef PG8_LDB
#undef PG8_MMA
#undef PG8_WAIT_V
#undef PG8_WAIT_L
#undef PG8_BAR
#undef PG8_SCHED
}
}

#ifndef PG8_SP2
#define PG8_SP2 true
#endif
#ifndef PG8_ALIGN
#define PG8_ALIGN true
#endif
#ifndef DOWN_STAGGER
#define DOWN_STAGGER 0
#endif
#ifndef CONV_NT
#define CONV_NT 1
#endif
#ifndef P5_MAIN_Q
#define P5_MAIN_Q 16
#endif
#ifndef P6_MIN_CONV
#define P6_MIN_CONV 0
#endif
#ifndef PROBE_STAMP
#define PROBE_STAMP -1
#endif
#ifndef PROBE_PIN
#define PROBE_PIN 0
#endif
#ifndef PROBE_NOSTORE
#define PROBE_NOSTORE 0
#endif
#ifndef REP_PHASE
#define REP_PHASE -1
#endif
#ifndef MK_PER_PHASE
#define MK_PER_PHASE 0
#endif

constexpr int NB = 2, SEQ = 4096, D = 2048, M = NB * SEQ;
constexpr int AW = 1024, NQH = 16, NKVH = 4, HD = 64, KVW = 256, CW = 1024, INW = 4608;
constexpr int COL_K = 1024, COL_V = 1280, COL_CB = 1536, COL_CC = 2560, COL_CH = 3584;
constexpr int NE = 64, TOPK = 8, DE = 512, NSLOT = NE + 1;
constexpr int MAXT = 32 + 256 + 64, MAXR = MAXT * 256;
constexpr float ALPHA = 1.189207115002721f;
constexpr float LN_EPS = 1e-5f, RSCALE = 2.5f;
constexpr int NWAVES = 8, NTHR = 512;
constexpr int KSL = 8;

constexpr size_t MiB = 1u << 20;
constexpr size_t WS_CTL = 0, CTL_ZERO_BYTES = 1 * MiB;
constexpr size_t WS_PART = 1 * MiB;
constexpr size_t WS_MODF = 2 * MiB;
constexpr size_t WS_WRT = 3 * MiB;
constexpr size_t WS_ROWTOK = 4 * MiB;
constexpr size_t WS_ROWW = 6 * MiB;
constexpr size_t WS_TOKSLOT = 8 * MiB;
constexpr size_t WS_WROW = 9 * MiB;
constexpr size_t WS_WINT = 10 * MiB;
constexpr size_t WS_WOUTT = 28 * MiB;
constexpr size_t WS_WGUT = 36 * MiB;
constexpr size_t WS_WDT = 296 * MiB;
constexpr size_t WS_X1 = 426 * MiB;
constexpr size_t WS_H = 490 * MiB;
constexpr size_t WS_XG = 578 * MiB;
constexpr size_t WS_HB = 610 * MiB;
constexpr size_t WS_PROJ = 642 * MiB;
constexpr size_t WS_MIX = 714 * MiB;
constexpr size_t WS_Y1 = 746 * MiB;
constexpr size_t WS_VTAB = 930 * MiB;
constexpr size_t WS_END = 946 * MiB;
static_assert(WS_XG + (size_t)MAXR * D * 2 <= WS_VTAB && WS_H + (size_t)MAXR * DE * 2 <= WS_XG && WS_Y1 + (size_t)M * D * 4 <= WS_VTAB, "ws map");
static_assert(WS_WGUT + (size_t)NSLOT * 1024 * D * 2 <= WS_WDT && WS_WDT + (size_t)NSLOT * D * DE * 2 <= WS_X1 && WS_X1 + (size_t)M * D * 4 <= WS_H, "ws map 2");
constexpr int CW_TMO = 0;
constexpr int CW_BAR = 4096;
constexpr int CW_Q = 8192;
constexpr int CW_FIN = 8448;
constexpr int CW_CNT = 16384;

constexpr int RING_OFF = 0, RING_BYTES = 131072;
constexpr int LDSCTL_OFF = RING_BYTES, MISC_OFF = LDSCTL_OFF + 320;
constexpr int TS_OFF = LDSCTL_OFF + 512;
constexpr int POFF_OFF = LDSCTL_OFF + 1280;
constexpr int LDS_BYTES = 155648;

#define GAS __attribute__((address_space(1)))
#define LAS __attribute__((address_space(3)))
typedef unsigned short bf16;
typedef unsigned v4u __attribute__((ext_vector_type(4)));
typedef unsigned v2u __attribute__((ext_vector_type(2)));
typedef float f32x4 __attribute__((ext_vector_type(4)));
typedef short bf16x8 __attribute__((ext_vector_type(8)));
typedef GAS unsigned gu32;
#define RLX_AGENT __ATOMIC_RELAXED, __HIP_MEMORY_SCOPE_AGENT
#define LDS_WAIT() asm volatile("s_waitcnt lgkmcnt(0)" ::: "memory")
#define VM_WAIT() asm volatile("s_waitcnt vmcnt(0)" ::: "memory")
__device__ __forceinline__ unsigned f2bf(float f) { unsigned u = __builtin_bit_cast(unsigned, f); return (u + 0x7fffu + ((u >> 16) & 1u)) >> 16; }
__device__ __forceinline__ unsigned pk2(float lo, float hi) { return f2bf(lo) | (f2bf(hi) << 16); }
__device__ __forceinline__ float bf2f(unsigned h) { return __builtin_bit_cast(float, h << 16); }
__device__ __forceinline__ float bflo(unsigned w) { return __builtin_bit_cast(float, w << 16); }
__device__ __forceinline__ float bfhi(unsigned w) { return __builtin_bit_cast(float, w & 0xffff0000u); }

#define XB_TMO      128
#define XB_XCNT(j)  (256  + 64 * (j))
#define XB_XSUB(j)  (1280 + 64 * (j))
#define XB_XGEN(j)  (2304 + 64 * (j))
#define XB_TOP      3328
#define XB_TOPGEN   3392
#define XCD_BAR_WORDS 3456
#define XB_SPIN_CAP (1u << 18)
__device__ __forceinline__ unsigned xb_ld(unsigned* p)              { return __hip_atomic_load(p, __ATOMIC_RELAXED, __HIP_MEMORY_SCOPE_AGENT); }
__device__ __forceinline__ unsigned xb_add(unsigned* p, unsigned v) { return __hip_atomic_fetch_add(p, v, __ATOMIC_RELAXED, __HIP_MEMORY_SCOPE_AGENT); }
__device__ __forceinline__ unsigned xb_xcc_id() { return (unsigned)__builtin_amdgcn_s_getreg((3 << 11) | 20) & 0xFu; }
#define XB_SPIN(cond, bar) do { unsigned _sp = 0; while (cond) { __builtin_amdgcn_s_sleep(1); \
    if ((++_sp & 255u) == 0u) { if (xb_ld(&(bar)[XB_TMO])) break; if (_sp > XB_SPIN_CAP) { atomicAdd(&(bar)[XB_TMO], 1u); break; } } } } while (0)
struct XcdBarrier { unsigned* bar; unsigned x; volatile LAS unsigned* st; };
__device__ __forceinline__ XcdBarrier xcd_barrier_post(unsigned* bar, volatile LAS unsigned* st) {
    XcdBarrier b; b.bar = bar; b.x = xb_xcc_id(); b.st = st;
    if (threadIdx.x == 0) (void)xb_add(&bar[XB_XCNT(b.x)], 1u);
    return b;
}
__device__ __forceinline__ void xcd_barrier_complete(unsigned* bar, unsigned x, unsigned& nloc, unsigned& nx) {
    const unsigned G = gridDim.x * gridDim.y * gridDim.z;
    unsigned sum, cnt, mine, sp = 0u;
    for (;;) {
        sum = 0u; cnt = 0u; mine = 0u;
#pragma unroll
        for (unsigned j = 0; j < 16; ++j) { const unsigned c = xb_ld(&bar[XB_XCNT(j)]); sum += c; cnt += (c > 0u) ? 1u : 0u; mine = (j == x) ? c : mine; }
        if (sum == G) break;
        __builtin_amdgcn_s_sleep(1);
        if ((++sp & 255u) == 0u) { if (xb_ld(&bar[XB_TMO])) break; if (sp > XB_SPIN_CAP) { atomicAdd(&bar[XB_TMO], 1u); break; } }
    }
    nloc = mine > 0u ? mine : 1u; nx = cnt > 0u ? cnt : 1u;
}
__device__ __forceinline__ void xcd_barrier(const XcdBarrier& b) {
    asm volatile("s_waitcnt vmcnt(0)" ::: "memory");
    __syncthreads();
    if (threadIdx.x == 0) {
        unsigned* bar = b.bar;
        __builtin_amdgcn_s_waitcnt(0);
        unsigned nloc = b.st[0], nx = b.st[1];
        if (nloc == 0u) { xcd_barrier_complete(bar, b.x, nloc, nx); b.st[0] = nloc; b.st[1] = nx; }
        const unsigned old = xb_add(&bar[XB_XSUB(b.x)], 1u);
        const unsigned gen = old / nloc;
        if (old + 1u == (gen + 1u) * nloc) {
            __builtin_amdgcn_fence(__ATOMIC_RELEASE, "agent");
            asm volatile("s_waitcnt vmcnt(0)" ::: "memory");
            const unsigned og = xb_add(&bar[XB_TOP], 1u);
            const unsigned tg = og / nx;
            if (og + 1u == (tg + 1u) * nx) xb_add(&bar[XB_TOPGEN], 1u);
            else XB_SPIN(xb_ld(&bar[XB_TOPGEN]) == tg, bar);
            __builtin_amdgcn_fence(__ATOMIC_ACQUIRE, "agent");
            xb_add(&bar[XB_XGEN(b.x)], 1u);
            asm volatile("s_waitcnt vmcnt(0)" ::: "memory");
        } else {
            XB_SPIN(xb_ld(&bar[XB_XGEN(b.x)]) == gen, bar);
            __builtin_amdgcn_fence(__ATOMIC_ACQUIRE, "agent");
            asm volatile("s_waitcnt vmcnt(0)" ::: "memory");
        }
    }
    __syncthreads();
}

struct Frame {
    LAS unsigned char* lds;
    volatile LAS unsigned* MISC;
    gu32* ctl;
    int tid, lane, wave;
    int vcu, G;
    unsigned char* ws;
    const float *x, *c, *w_mod, *b_mod, *w_in, *conv_w, *sinks, *w_out, *ln1_g, *ln1_b, *w_router, *router_bias, *w_gate, *w_up, *w_down, *ws_gate, *ws_up, *ws_down, *ln2_g, *ln2_b;
    float* out;
};
__device__ __forceinline__ float wave_sum(float v) {
#pragma unroll
    for (int o = 1; o < 64; o <<= 1) v += __shfl_xor(v, o);
    return v;
}

__device__ __forceinline__ void p0_transpose_item(const float* src, int ldw, bf16* dst, int ldt, LAS float* scr, int lane) {
    { const float* sp = src + (size_t)(lane >> 5) * ldw + (lane & 31); LAS float* dp = scr + (lane >> 5) * 33 + (lane & 31);
#pragma unroll 1
      for (int h = 0; h < 2; ++h) { float tv[16];
#pragma unroll
        for (int i = 0; i < 16; ++i) tv[i] = sp[(size_t)(2 * i) * ldw];
#pragma unroll
        for (int i = 0; i < 16; ++i) dp[(2 * i) * 33] = tv[i];
        sp += (size_t)32 * ldw; dp += 32 * 33; } }
    LDS_WAIT(); asm volatile("" ::: "memory");
    const int c = lane & 7;
#pragma unroll
    for (int j = 0; j < 4; ++j) { const int n = (lane >> 3) + 8 * j; const LAS float* s = scr + (8 * c) * 33 + n;
        v4u o; o.x = pk2(s[0 * 33], s[1 * 33]); o.y = pk2(s[2 * 33], s[3 * 33]); o.z = pk2(s[4 * 33], s[5 * 33]); o.w = pk2(s[6 * 33], s[7 * 33]);
        *(GAS v4u*)(dst + (size_t)n * ldt + 8 * c) = o; }
    LDS_WAIT(); asm volatile("" ::: "memory");
}
constexpr int SCRP = 136;
__device__ __forceinline__ void conv64(const float* src, int ldw, bf16* dst, int ldt, LAS unsigned char* scr, int lane) {
    const int kr = lane >> 4, nq = lane & 15;
    const float* sp = src + (size_t)kr * ldw + 4 * nq;
    f32x4 tv[16];
#pragma unroll
    for (int i = 0; i < 16; ++i) tv[i] = CONV_NT ? __builtin_nontemporal_load((const GAS f32x4*)(sp + (size_t)(4 * i) * ldw)) : *(const GAS f32x4*)(sp + (size_t)(4 * i) * ldw);
#pragma unroll
    for (int i = 0; i < 16; ++i) { v2u w; w.x = pk2(tv[i].x, tv[i].y); w.y = pk2(tv[i].z, tv[i].w); *(LAS v2u*)(scr + (4 * i + kr) * SCRP + 8 * nq) = w; }
    LDS_WAIT(); asm volatile("" ::: "memory");
    const int c = lane & 7;
#pragma unroll
    for (int j = 0; j < 8; ++j) { const int n = (lane >> 3) + 8 * j; const LAS unsigned short* p = (const LAS unsigned short*)(scr + (8 * c) * SCRP + 2 * n);
        v4u o; o.x = (unsigned)p[0] | ((unsigned)p[SCRP / 2] << 16); o.y = (unsigned)p[2 * (SCRP / 2)] | ((unsigned)p[3 * (SCRP / 2)] << 16);
        o.z = (unsigned)p[4 * (SCRP / 2)] | ((unsigned)p[5 * (SCRP / 2)] << 16); o.w = (unsigned)p[6 * (SCRP / 2)] | ((unsigned)p[7 * (SCRP / 2)] << 16);
        if (CONV_NT) __builtin_nontemporal_store(o, (GAS v4u*)(dst + (size_t)n * ldt + 8 * c)); else *(GAS v4u*)(dst + (size_t)n * ldt + 8 * c) = o; }
    LDS_WAIT(); asm volatile("" ::: "memory");
}
constexpr int SCRP8 = 68;
__device__ __forceinline__ void conv64_f8(const float* src, int ldw, unsigned char* dst, int ldt, LAS unsigned char* scr, int lane, float scale) {
    const int kr = lane >> 4, nq = lane & 15;
    const float* sp = src + (size_t)kr * ldw + 4 * nq;
    f32x4 tv[16];
#pragma unroll
    for (int i = 0; i < 16; ++i) tv[i] = CONV_NT ? __builtin_nontemporal_load((const GAS f32x4*)(sp + (size_t)(4 * i) * ldw)) : *(const GAS f32x4*)(sp + (size_t)(4 * i) * ldw);
#pragma unroll
    for (int i = 0; i < 16; ++i) { const f32x4 t = tv[i] * scale; int a = __builtin_amdgcn_cvt_pk_fp8_f32(t.x, t.y, 0, false); a = __builtin_amdgcn_cvt_pk_fp8_f32(t.z, t.w, a, true);
        *(LAS unsigned*)(scr + (4 * i + kr) * SCRP8 + 4 * nq) = (unsigned)a; }
    LDS_WAIT(); asm volatile("" ::: "memory");
    const int c = lane & 3;
#pragma unroll
    for (int j = 0; j < 4; ++j) { const int n = (lane >> 2) + 16 * j; const LAS unsigned char* p = scr + (16 * c) * SCRP8 + n;
        unsigned o[4];
#pragma unroll
        for (int q = 0; q < 4; ++q) o[q] = (unsigned)p[(4 * q) * SCRP8] | ((unsigned)p[(4 * q + 1) * SCRP8] << 8) | ((unsigned)p[(4 * q + 2) * SCRP8] << 16) | ((unsigned)p[(4 * q + 3) * SCRP8] << 24);
        v4u ov; ov.x = o[0]; ov.y = o[1]; ov.z = o[2]; ov.w = o[3];
        if (CONV_NT) __builtin_nontemporal_store(ov, (GAS v4u*)(dst + (size_t)n * ldt + 16 * c)); else *(GAS v4u*)(dst + (size_t)n * ldt + 16 * c) = ov; }
    LDS_WAIT(); asm volatile("" ::: "memory");
}
__device__ __forceinline__ void p0_transpose_item_hilo(const float* src, int ldw, bf16* dhi, bf16* dlo, int ldt, LAS float* scr, int lane) {
    { const float* sp = src + (size_t)(lane >> 5) * ldw + (lane & 31); LAS float* dp = scr + (lane >> 5) * 33 + (lane & 31);
#pragma unroll 1
      for (int h = 0; h < 2; ++h) { float tv[16];
#pragma unroll
        for (int i = 0; i < 16; ++i) tv[i] = sp[(size_t)(2 * i) * ldw];
#pragma unroll
        for (int i = 0; i < 16; ++i) dp[(2 * i) * 33] = tv[i];
        sp += (size_t)32 * ldw; dp += 32 * 33; } }
    LDS_WAIT(); asm volatile("" ::: "memory");
    const int c = lane & 7;
#pragma unroll
    for (int j = 0; j < 4; ++j) { const int n = (lane >> 3) + 8 * j; const LAS float* s = scr + (8 * c) * 33 + n;
        float v[8]; unsigned h[8], l[8];
#pragma unroll
        for (int q = 0; q < 8; ++q) { v[q] = s[q * 33]; h[q] = f2bf(v[q]); l[q] = f2bf(v[q] - bf2f(h[q])); }
        v4u o; o.x = h[0] | (h[1] << 16); o.y = h[2] | (h[3] << 16); o.z = h[4] | (h[5] << 16); o.w = h[6] | (h[7] << 16);
        *(GAS v4u*)(dhi + (size_t)n * ldt + 8 * c) = o;
        o.x = l[0] | (l[1] << 16); o.y = l[2] | (l[3] << 16); o.z = l[4] | (l[5] << 16); o.w = l[6] | (l[7] << 16);
        *(GAS v4u*)(dlo + (size_t)n * ldt + 8 * c) = o; }
    LDS_WAIT(); asm volatile("" ::: "memory");
}
constexpr int I_G = (D / 64) * (DE / 64), I_D = (DE / 64) * (D / 64);
constexpr int QB_ITEMS = NE * 2 * I_G, QC_ITEMS = NE * I_D, CONV_CH = 8;
__device__ __forceinline__ void conv_item_gu(Frame& F, int s, int q, LAS float* scr) {
    const int up = q / I_G, q2 = q % I_G, nblk = DE / 64, kb = q2 / nblk, nb = q2 % nblk, n0 = 64 * nb;
    const float* W = up ? (s == 0 ? F.ws_up : F.w_up + (size_t)(s - 1) * D * DE) : (s == 0 ? F.ws_gate : F.w_gate + (size_t)(s - 1) * D * DE);
    const int drow = s * 1024 + (n0 >> 7) * 256 + up * 128 + (n0 & 127);
    if (MOE_F8) conv64_f8(W + (size_t)(64 * kb) * DE + n0, DE, (unsigned char*)(F.ws + WS_WGUT) + (size_t)drow * D + 64 * kb, D, (LAS unsigned char*)scr, F.lane, pg8::F8_SWG);
    else conv64(W + (size_t)(64 * kb) * DE + n0, DE, (bf16*)(F.ws + WS_WGUT) + (size_t)drow * D + 64 * kb, D, (LAS unsigned char*)scr, F.lane);
}
__device__ __forceinline__ void conv_item_dn(Frame& F, int s, int q, LAS float* scr) {
    const int nblk = D / 64, kb = q / nblk, nb = q % nblk;
    const float* W = (s == 0 ? F.ws_down : F.w_down + (size_t)(s - 1) * DE * D);
    if (MOE_F8) conv64_f8(W + (size_t)(64 * kb) * D + 64 * nb, D, (unsigned char*)(F.ws + WS_WDT) + (size_t)(s * D + 64 * nb) * DE + 64 * kb, DE, (LAS unsigned char*)scr, F.lane, pg8::F8_SWD);
    else conv64(W + (size_t)(64 * kb) * D + 64 * nb, D, (bf16*)(F.ws + WS_WDT) + (size_t)(s * D + 64 * nb) * DE + 64 * kb, DE, (LAS unsigned char*)scr, F.lane);
}
__device__ __forceinline__ void drain(Frame& F, int which, int fin_idx, unsigned target) {
    LAS float* scr = (LAS float*)(F.lds + RING_OFF + 32768 + F.wave * 12288);
    const unsigned total = which ? (unsigned)QC_ITEMS : (unsigned)QB_ITEMS;
    for (;;) {
        if (F.tid == 0) {
            unsigned base = 0xffffffffu; bool go = true;
            if (fin_idx >= 0) go = __hip_atomic_load(F.ctl + fin_idx, RLX_AGENT) < target;
            if (go) base = __hip_atomic_fetch_add(F.ctl + CW_Q + 64 * which, (unsigned)CONV_CH, RLX_AGENT);
            F.MISC[16] = base;
        }
        __syncthreads();
        const unsigned base = F.MISC[16];
        __syncthreads();
        if (base >= total) break;
        for (int j = F.wave; j < CONV_CH; j += NWAVES) { const unsigned r = base + j; if (r < total) { if (which) conv_item_dn(F, 1 + (int)(r / I_D), (int)(r % I_D), scr); else conv_item_gu(F, 1 + (int)(r / (2 * I_G)), (int)(r % (2 * I_G)), scr); } }
    }
}
__device__ __forceinline__ void phase_fin(Frame& F, int fin_idx) { __syncthreads(); if (F.tid == 0) __hip_atomic_fetch_add(F.ctl + fin_idx, 1u, RLX_AGENT); }

__device__ __forceinline__ void p0_gemv(Frame& F, int c0, int c1) {
    {
        __syncthreads();
        LAS float* cs = (LAS float*)(F.lds + RING_OFF);
        LAS float* red = (LAS float*)(F.lds + RING_OFF + 16384);
        for (int i = F.tid; i < NB * D; i += NTHR) { const float v = F.c[i]; cs[i] = v / (1.0f + __expf(-v)); }
        __syncthreads();
        float* part = (float*)(F.ws + WS_PART);
        const int nch = c1 - c0;
        for (int it = blockIdx.x; it < nch * KSL; it += F.G) {
            const int chunk = c0 + it % nch, sl = it / nch, k0 = sl * (D / KSL) + F.wave * 32;
            const float* wp = F.w_mod + (size_t)k0 * (6 * D) + chunk * 256 + F.lane * 4;
            f32x4 a0 = {0.f, 0.f, 0.f, 0.f}, a1 = {0.f, 0.f, 0.f, 0.f};
#pragma unroll 8
            for (int k = 0; k < 32; ++k) { const f32x4 w = *(const GAS f32x4*)(wp + (size_t)k * (6 * D)); const float c0 = cs[k0 + k], c1 = cs[D + k0 + k]; a0 += w * c0; a1 += w * c1; }
            *(LAS f32x4*)(red + (F.wave * 2 + 0) * 256 + F.lane * 4) = a0;
            *(LAS f32x4*)(red + (F.wave * 2 + 1) * 256 + F.lane * 4) = a1;
            __syncthreads();
            { const int b = F.tid >> 8, col = F.tid & 255; float s = 0.f;
#pragma unroll
              for (int w = 0; w < 8; ++w) s += red[(w * 2 + b) * 256 + col];
              part[((size_t)sl * 2 + b) * (6 * D) + chunk * 256 + col] = s; }
            __syncthreads();
        }
    }
}
__device__ __forceinline__ void p0_static_conv(Frame& F) {
    __syncthreads();
    LAS float* scr = (LAS float*)(F.lds + RING_OFF + 32768 + F.wave * 12288);
    const int gw = F.vcu * NWAVES + F.wave, NGW = F.G * NWAVES;
    constexpr int I_IN = (D / 64) * (INW / 64), I_OUT = (D / 64) * (D / 64), I_R = (D / 64) * (NE / 32);
    constexpr int NITEMS = I_IN + I_OUT + (2 * I_G + I_D) + I_R;
    bf16* WinT = (bf16*)(F.ws + WS_WINT); bf16* WoutT = (bf16*)(F.ws + WS_WOUTT);
    bf16* WrHi = (bf16*)(F.ws + WS_WRT); bf16* WrLo = WrHi + NE * D;
    for (int it = gw; it < NITEMS; it += NGW) {
        int r = it;
        if (r < I_IN) { const int nblk = INW / 64, kb = r / nblk, nb = r % nblk; conv64(F.w_in + (size_t)(64 * kb) * INW + 64 * nb, INW, WinT + (size_t)(64 * nb) * D + 64 * kb, D, (LAS unsigned char*)scr, F.lane); continue; } r -= I_IN;
        if (r < I_OUT) { const int nblk = D / 64, kb = r / nblk, nb = r % nblk; conv64(F.w_out + (size_t)(64 * kb) * D + 64 * nb, D, WoutT + (size_t)(64 * nb) * D + 64 * kb, D, (LAS unsigned char*)scr, F.lane); continue; } r -= I_OUT;
        if (r < 2 * I_G) { conv_item_gu(F, 0, r, scr); continue; } r -= 2 * I_G;
        if (r < I_D) { conv_item_dn(F, 0, r, scr); continue; } r -= I_D;
        { const int nblk = NE / 32, kb = r / nblk, nb = r % nblk;
          p0_transpose_item_hilo(F.w_router + (size_t)(64 * kb) * NE + 32 * nb, NE, WrHi + (size_t)(32 * nb) * D + 64 * kb, WrLo + (size_t)(32 * nb) * D + 64 * kb, D, scr, F.lane); }
    }
}

__device__ __forceinline__ void modf_reduce(Frame& F) {
    const float* part = (const float*)(F.ws + WS_PART); float* modf = (float*)(F.ws + WS_MODF);
    const int idx = blockIdx.x * NTHR + F.tid;
    if (idx < NB * 6 * D) { const int b = idx / (6 * D), j = idx % (6 * D); float s = F.b_mod[j];
#pragma unroll
        for (int sl = 0; sl < KSL; ++sl) s += part[((size_t)sl * 2 + b) * (6 * D) + j];
        modf[idx] = s; }
}
__device__ __forceinline__ void p1a_modulate(Frame& F) {
    const float* part = (const float*)(F.ws + WS_PART);
    LAS float* sm = (LAS float*)(F.lds + RING_OFF);
    bf16* hb = (bf16*)(F.ws + WS_HB);
    for (int r0 = F.vcu * 32; r0 < M; r0 += F.G * 32) {
        const int b = r0 / SEQ;
        __syncthreads();
        for (int i = F.tid; i < 2 * D; i += NTHR) { float s = F.b_mod[i];
#pragma unroll
            for (int sl = 0; sl < KSL; ++sl) s += part[((size_t)sl * 2 + b) * (6 * D) + i];
            sm[i] = s; }
        __syncthreads();
#pragma unroll 1
        for (int rr = 0; rr < 4; ++rr) {
            const int m = r0 + F.wave * 4 + rr; const GAS f32x4* xr = (const GAS f32x4*)(F.x + (size_t)m * D) + F.lane;
            const LAS f32x4* sh = (const LAS f32x4*)sm + F.lane; const LAS f32x4* sc = (const LAS f32x4*)(sm + D) + F.lane;
            GAS v2u* o = (GAS v2u*)(hb + (size_t)m * D) + F.lane;
#pragma unroll
            for (int j = 0; j < 8; ++j) { const f32x4 v = xr[64 * j], a = sc[64 * j], s = sh[64 * j]; const f32x4 h = v * (a + 1.0f) + s;
                v2u w; w.x = pk2(h.x, h.y); w.y = pk2(h.z, h.w); o[64 * j] = w; }
        }
    }
}

constexpr int KS_PITCH = 144, VT_PITCH = 528, LDS_KS = 0, LDS_VT = 256 * KS_PITCH;
__device__ __forceinline__ void p2_attn_conv(Frame& F) {
    const bf16* proj = (const bf16*)(F.ws + WS_PROJ); bf16* mix = (bf16*)(F.ws + WS_MIX);
    const int fr = F.lane & 15, fq = F.lane >> 4;
    for (int unit = blockIdx.x; unit < NB * (SEQ / 128) * NKVH; unit += F.G) {
        const int hkv = unit % NKVH, nb = (unit / NKVH) % (SEQ / 128), b = unit / (NKVH * (SEQ / 128));
        const int rowbase = b * SEQ + nb * 128 - 128;
        __syncthreads();
#pragma unroll
        for (int it = 0; it < 4; ++it) {
            const int idx = F.tid + NTHR * it, j = idx >> 3, c = idx & 7;
            v4u kv = {0u, 0u, 0u, 0u};
            if (nb > 0 || j >= 128) kv = *(const GAS v4u*)(proj + (size_t)(rowbase + j) * INW + COL_K + hkv * HD + c * 8);
            *(LAS v4u*)(F.lds + LDS_KS + j * KS_PITCH + c * 16) = kv;
        }
#pragma unroll
        for (int it = 0; it < 4; ++it) {
            const int idx = F.tid + NTHR * it, j = idx & 255, c = idx >> 8;
            v4u vv = {0u, 0u, 0u, 0u};
            if (nb > 0 || j >= 128) vv = *(const GAS v4u*)(proj + (size_t)(rowbase + j) * INW + COL_V + hkv * HD + c * 8);
            LAS unsigned short* vt = (LAS unsigned short*)(F.lds + LDS_VT + (c * 8) * VT_PITCH + j * 2);
            vt[0 * (VT_PITCH / 2)] = (unsigned short)(vv.x & 0xffffu); vt[1 * (VT_PITCH / 2)] = (unsigned short)(vv.x >> 16);
            vt[2 * (VT_PITCH / 2)] = (unsigned short)(vv.y & 0xffffu); vt[3 * (VT_PITCH / 2)] = (unsigned short)(vv.y >> 16);
            vt[4 * (VT_PITCH / 2)] = (unsigned short)(vv.z & 0xffffu); vt[5 * (VT_PITCH / 2)] = (unsigned short)(vv.z >> 16);
            vt[6 * (VT_PITCH / 2)] = (unsigned short)(vv.w & 0xffffu); vt[7 * (VT_PITCH / 2)] = (unsigned short)(vv.w >> 16);
        }
        __syncthreads();
        const int g = F.wave & 3, half = F.wave >> 2, h = hkv * 4 + g;
        const float slope2 = exp2f(-0.5f * (float)(h + 1)) * 1.4426950408889634f;
        const float sink2 = F.sinks[h] * 1.4426950408889634f;
        const float qk2 = 0.125f * 1.4426950408889634f;
#pragma unroll 1
        for (int mi = 0; mi < 4; ++mi) {
            const int i = half * 4 + mi, j0 = i >> 1;
            const size_t qrow = (size_t)(b * SEQ + nb * 128 + 16 * i + fr);
            const bf16x8 q0 = *(const GAS bf16x8*)(proj + qrow * INW + h * HD + 8 * fq), q1 = *(const GAS bf16x8*)(proj + qrow * INW + h * HD + 32 + 8 * fq);
            f32x4 s[10];
#pragma unroll
            for (int x = 0; x < 10; ++x) {
                const int tt = 2 * j0 + x;
                const bf16x8 k0 = *(const LAS bf16x8*)(F.lds + LDS_KS + (16 * tt + fr) * KS_PITCH + 16 * fq), k1 = *(const LAS bf16x8*)(F.lds + LDS_KS + (16 * tt + fr) * KS_PITCH + 64 + 16 * fq);
                f32x4 a = {0.f, 0.f, 0.f, 0.f};
                a = __builtin_amdgcn_mfma_f32_16x16x32_bf16(k0, q0, a, 0, 0, 0);
                a = __builtin_amdgcn_mfma_f32_16x16x32_bf16(k1, q1, a, 0, 0, 0);
                s[x] = a;
            }
            float mx = sink2;
#pragma unroll
            for (int x = 0; x < 10; ++x) {
#pragma unroll
                for (int r = 0; r < 4; ++r) {
                    const int kj = 16 * (2 * j0 + x) + 4 * fq + r, dist = 16 * i + fr + 128 - kj;
                    const bool valid = (dist >= 0) && (dist < 128) && (nb > 0 || kj >= 128);
                    const float v = valid ? (s[x][r] * qk2 - slope2 * (float)dist) : -INFINITY;
                    s[x][r] = v; mx = fmaxf(mx, v);
                }
            }
            mx = fmaxf(mx, __shfl_xor(mx, 16)); mx = fmaxf(mx, __shfl_xor(mx, 32));
            float l = 0.f;
#pragma unroll
            for (int x = 0; x < 10; ++x) {
#pragma unroll
                for (int r = 0; r < 4; ++r) { const float p = __builtin_amdgcn_exp2f(s[x][r] - mx); s[x][r] = p; l += p; }
            }
            l += __shfl_xor(l, 16); l += __shfl_xor(l, 32);
            const float inv = 1.0f / (l + __builtin_amdgcn_exp2f(sink2 - mx));
            f32x4 o[4];
#pragma unroll
            for (int dt = 0; dt < 4; ++dt) o[dt] = (f32x4){0.f, 0.f, 0.f, 0.f};
#pragma unroll
            for (int pp = 0; pp < 5; ++pp) {
                const int tt0 = 2 * (j0 + pp);
                v4u pw; pw.x = pk2(s[2 * pp][0] * inv, s[2 * pp][1] * inv); pw.y = pk2(s[2 * pp][2] * inv, s[2 * pp][3] * inv);
                pw.z = pk2(s[2 * pp + 1][0] * inv, s[2 * pp + 1][1] * inv); pw.w = pk2(s[2 * pp + 1][2] * inv, s[2 * pp + 1][3] * inv);
                const bf16x8 pf = __builtin_bit_cast(bf16x8, pw);
#pragma unroll
                for (int dt = 0; dt < 4; ++dt) {
                    const LAS unsigned char* vp = F.lds + LDS_VT + (16 * dt + fr) * VT_PITCH + 32 * tt0 + 8 * fq;
                    const v2u lo = *(const LAS v2u*)vp, hi = *(const LAS v2u*)(vp + 32);
                    v4u vw; vw.x = lo.x; vw.y = lo.y; vw.z = hi.x; vw.w = hi.y;
                    o[dt] = __builtin_amdgcn_mfma_f32_16x16x32_bf16(__builtin_bit_cast(bf16x8, vw), pf, o[dt], 0, 0, 0);
                }
            }
#pragma unroll
            for (int dt = 0; dt < 4; ++dt) { v2u w; w.x = pk2(o[dt][0], o[dt][1]); w.y = pk2(o[dt][2], o[dt][3]);
                *(GAS v2u*)(mix + qrow * D + h * HD + 16 * dt + 4 * fq) = w; }
        }
    }
    for (int item = F.vcu * NTHR + F.tid; item < (M / 8) * (CW / 8); item += F.G * NTHR) {
        const int cch = item % (CW / 8), rb = item / (CW / 8), r0 = rb * 8, t0 = r0 % SEQ, c0 = cch * 8;
        float w0[8], w1[8], w2[8], u1[8], u2[8];
        { const f32x4 a = *(const GAS f32x4*)(F.conv_w + c0), b2 = *(const GAS f32x4*)(F.conv_w + c0 + 4);
          w0[0] = a.x; w0[1] = a.y; w0[2] = a.z; w0[3] = a.w; w0[4] = b2.x; w0[5] = b2.y; w0[6] = b2.z; w0[7] = b2.w; }
        { const f32x4 a = *(const GAS f32x4*)(F.conv_w + CW + c0), b2 = *(const GAS f32x4*)(F.conv_w + CW + c0 + 4);
          w1[0] = a.x; w1[1] = a.y; w1[2] = a.z; w1[3] = a.w; w1[4] = b2.x; w1[5] = b2.y; w1[6] = b2.z; w1[7] = b2.w; }
        { const f32x4 a = *(const GAS f32x4*)(F.conv_w + 2 * CW + c0), b2 = *(const GAS f32x4*)(F.conv_w + 2 * CW + c0 + 4);
          w2[0] = a.x; w2[1] = a.y; w2[2] = a.z; w2[3] = a.w; w2[4] = b2.x; w2[5] = b2.y; w2[6] = b2.z; w2[7] = b2.w; }
        if (t0 == 0) {
#pragma unroll
            for (int q = 0; q < 8; ++q) { u1[q] = 0.f; u2[q] = 0.f; }
        } else {
            const v4u c1 = *(const GAS v4u*)(proj + (size_t)(r0 - 1) * INW + COL_CC + c0), h1 = *(const GAS v4u*)(proj + (size_t)(r0 - 1) * INW + COL_CH + c0);
            const v4u c2 = *(const GAS v4u*)(proj + (size_t)(r0 - 2) * INW + COL_CC + c0), h2 = *(const GAS v4u*)(proj + (size_t)(r0 - 2) * INW + COL_CH + c0);
            u1[0] = bflo(c1.x) * bflo(h1.x); u1[1] = bfhi(c1.x) * bfhi(h1.x); u1[2] = bflo(c1.y) * bflo(h1.y); u1[3] = bfhi(c1.y) * bfhi(h1.y);
            u1[4] = bflo(c1.z) * bflo(h1.z); u1[5] = bfhi(c1.z) * bfhi(h1.z); u1[6] = bflo(c1.w) * bflo(h1.w); u1[7] = bfhi(c1.w) * bfhi(h1.w);
            u2[0] = bflo(c2.x) * bflo(h2.x); u2[1] = bfhi(c2.x) * bfhi(h2.x); u2[2] = bflo(c2.y) * bflo(h2.y); u2[3] = bfhi(c2.y) * bfhi(h2.y);
            u2[4] = bflo(c2.z) * bflo(h2.z); u2[5] = bfhi(c2.z) * bfhi(h2.z); u2[6] = bflo(c2.w) * bflo(h2.w); u2[7] = bfhi(c2.w) * bfhi(h2.w);
        }
#pragma unroll
        for (int rr = 0; rr < 8; ++rr) {
            const size_t ro = (size_t)(r0 + rr) * INW;
            const v4u bv = *(const GAS v4u*)(proj + ro + COL_CB + c0), cv = *(const GAS v4u*)(proj + ro + COL_CC + c0), hv = *(const GAS v4u*)(proj + ro + COL_CH + c0);
            float u0[8], cb[8], y[8];
            u0[0] = bflo(cv.x) * bflo(hv.x); u0[1] = bfhi(cv.x) * bfhi(hv.x); u0[2] = bflo(cv.y) * bflo(hv.y); u0[3] = bfhi(cv.y) * bfhi(hv.y);
            u0[4] = bflo(cv.z) * bflo(hv.z); u0[5] = bfhi(cv.z) * bfhi(hv.z); u0[6] = bflo(cv.w) * bflo(hv.w); u0[7] = bfhi(cv.w) * bfhi(hv.w);
            cb[0] = bflo(bv.x); cb[1] = bfhi(bv.x); cb[2] = bflo(bv.y); cb[3] = bfhi(bv.y); cb[4] = bflo(bv.z); cb[5] = bfhi(bv.z); cb[6] = bflo(bv.w); cb[7] = bfhi(bv.w);
#pragma unroll
            for (int q = 0; q < 8; ++q) { y[q] = cb[q] * (w0[q] * u2[q] + w1[q] * u1[q] + w2[q] * u0[q]); u2[q] = u1[q]; u1[q] = u0[q]; }
            v4u ov; ov.x = pk2(y[0], y[1]); ov.y = pk2(y[2], y[3]); ov.z = pk2(y[4], y[5]); ov.w = pk2(y[6], y[7]);
            *(GAS v4u*)(mix + (size_t)(r0 + rr) * D + AW + c0) = ov;
        }
    }
}

constexpr int P4_STAT = 0, P4_GB = 1024, P4_PART = P4_GB + 4 * D * 4, P4_END = P4_PART + 8 * 32 * 64 * 4;
static_assert(P4_END <= RING_BYTES, "P4 LDS");
__device__ __forceinline__ void p4_ln_router(Frame& F, int u_first, int u_stride, int u_count) {
    const bf16* y1 = (const bf16*)(F.ws + WS_Y1); bf16* x1 = (bf16*)(F.ws + WS_X1); bf16* xg = (bf16*)(F.ws + WS_XG);
    const float* modf = (const float*)(F.ws + WS_MODF);
    const bf16* WrHi = (const bf16*)(F.ws + WS_WRT); const bf16* WrLo = WrHi + NE * D;
    int* rowtok = (int*)(F.ws + WS_ROWTOK); float* roww = (float*)(F.ws + WS_ROWW); int* tokslot = (int*)(F.ws + WS_TOKSLOT);
    LAS float* stat = (LAS float*)(F.lds + P4_STAT); LAS float* GB = (LAS float*)(F.lds + P4_GB); LAS float* lpart = (LAS float*)(F.lds + P4_PART);
    const int fr = F.lane & 15, fq = F.lane >> 4;
    int prev_b = -1;
    for (int ui_ = 0, unit = u_first; ui_ < u_count && unit < M / 32; ++ui_, unit += u_stride) {
        const int row0 = unit * 32, b = row0 / SEQ;
        const float* sh2 = modf + (size_t)b * 6 * D + 3 * D; const float* sc2 = modf + (size_t)b * 6 * D + 4 * D;
        __syncthreads();
        if (F.tid < NE) ((LAS unsigned*)(F.lds + P4_STAT + 512))[F.tid] = 0u;
        if (b != prev_b) { prev_b = b;
        for (int k = F.tid; k < D; k += NTHR) { const float a = 1.0f + sc2[k], g = F.ln1_g[k], bb = F.ln1_b[k]; GB[k] = g * a; GB[D + k] = bb * a + sh2[k]; GB[2 * D + k] = g; GB[3 * D + k] = bb; } }
        v4u yw[4][4];
#pragma unroll
        for (int rr = 0; rr < 4; ++rr) { const GAS v4u* yr = (const GAS v4u*)(y1 + (size_t)(row0 + F.wave * 4 + rr) * D) + F.lane;
#pragma unroll
            for (int c = 0; c < 4; ++c) yw[rr][c] = yr[64 * c]; }
        __syncthreads();
#pragma unroll
        for (int rr = 0; rr < 4; ++rr) {
            const int r = F.wave * 4 + rr; const size_t m = (size_t)(row0 + r);
            f32x4 v[8]; float s = 0.f;
#pragma unroll
            for (int c = 0; c < 4; ++c) { const v4u w = yw[rr][c]; v[2 * c] = (f32x4){bflo(w.x), bfhi(w.x), bflo(w.y), bfhi(w.y)}; v[2 * c + 1] = (f32x4){bflo(w.z), bfhi(w.z), bflo(w.w), bfhi(w.w)}; }
#pragma unroll
            for (int j = 0; j < 8; ++j) s += (v[j].x + v[j].y) + (v[j].z + v[j].w);
            const float mean = wave_sum(s) * (1.f / D); float s2 = 0.f;
#pragma unroll
            for (int j = 0; j < 8; ++j) { v[j] = v[j] - mean; s2 += (v[j].x * v[j].x + v[j].y * v[j].y) + (v[j].z * v[j].z + v[j].w * v[j].w); }
            const float rstd = 1.f / sqrtf(wave_sum(s2) * (1.f / D) + LN_EPS);
            if (F.lane == 0) { stat[2 * r] = mean; stat[2 * r + 1] = rstd; }
            GAS v2u* xo = (GAS v2u*)(x1 + m * D); GAS v2u* ho = (GAS v2u*)(xg + m * D); GAS unsigned* ho8 = (GAS unsigned*)((unsigned char*)xg + m * D);
#pragma unroll
            for (int j = 0; j < 8; ++j) {
                const int q4 = 128 * (j >> 1) + 2 * F.lane + (j & 1);
                const f32x4 vn = v[j] * rstd;
                const f32x4 xv = vn * *((const LAS f32x4*)(GB + 2 * D) + q4) + *((const LAS f32x4*)(GB + 3 * D) + q4); { v2u xw; xw.x = pk2(xv.x, xv.y); xw.y = pk2(xv.z, xv.w); xo[q4] = xw; }
                const f32x4 hv = vn * *((const LAS f32x4*)GB + q4) + *((const LAS f32x4*)(GB + D) + q4);
                if (MOE_F8) { f32x4 t = hv * pg8::F8_SX;
#pragma unroll
                    for (int q = 0; q < 4; ++q) t[q] = __builtin_fminf(__builtin_fmaxf(t[q], -440.0f), 440.0f);
                    int pa = __builtin_amdgcn_cvt_pk_fp8_f32(t.x, t.y, 0, false); pa = __builtin_amdgcn_cvt_pk_fp8_f32(t.z, t.w, pa, true); ho8[q4] = (unsigned)pa; }
                else { v2u w; w.x = pk2(hv.x, hv.y); w.y = pk2(hv.z, hv.w); ho[q4] = w; }
            }
        }
        __syncthreads();
        {
            f32x4 acc[2][4];
#pragma unroll
            for (int mt = 0; mt < 2; ++mt)
#pragma unroll
                for (int nt = 0; nt < 4; ++nt) acc[mt][nt] = (f32x4){0.f, 0.f, 0.f, 0.f};
            const float mu0 = stat[2 * fr], rs0 = stat[2 * fr + 1], mu1 = stat[2 * (16 + fr)], rs1 = stat[2 * (16 + fr) + 1];
#pragma unroll 4
            for (int ks = F.wave * 8; ks < F.wave * 8 + 8; ++ks) {
                const int k0 = 32 * ks + 8 * fq;
                const f32x4 g0 = *(const LAS f32x4*)(GB + k0), g1 = *(const LAS f32x4*)(GB + k0 + 4), b0 = *(const LAS f32x4*)(GB + D + k0), b1 = *(const LAS f32x4*)(GB + D + k0 + 4);
                bf16x8 whi[4], wlo[4];
#pragma unroll
                for (int nt = 0; nt < 4; ++nt) { whi[nt] = *(const GAS bf16x8*)(WrHi + (size_t)(16 * nt + fr) * D + k0); wlo[nt] = *(const GAS bf16x8*)(WrLo + (size_t)(16 * nt + fr) * D + k0); }
#pragma unroll
                for (int mt = 0; mt < 2; ++mt) {
                    const float mu = mt ? mu1 : mu0, rs = mt ? rs1 : rs0;
                    const v4u yw = *(const GAS v4u*)(y1 + (size_t)(row0 + 16 * mt + fr) * D + k0);
                    const f32x4 ya = {bflo(yw.x), bfhi(yw.x), bflo(yw.y), bfhi(yw.y)}, yb = {bflo(yw.z), bfhi(yw.z), bflo(yw.w), bfhi(yw.w)};
                    const f32x4 ha = (ya - mu) * rs * g0 + b0, hb2 = (yb - mu) * rs * g1 + b1;
                    unsigned hh[8], ll[8];
                    { const float t[8] = {ha.x, ha.y, ha.z, ha.w, hb2.x, hb2.y, hb2.z, hb2.w};
#pragma unroll
                      for (int q = 0; q < 8; ++q) { hh[q] = f2bf(t[q]); ll[q] = f2bf(t[q] - bf2f(hh[q])); } }
                    v4u ah, al; ah.x = hh[0] | (hh[1] << 16); ah.y = hh[2] | (hh[3] << 16); ah.z = hh[4] | (hh[5] << 16); ah.w = hh[6] | (hh[7] << 16);
                    al.x = ll[0] | (ll[1] << 16); al.y = ll[2] | (ll[3] << 16); al.z = ll[4] | (ll[5] << 16); al.w = ll[6] | (ll[7] << 16);
                    const bf16x8 fh = __builtin_bit_cast(bf16x8, ah), fl = __builtin_bit_cast(bf16x8, al);
#pragma unroll
                    for (int nt = 0; nt < 4; ++nt) {
                        acc[mt][nt] = __builtin_amdgcn_mfma_f32_16x16x32_bf16(fh, whi[nt], acc[mt][nt], 0, 0, 0);
                        acc[mt][nt] = __builtin_amdgcn_mfma_f32_16x16x32_bf16(fl, whi[nt], acc[mt][nt], 0, 0, 0);
                        acc[mt][nt] = __builtin_amdgcn_mfma_f32_16x16x32_bf16(fh, wlo[nt], acc[mt][nt], 0, 0, 0);
                    }
                }
            }
#pragma unroll
            for (int mt = 0; mt < 2; ++mt)
#pragma unroll
                for (int nt = 0; nt < 4; ++nt)
#pragma unroll
                    for (int r = 0; r < 4; ++r) lpart[(F.wave * 32 + 16 * mt + 4 * fq + r) * 64 + 16 * nt + fr] = acc[mt][nt][r];
        }
        __syncthreads();
        {
            LAS unsigned* hist = (LAS unsigned*)(F.lds + P4_STAT + 512); LAS unsigned* hbase = hist + 64;
            const int e = F.lane; const float rb = F.router_bias[e];
            bool chosen[4]; float wgt[4]; int erks[4]; unsigned lrank[4];
#pragma unroll
            for (int rr = 0; rr < 4; ++rr) {
                const int r = F.wave * 4 + rr;
                float logit = 0.f;
#pragma unroll
                for (int w = 0; w < 8; ++w) logit += lpart[(w * 32 + r) * 64 + e];
                const float score = 1.0f / (1.0f + __expf(-logit));
                const float sel = score + rb;
                int rk = 0;
#pragma unroll
                for (int x = 1; x < 8; ++x) { const float o = __shfl_xor(sel, x); const int e2 = e ^ x; rk += (o > sel || (o == sel && e2 < e)) ? 1 : 0; }
                float gs = rk < 2 ? sel : 0.f;
                gs += __shfl_xor(gs, 1); gs += __shfl_xor(gs, 2); gs += __shfl_xor(gs, 4);
                int grk = 0; const int gi = e >> 3;
#pragma unroll
                for (int x = 1; x < 8; ++x) { const float o = __shfl_xor(gs, 8 * x); const int g2 = gi ^ x; grk += (o > gs || (o == gs && g2 < gi)) ? 1 : 0; }
                const bool gsel = grk < 4;
                const float mv = gsel ? sel : -INFINITY;
                int erk = 0;
#pragma unroll 9
                for (int x = 1; x < 64; ++x) { const float o = __shfl_xor(mv, x); const int e2 = e ^ x; erk += (o > mv || (o == mv && e2 < e)) ? 1 : 0; }
                chosen[rr] = gsel && erk < TOPK; erks[rr] = erk;
                const float wsum = wave_sum(chosen[rr] ? score : 0.f);
                wgt[rr] = score / wsum * RSCALE;
                lrank[rr] = chosen[rr] ? __hip_atomic_fetch_add(hist + e, 1u, __ATOMIC_RELAXED, __HIP_MEMORY_SCOPE_WORKGROUP) : 0u;
            }
            __syncthreads();
            if (F.tid < NE) { const unsigned n = hist[F.tid]; hbase[F.tid] = n ? __hip_atomic_fetch_add(F.ctl + CW_CNT + 64 * F.tid, n, RLX_AGENT) : 0u; }
            __syncthreads();
            const unsigned pb = hbase[e];
#pragma unroll
            for (int rr = 0; rr < 4; ++rr) if (chosen[rr]) { const int tok = row0 + F.wave * 4 + rr; const unsigned pos = pb + lrank[rr];
                rowtok[e * M + pos] = tok; roww[e * M + pos] = wgt[rr]; tokslot[tok * TOPK + erks[rr]] = e * M + (int)pos; }
        }
    }
}

__device__ __forceinline__ void build_tables(Frame& F) {
    LAS unsigned short* tslot = (LAS unsigned short*)(F.lds + TS_OFF); LAS int* poff = (LAS int*)(F.lds + POFF_OFF); LAS int* cnt = poff + 128; LAS int* nt_p = poff + 256;
    __syncthreads();
    if (F.wave == 0) {
        const int e = F.lane; int c = (int)__hip_atomic_load(F.ctl + CW_CNT + 64 * e, RLX_AGENT); c = c < 0 ? 0 : (c > M ? M : c);
        cnt[e] = c;
        const int n = (c + 255) >> 8; int incl = n;
#pragma unroll
        for (int o = 1; o < 64; o <<= 1) { const int v = __shfl_up(incl, o); if (e >= o) incl += v; }
        const int t0 = M / 256 + incl - n;
        poff[1 + e] = t0 * 256; if (e == 0) poff[0] = 0;
        for (int i = 0; i < n; ++i) if (t0 + i < MAXT) tslot[t0 + i] = (unsigned short)(1 + e);
        if (e < M / 256) tslot[e] = 0;
        if (e == 63) { const int t = M / 256 + incl; nt_p[0] = t < MAXT ? t : MAXT; }
    }
    __syncthreads();
}

__device__ __forceinline__ void p6_setup(Frame& F, int Geff, int c) {
    const LAS unsigned short* tslot = (const LAS unsigned short*)(F.lds + TS_OFF); const LAS int* poff = (const LAS int*)(F.lds + POFF_OFF); const LAS int* cnt = poff + 128; const int ntiles = poff[256];
    const int* rowtok = (const int*)(F.ws + WS_ROWTOK); const float* roww = (const float*)(F.ws + WS_ROWW); float* wrow = (float*)(F.ws + WS_WROW);
    v4u* vt = (v4u*)(F.ws + WS_VTAB) + (size_t)blockIdx.x * 8 * NTHR;
    int R0, C0, R1, C1; pg8::stage_rc(F.tid * 16, R0, C0); pg8::stage_rc(F.tid * 16 + 8192, R1, C1);
    const int nun = (ntiles * 4 - c + Geff - 1) / Geff;
    int rr[4] = {R0, R1, 128 + R0, 128 + R1}; const int cc[4] = {C0, C1, C0, C1};
    int tokv[8][4]; float wv[8];
#pragma unroll
    for (int i = 0; i < 8; ++i) {
        wv[i] = 1.0f;
#pragma unroll
        for (int q = 0; q < 4; ++q) tokv[i][q] = 0;
        if (i < nun) {
            const int L = i * Geff + c, t = L >> 2, s = tslot[t], e = s - 1, pos0 = t * 256 - poff[s], ce = s ? cnt[e] : 0;
#pragma unroll
            for (int q = 0; q < 4; ++q) { tokv[i][q] = t * 256 + rr[q]; if (s) { const int pos = pos0 + rr[q]; tokv[i][q] = pos < ce ? rowtok[e * M + pos] : 0; } }
            if (F.tid < 256 && s) { const int pos = pos0 + F.tid; wv[i] = pos < ce ? roww[e * M + pos] : 0.f; }
        }
    }
#pragma unroll
    for (int i = 0; i < 8; ++i) if (i < nun) {
        const int L = i * Geff + c, t = L >> 2;
        v4u o; o.x = (unsigned)(tokv[i][0] * (MOE_F8 ? D / 2 : D) + cc[0]) * 2u; o.y = (unsigned)(tokv[i][1] * (MOE_F8 ? D / 2 : D) + cc[1]) * 2u;
        o.z = (unsigned)(tokv[i][2] * (MOE_F8 ? D / 2 : D) + cc[2]) * 2u; o.w = (unsigned)(tokv[i][3] * (MOE_F8 ? D / 2 : D) + cc[3]) * 2u;
        vt[i * NTHR + F.tid] = o;
        if (F.tid < 256) wrow[t * 256 + F.tid] = wv[i];
    }
    VM_WAIT(); __syncthreads();
}

__device__ __forceinline__ void p7_combine(Frame& F) {
    build_tables(F);
    const LAS int* poff = (const LAS int*)(F.lds + POFF_OFF);
    const unsigned char* Y = (const unsigned char*)(F.ws + WS_XG); const bf16* x1 = (const bf16*)(F.ws + WS_X1); const float* modf = (const float*)(F.ws + WS_MODF);
    const int* tokslot = (const int*)(F.ws + WS_TOKSLOT);
    const int gw = F.vcu * NWAVES + F.wave, NGW = F.G * NWAVES;
    typedef float f32x2 __attribute__((ext_vector_type(2)));
    for (int m = gw; m < M; m += NGW) {
        const int b = m / SEQ; const float* g2 = modf + (size_t)b * 6 * D + 5 * D;
        int ln = F.lane; asm volatile("" : "+v"(ln));
        int rows[9]; rows[0] = m;
#pragma unroll
        for (int k = 0; k < TOPK; ++k) { const int sl = __builtin_amdgcn_readfirstlane(tokslot[m * TOPK + k]), e = sl / M, pos = sl % M; rows[1 + k] = poff[1 + e] + pos; }
        f32x4 v[2][4];
#pragma unroll
        for (int j = 0; j < 2; ++j)
#pragma unroll
            for (int q = 0; q < 4; ++q) v[j][q] = (f32x4){0.f, 0.f, 0.f, 0.f};
        v4u w[9][2];
#pragma unroll
        for (int k = 0; k < 9; ++k) { const GAS v4u* yr = (const GAS v4u*)(Y + (size_t)rows[k] * D); w[k][0] = yr[ln]; w[k][1] = yr[64 + ln]; }
        f32x4 xv[2][4];
        { const GAS v4u* xr0 = (const GAS v4u*)(x1 + (size_t)m * D);
#pragma unroll
          for (int j = 0; j < 2; ++j)
#pragma unroll
              for (int h = 0; h < 2; ++h) { const v4u w = xr0[2 * ln + 128 * j + h];
                  xv[j][2 * h] = (f32x4){bflo(w.x), bfhi(w.x), bflo(w.y), bfhi(w.y)}; xv[j][2 * h + 1] = (f32x4){bflo(w.z), bfhi(w.z), bflo(w.w), bfhi(w.w)}; } }
#pragma unroll
        for (int k = 0; k < 9; ++k)
#pragma unroll
            for (int j = 0; j < 2; ++j) {
                const unsigned ww[4] = {w[k][j].x, w[k][j].y, w[k][j].z, w[k][j].w};
#pragma unroll
                for (int q = 0; q < 4; ++q) { const f32x2 lo = (Y_BF8 == 2) ? __builtin_amdgcn_cvt_pk_f32_fp8((int)ww[q], false) : __builtin_amdgcn_cvt_pk_f32_bf8((int)ww[q], false), hi = (Y_BF8 == 2) ? __builtin_amdgcn_cvt_pk_f32_fp8((int)ww[q], true) : __builtin_amdgcn_cvt_pk_f32_bf8((int)ww[q], true);
                    v[j][q].x += lo.x; v[j][q].y += lo.y; v[j][q].z += hi.x; v[j][q].w += hi.y; }
            }
        const GAS f32x4* gr = (const GAS f32x4*)g2; const int l4 = 4 * ln; float s = 0.f;
#pragma unroll
        for (int j = 0; j < 2; ++j)
#pragma unroll
            for (int q = 0; q < 4; ++q) { v[j][q] = xv[j][q] * ALPHA + (gr[l4 + 256 * j + q] + 1.0f) * (v[j][q] * ((Y_BF8 == 2) ? (1.0f / 64.0f) : 1.0f)); s += (v[j][q].x + v[j][q].y) + (v[j][q].z + v[j][q].w); }
        const float mean = wave_sum(s) * (1.f / D); float s2 = 0.f;
#pragma unroll
        for (int j = 0; j < 2; ++j)
#pragma unroll
            for (int q = 0; q < 4; ++q) { v[j][q] = v[j][q] - mean; s2 += (v[j][q].x * v[j][q].x + v[j][q].y * v[j][q].y) + (v[j][q].z * v[j][q].z + v[j][q].w * v[j][q].w); }
        const float rstd = 1.f / sqrtf(wave_sum(s2) * (1.f / D) + LN_EPS);
        GAS f32x4* o = (GAS f32x4*)(F.out + (size_t)m * D); const GAS f32x4* lg = (const GAS f32x4*)F.ln2_g; const GAS f32x4* lb = (const GAS f32x4*)F.ln2_b;
#pragma unroll
        for (int j = 0; j < 2; ++j)
#pragma unroll
            for (int q = 0; q < 4; ++q) o[l4 + 256 * j + q] = v[j][q] * rstd * lg[l4 + 256 * j + q] + lb[l4 + 256 * j + q];
    }
}

constexpr int NPHASE = 9;
struct Args { const float* in[20]; float* out; unsigned char* ws; int ph_lo, ph_hi; };
__global__ void __launch_bounds__(NWAVES * 64, 2) mk_fwd(Args args) {
    extern __shared__ __attribute__((aligned(16))) unsigned char lds[];
    Frame F;
    F.lds = (LAS unsigned char*)lds;
    F.MISC = (volatile LAS unsigned*)(F.lds + MISC_OFF);
    F.tid = threadIdx.x; F.lane = F.tid & 63; F.wave = __builtin_amdgcn_readfirstlane(F.tid >> 6);
    F.G = gridDim.x; { const int bx = blockIdx.x; F.vcu = (F.G % 8 == 0) ? (bx % 8) * (F.G / 8) + bx / 8 : bx; }
    F.ws = args.ws; F.ctl = (gu32*)(args.ws + WS_CTL);
    F.x = args.in[0]; F.c = args.in[1]; F.w_mod = args.in[2]; F.b_mod = args.in[3]; F.w_in = args.in[4]; F.conv_w = args.in[5]; F.sinks = args.in[6]; F.w_out = args.in[7];
    F.ln1_g = args.in[8]; F.ln1_b = args.in[9]; F.w_router = args.in[10]; F.router_bias = args.in[11]; F.w_gate = args.in[12]; F.w_up = args.in[13]; F.w_down = args.in[14];
    F.ws_gate = args.in[15]; F.ws_up = args.in[16]; F.ws_down = args.in[17]; F.ln2_g = args.in[18]; F.ln2_b = args.in[19]; F.out = args.out;
    for (int u = F.tid; u < (LDS_BYTES - LDSCTL_OFF) / 4; u += NWAVES * 64) ((LAS unsigned*)(F.lds + LDSCTL_OFF))[u] = 0u;
    __syncthreads();
    XcdBarrier bar; bar.bar = (unsigned*)(F.ctl + CW_BAR); bar.x = 0; bar.st = nullptr;
    if (!MK_PER_PHASE) bar = xcd_barrier_post((unsigned*)(F.ctl + CW_BAR), F.MISC + 8);
#define GRID_BAR() do { if (!MK_PER_PHASE) xcd_barrier(bar); } while (0)
    unsigned long long tA = 0;
#define ST_BEGIN(k) do { if (PROBE_STAMP == (k)) tA = __builtin_amdgcn_s_memrealtime(); } while (0)
#define ST_END(k) do { if (PROBE_STAMP == (k)) { const unsigned long long t1 = __builtin_amdgcn_s_memrealtime(), dd = t1 - tA; while (__builtin_amdgcn_s_memrealtime() - t1 < dd) __builtin_amdgcn_s_sleep(8); } } while (0)
    const int lo = args.ph_lo, hi = args.ph_hi;
#define IN(k) (lo <= (k) && (k) < hi && ((F.lane = pg8::lane_id_v()), (F.tid = F.wave * 64 + F.lane), true))
#define BOTH(k) (IN(k) && IN((k) + 1))
    if (IN(0)) { ST_BEGIN(0); p0_gemv(F, 0, 16); if (BOTH(0)) GRID_BAR(); ST_END(0); }
    if (IN(1)) { ST_BEGIN(1); p1a_modulate(F); p0_gemv(F, 16, 48); p0_static_conv(F); if (BOTH(1)) GRID_BAR(); ST_END(1); }
    if (IN(2)) {
        ST_BEGIN(2);
        __syncthreads();
        const bool split = (F.G == 256); const int q = (int)blockIdx.x >> 3, x = (int)blockIdx.x & 7, Geff = split ? 192 : F.G;
        if (!split || q < 24) {
            pg8::Gemm g{(const pg8::bf16_t*)(F.ws + WS_HB), (const pg8::bf16_t*)(F.ws + WS_WINT), M, INW, D, F.ws}; pg8::StaticOrder S; S.init(M, INW, Geff, split ? q * 8 + x : (int)blockIdx.x);
            pg8::EpiBf16<0> E{(pg8::bf16_t*)(F.ws + WS_PROJ), INW, nullptr, 0, 0, 1.f};
            pg8::gemm_phase<pg8::EpiBf16<0>, pg8::StaticOrder, PG8_ALIGN, PG8_SP2>(F.lds + RING_OFF, g, S, E, F.wave);
            phase_fin(F, CW_FIN + 64 * 2);
        } else { drain(F, 0, CW_FIN + 64 * 2, (unsigned)Geff); drain(F, 1, CW_FIN + 64 * 2, (unsigned)Geff); }
        if (BOTH(2)) GRID_BAR();
        ST_END(2);
    }
    if (IN(3)) { ST_BEGIN(3); modf_reduce(F); p2_attn_conv(F); if (BOTH(3)) GRID_BAR(); ST_END(3); }
    if (IN(4)) {
        ST_BEGIN(4);
        _Pragma("unroll") for (int rep = (REP_PHASE == 4 ? 0 : 1); rep < 2; ++rep) {
        __syncthreads();
        pg8::Gemm g{(const pg8::bf16_t*)(F.ws + WS_MIX), (const pg8::bf16_t*)(F.ws + WS_WOUTT), M, D, D, F.ws}; pg8::StaticOrder S; S.init(M, D, F.G, (int)blockIdx.x);
        pg8::EpiResF32 E{F.x, (pg8::bf16_t*)(F.ws + WS_Y1), (const float*)(F.ws + WS_MODF) + 2 * D, D, SEQ, 6 * D, ALPHA};
        pg8::gemm_phase<pg8::EpiResF32, pg8::StaticOrder, PG8_ALIGN, PG8_SP2>(F.lds + RING_OFF, g, S, E, F.wave);
        if (rep == 0) GRID_BAR(); }
        if (BOTH(4)) GRID_BAR();
        ST_END(4);
    }
    if (IN(5)) { ST_BEGIN(5);
        const bool split5 = (F.G == 256) && (P5_MAIN_Q < 32); const int q5 = (int)blockIdx.x >> 3, x5 = (int)blockIdx.x & 7, nmain = split5 ? 8 * P5_MAIN_Q : F.G;
        if (!split5 || q5 < P5_MAIN_Q) { p4_ln_router(F, split5 ? (q5 * 8 + x5) * (256 / nmain) : (int)blockIdx.x, split5 ? 1 : nmain, split5 ? 256 / nmain : 1 << 20); phase_fin(F, CW_FIN + 64 * 5); }
        else { drain(F, 0, CW_FIN + 64 * 5, (unsigned)nmain); drain(F, 1, CW_FIN + 64 * 5, (unsigned)nmain); }
        __syncthreads(); ST_BEGIN(10); drain(F, 0, -1, 0u); ST_END(10); if (BOTH(5)) GRID_BAR(); ST_END(5); }
    if (IN(6)) {
        ST_BEGIN(6); ST_BEGIN(12);
        build_tables(F);
        const int ntiles = ((const LAS int*)(F.lds + POFF_OFF))[256];
        const int units = ntiles * 4, Rn = (units + F.G - 1) / F.G, slack = F.G - (units + Rn - 1) / Rn, R = (F.G == 256 && slack < P6_MIN_CONV) ? Rn + 1 : Rn, Geff = (F.G % 8 == 0) ? (units + R - 1) / R : F.G;
        const int x = (int)blockIdx.x & 7, q = (int)blockIdx.x >> 3;
        int c = (int)blockIdx.x;
        if (F.G % 8 == 0) { int px = 0; for (int xx = 0; xx < x; ++xx) px += (Geff - xx + 7) >> 3; c = px + q; }
        if ((int)blockIdx.x < Geff) {
            p6_setup(F, Geff, c);
            int Kgu = MOE_F8 ? D / 2 : D; asm volatile("" : "+s"(Kgu));
            pg8::Gemm g{(const pg8::bf16_t*)(F.ws + WS_XG), (const pg8::bf16_t*)(F.ws + WS_WGUT), M, NSLOT * 1024, Kgu, F.ws};
            pg8::GroupedOrder<true> S{(const PG8_LAS unsigned short*)(F.lds + TS_OFF), ntiles, 4, Geff, c, (const unsigned*)(F.ws + WS_VTAB) + (size_t)blockIdx.x * 8 * NTHR * 4, 0, (const float*)(F.ws + WS_WROW)};
            pg8::EpiSwiGLU E{(pg8::bf16_t*)(F.ws + WS_H), (const PG8_LAS float*)(F.lds + RING_OFF + pg8::WR_SLOT), DE, 4};
            pg8::gemm_phase<pg8::EpiSwiGLU, pg8::GroupedOrder<true>, PG8_ALIGN, PG8_SP2>(F.lds + RING_OFF, g, S, E, F.wave);
            phase_fin(F, CW_FIN + 64 * 6);
        } else drain(F, 1, CW_FIN + 64 * 6, (unsigned)Geff);
        __syncthreads();
        ST_END(12); ST_BEGIN(11);
        drain(F, 1, -1, 0u);
        ST_END(11);
        if (BOTH(6)) GRID_BAR();
        ST_END(6);
    }
    if (IN(7)) {
        ST_BEGIN(7);
        _Pragma("unroll") for (int rep = (REP_PHASE == 7 ? 0 : 1); rep < 2; ++rep) {
        build_tables(F);
        const int ntiles = ((const LAS int*)(F.lds + POFF_OFF))[256];
        int Kdn = MOE_F8 ? DE / 2 : DE; asm volatile("" : "+s"(Kdn));
        pg8::Gemm g{(const pg8::bf16_t*)(F.ws + WS_H), (const pg8::bf16_t*)(F.ws + WS_WDT), MAXR, NSLOT * D, Kdn, F.ws};
        pg8::GroupedOrder<false> S{(const PG8_LAS unsigned short*)(F.lds + TS_OFF), ntiles, 8, F.G, F.vcu, nullptr, (PROBE_PIN && rep == 0) ? 1 : 0};
        pg8::EpiDown E{(pg8::bf16_t*)(F.ws + WS_XG), D, 8, (PROBE_NOSTORE && rep == 0) ? 1 : 0};
        if (DOWN_STAGGER) {
            const unsigned long long t0 = __builtin_amdgcn_s_memrealtime(), dl = (unsigned long long)(((unsigned)F.vcu >> 3) & 7u) * DOWN_STAGGER;
            while (__builtin_amdgcn_s_memrealtime() - t0 < dl) __builtin_amdgcn_s_sleep(4);
        }
        pg8::gemm_phase<pg8::EpiDown, pg8::GroupedOrder<false>, PG8_ALIGN, PG8_SP2>(F.lds + RING_OFF, g, S, E, F.wave);
        if (rep == 0) GRID_BAR(); }
        if (BOTH(7)) GRID_BAR();
        ST_END(7);
    }
    if (IN(8)) { ST_BEGIN(8); p7_combine(F); VM_WAIT(); ST_END(8); }
#undef IN
#undef BOTH
}

extern "C" void kernel_launch(void* const* d_in, const int* in_sizes, int n_in, void* d_out, int out_size, void* d_ws, size_t ws_size, hipStream_t stream) {
    static int grid = 0;
    if (grid == 0) {
        if (n_in != 20 || in_sizes[0] != M * D || out_size != M * D || ws_size < WS_END) { fprintf(stderr, "kernel_launch: unexpected shapes (n_in %d, in0 %d, out %d, ws %zu)\n", n_in, n_in > 0 ? in_sizes[0] : -1, out_size, ws_size); grid = -1; return; }
        int dev = 0, cus = 0, per_cu = 0;
        if (hipGetDevice(&dev) != hipSuccess || hipDeviceGetAttribute(&cus, hipDeviceAttributeMultiprocessorCount, dev) != hipSuccess) { grid = -1; return; }
        if (hipFuncSetAttribute((const void*)mk_fwd, hipFuncAttributeMaxDynamicSharedMemorySize, LDS_BYTES) != hipSuccess) { fprintf(stderr, "kernel_launch: hipFuncSetAttribute failed\n"); grid = -1; return; }
        if (hipOccupancyMaxActiveBlocksPerMultiprocessor(&per_cu, (const void*)mk_fwd, NWAVES * 64, LDS_BYTES) != hipSuccess || per_cu < 1) fprintf(stderr, "kernel_launch: occupancy query reports %d\n", per_cu);
        (void)hipGetLastError();
        grid = cus;
    }
    if (grid < 0) return;
    if (hipMemsetAsync((char*)d_ws + WS_CTL, 0, CTL_ZERO_BYTES, stream) != hipSuccess) return;
    Args a{};
    for (int i = 0; i < 20; ++i) a.in[i] = (const float*)d_in[i];
    a.out = (float*)d_out; a.ws = (unsigned char*)d_ws;
#if MK_PER_PHASE
    for (int p = 0; p < NPHASE; ++p) { a.ph_lo = p; a.ph_hi = p + 1; hipLaunchKernelGGL(mk_fwd, dim3(grid), dim3(NWAVES * 64), LDS_BYTES, stream, a); }
#else
    a.ph_lo = 0; a.ph_hi = NPHASE; hipLaunchKernelGGL(mk_fwd, dim3(grid), dim3(NWAVES * 64), LDS_BYTES, stream, a);
#endif
}
```
